# Optimizing an MI355X kernel written in HIP

```python
import math
import jax
import jax.numpy as jnp
from jax import lax
import numpy as np

D_MODEL = 1024
BATCH = 2
SEQ = 16384
DEPTH = 1

D_MIX = D_MODEL
HEAD_DIM = 64
D_ATTN = D_MIX // 2
D_CONV = D_MIX - D_ATTN
N_HEADS = D_ATTN // HEAD_DIM
N_KV = 2
HPG = N_HEADS // N_KV
KV_DIM = N_KV * HEAD_DIM
N_MIX_GROUPS = D_MIX // HEAD_DIM
CONV_WIDTH = 3
CMP_LEN = 32
CMP_STRIDE = 16
CMP_HIDDEN = 256
SLC_LEN = 64
N_SELECT = 16
WINDOW = 512
Q_BLOCK = 128
N_BUCKETS = 32
MAX_DISTANCE = 128
N_GROUPS = 8
EXPERTS_PER_GROUP = 8
N_EXPERTS = N_GROUPS * EXPERTS_PER_GROUP
TOP_K = 2
D_EXPERT = D_MODEL // 2
MOE_BLOCK = 128
FORCED_SCORE = 1e4
EPS = 1e-6
N_IN = D_ATTN + 6 * KV_DIM + 3 * N_HEADS + 3 * D_CONV

kernel_name = 'hybrid_nsa_shortconv_hmoe'


def rms_norm(x, w):
    xf = x.astype(jnp.float32)
    y = xf * lax.rsqrt(jnp.mean(xf * xf, axis=-1, keepdims=True) + EPS)
    return (y * w.astype(jnp.float32)).astype(x.dtype)


def t5_bucket(dist):
    n = jnp.maximum(dist, 0)
    max_exact = N_BUCKETS // 2
    nf = jnp.maximum(n, 1).astype(jnp.float32)
    large = max_exact + (jnp.log(nf / max_exact) / math.log(MAX_DISTANCE / max_exact)
                         * (N_BUCKETS - max_exact)).astype(jnp.int32)
    large = jnp.minimum(large, N_BUCKETS - 1)
    return jnp.where(n < max_exact, n, large)


def masked_softmax(logits, mask):
    lf = jnp.where(mask, logits.astype(jnp.float32), -jnp.inf)
    m = jnp.max(lf, axis=-1, keepdims=True)
    m = jnp.where(jnp.isfinite(m), m, 0.0)
    e = jnp.where(mask, jnp.exp(lf - m), 0.0)
    return e / jnp.maximum(jnp.sum(e, axis=-1, keepdims=True), 1e-30)


def compress(kv, pos_emb, w1, w2):
    b, s, g, dh = kv.shape
    nc = (s - CMP_LEN) // CMP_STRIDE + 1
    idx = jnp.arange(nc)[:, None] * CMP_STRIDE + jnp.arange(CMP_LEN)[None, :]
    blocks = kv[:, idx] + pos_emb[None, None, :, None, :]
    blocks = jnp.moveaxis(blocks, 3, 2).reshape(b, nc, g, CMP_LEN * dh)
    return jax.nn.silu(blocks @ w1) @ w2


def nsa_attention(q, gates, k_cmp, v_cmp, k_slc, v_slc, k_win, v_win, rel_bias):
    b, s = q.shape[0], q.shape[1]
    nc = k_cmp.shape[1]
    ns = s // SLC_LEN
    n_sel = min(N_SELECT, ns)
    nqb = s // Q_BLOCK
    scale = HEAD_DIM ** -0.5
    bias_gh = rel_bias.T.reshape(N_KV, HPG, N_BUCKETS)

    c_start = jnp.arange(nc) * CMP_STRIDE
    c_end = c_start + CMP_LEN - 1
    s_start = jnp.arange(ns) * SLC_LEN
    overlap = ((c_start[:, None] <= s_start[None, :] + SLC_LEN - 1)
               & (c_end[:, None] >= s_start[None, :])).astype(jnp.float32)

    ks_blocks = k_slc.reshape(b, ns, SLC_LEN, N_KV, HEAD_DIM).transpose(0, 3, 1, 2, 4)
    vs_blocks = v_slc.reshape(b, ns, SLC_LEN, N_KV, HEAD_DIM).transpose(0, 3, 1, 2, 4)
    pad = ((0, 0), (WINDOW, 0), (0, 0), (0, 0))
    kw_pad = jnp.pad(k_win, pad)
    vw_pad = jnp.pad(v_win, pad)

    q_all = q.reshape(b, nqb, Q_BLOCK, N_KV, HPG, HEAD_DIM).swapaxes(0, 1)
    g_all = gates.reshape(b, nqb, Q_BLOCK, N_KV, HPG, 3).swapaxes(0, 1)
    b_ix = jnp.arange(b)[:, None, None, None]
    g_ix = jnp.arange(N_KV)[None, :, None, None]
    g_ix5 = jnp.arange(N_KV)[None, :, None, None, None]
    h_ix5 = jnp.arange(HPG)[None, None, :, None, None]
    blk = jnp.arange(ns)

    def block_fn(args):
        j, qb, gb = args
        s0 = j * Q_BLOCK
        pos = s0 + jnp.arange(Q_BLOCK)

        dist_c = pos[:, None] - c_end[None, :]
        lc = jnp.einsum('bqghd,bngd->bghqn', qb, k_cmp) * scale + bias_gh[:, :, t5_bucket(dist_c)]
        p_cmp = masked_softmax(lc, dist_c >= 0)
        o_cmp = jnp.einsum('bghqn,bngd->bqghd', p_cmp.astype(v_cmp.dtype), v_cmp)

        imp = jnp.einsum('bghqn,ns->bgqs', p_cmp, overlap)
        cur = pos // SLC_LEN
        valid = blk[None, :] <= cur[:, None]
        forced = (blk[None, :] == 0) | (blk[None, :] == cur[:, None]) | (blk[None, :] == cur[:, None] - 1)
        score = jnp.where(forced, FORCED_SCORE, jnp.where(valid, imp, -1.0))
        top_val, top_idx = lax.top_k(score, n_sel)
        sel_ok = top_val >= 0.0
        ks = ks_blocks[b_ix, g_ix, top_idx].reshape(b, N_KV, Q_BLOCK, n_sel * SLC_LEN, HEAD_DIM)
        vs = vs_blocks[b_ix, g_ix, top_idx].reshape(b, N_KV, Q_BLOCK, n_sel * SLC_LEN, HEAD_DIM)
        kpos = (top_idx[..., None] * SLC_LEN + jnp.arange(SLC_LEN)).reshape(b, N_KV, Q_BLOCK, -1)
        dist_s = pos[None, None, :, None] - kpos
        mask_s = jnp.repeat(sel_ok, SLC_LEN, axis=-1) & (dist_s >= 0)
        ls = (jnp.einsum('bqghd,bgqkd->bghqk', qb, ks) * scale
              + bias_gh[g_ix5, h_ix5, t5_bucket(dist_s)[:, :, None]])
        p_s = masked_softmax(ls, mask_s[:, :, None])
        o_slc = jnp.einsum('bghqk,bgqkd->bqghd', p_s.astype(vs.dtype), vs)

        kw = lax.dynamic_slice_in_dim(kw_pad, s0, WINDOW + Q_BLOCK, axis=1)
        vw = lax.dynamic_slice_in_dim(vw_pad, s0, WINDOW + Q_BLOCK, axis=1)
        kpos_w = s0 - WINDOW + jnp.arange(WINDOW + Q_BLOCK)
        dist_w = pos[:, None] - kpos_w[None, :]
        mask_w = (dist_w >= 0) & (dist_w < WINDOW) & (kpos_w[None, :] >= 0)
        lw = jnp.einsum('bqghd,bkgd->bghqk', qb, kw) * scale + bias_gh[:, :, t5_bucket(dist_w)]
        p_w = masked_softmax(lw, mask_w)
        o_win = jnp.einsum('bghqk,bkgd->bqghd', p_w.astype(vw.dtype), vw)

        out = gb[..., 0:1] * o_cmp + gb[..., 1:2] * o_slc + gb[..., 2:3] * o_win
        return out.reshape(b, Q_BLOCK, D_ATTN)

    outs = lax.map(block_fn, (jnp.arange(nqb), q_all, g_all))
    return outs.swapaxes(0, 1).reshape(b, s, D_ATTN)


def short_conv(u, w):
    return lax.conv_general_dilated(u, w[:, None, :], window_strides=(1,),
                                    padding=[(CONV_WIDTH - 1, 0)],
                                    dimension_numbers=('NWC', 'WIO', 'NWC'),
                                    feature_group_count=u.shape[-1])


def hier_moe(h, w_group, b_group, w_expert, b_expert, w1, w3, w2):
    b, s, d = h.shape
    t = b * s
    xt = h.reshape(t, d)
    g_prob = jax.nn.softmax((xt @ w_group + b_group).astype(jnp.float32), axis=-1)
    g_top_p, g_top = lax.top_k(g_prob, 1)
    e_logits = (xt @ w_expert + b_expert).astype(jnp.float32).reshape(t, N_GROUPS, EXPERTS_PER_GROUP)
    e_in = jnp.take_along_axis(e_logits, g_top[:, :, None], axis=1)[:, 0]
    e_top_p, e_top = lax.top_k(jax.nn.softmax(e_in, axis=-1), TOP_K)
    e_top_p = e_top_p / jnp.sum(e_top_p, axis=-1, keepdims=True)
    weights = (g_top_p * e_top_p).reshape(-1)
    expert_ids = (g_top * EXPERTS_PER_GROUP + e_top).reshape(-1)
    token_ids = jnp.repeat(jnp.arange(t), TOP_K)

    a = t * TOP_K
    order = jnp.argsort(expert_ids)
    e_sorted = expert_ids[order]
    tok_sorted = token_ids[order]
    w_sorted = weights[order]
    counts = jax.ops.segment_sum(jnp.ones((a,), jnp.int32), expert_ids, num_segments=N_EXPERTS)
    padded = (counts + MOE_BLOCK - 1) // MOE_BLOCK * MOE_BLOCK
    start = jnp.cumsum(counts) - counts
    pad_end = jnp.cumsum(padded)
    pad_start = pad_end - padded
    dest = pad_start[e_sorted] + (jnp.arange(a) - start[e_sorted])
    n_blocks = (a + N_EXPERTS * (MOE_BLOCK - 1)) // MOE_BLOCK + 1
    rows = n_blocks * MOE_BLOCK
    x_disp = jnp.zeros((rows, d), xt.dtype).at[dest].set(xt[tok_sorted])
    blk_expert = jnp.minimum(jnp.searchsorted(pad_end, jnp.arange(n_blocks) * MOE_BLOCK, side='right'),
                             N_EXPERTS - 1)

    def expert_block(args):
        xb, e = args
        return (jax.nn.silu(xb @ w1[e]) * (xb @ w3[e])) @ w2[e]

    y_disp = lax.map(expert_block, (x_disp.reshape(n_blocks, MOE_BLOCK, d), blk_expert)).reshape(rows, d)
    y = jax.ops.segment_sum(y_disp[dest] * w_sorted[:, None].astype(y_disp.dtype), tok_sorted,
                            num_segments=t)
    return y.reshape(b, s, d)


def setup_inputs(seed: int = 0) -> dict:
    key = jax.random.key(seed)
    ks = jax.random.split(key, 26)
    f32 = jnp.float32

    def nrm(k, shape, scale):
        return jax.random.normal(k, shape, f32) * scale

    def gain(k, shape):
        return 1.0 + 0.02 * jax.random.normal(k, shape, f32)

    L = DEPTH
    return {
        'x': nrm(ks[0], (BATCH, SEQ, D_MODEL), 1.0),
        'c': nrm(ks[1], (BATCH, D_MODEL), 1.0),
        'w_ada': nrm(ks[2], (L, D_MODEL, 6 * D_MODEL), 0.5 * D_MODEL ** -0.5),
        'b_ada': nrm(ks[3], (L, 6 * D_MODEL), 0.01),
        'norm1_w': gain(ks[4], (L, D_MODEL)),
        'w_in': nrm(ks[5], (L, D_MODEL, N_IN), D_MODEL ** -0.5),
        'q_norm_w': gain(ks[6], (L, HEAD_DIM)),
        'k_norm_w': gain(ks[7], (L, 3, HEAD_DIM)),
        'cmp_pos_k': nrm(ks[8], (L, CMP_LEN, HEAD_DIM), 0.1),
        'cmp_pos_v': nrm(ks[9], (L, CMP_LEN, HEAD_DIM), 0.1),
        'cmp_k_w1': nrm(ks[10], (L, CMP_LEN * HEAD_DIM, CMP_HIDDEN), (CMP_LEN * HEAD_DIM) ** -0.5),
        'cmp_k_w2': nrm(ks[11], (L, CMP_HIDDEN, HEAD_DIM), CMP_HIDDEN ** -0.5),
        'cmp_v_w1': nrm(ks[12], (L, CMP_LEN * HEAD_DIM, CMP_HIDDEN), (CMP_LEN * HEAD_DIM) ** -0.5),
        'cmp_v_w2': nrm(ks[13], (L, CMP_HIDDEN, HEAD_DIM), CMP_HIDDEN ** -0.5),
        'conv_w': nrm(ks[14], (L, CONV_WIDTH, D_CONV), CONV_WIDTH ** -0.5),
        'out_norm_w': gain(ks[15], (L, D_MIX)),
        'w_out': nrm(ks[16], (L, D_MIX, D_MODEL), D_MIX ** -0.5),
        'rel_bias': nrm(ks[17], (N_BUCKETS, N_HEADS), 0.5),
        'norm2_w': gain(ks[18], (L, D_MODEL)),
        'w_group': nrm(ks[19], (L, D_MODEL, N_GROUPS), D_MODEL ** -0.5),
        'b_group': nrm(ks[20], (L, N_GROUPS), 0.01),
        'w_expert': nrm(ks[21], (L, D_MODEL, N_EXPERTS), D_MODEL ** -0.5),
        'b_expert': nrm(ks[22], (L, N_EXPERTS), 0.01),
        'w1': nrm(ks[23], (L, N_EXPERTS, D_MODEL, D_EXPERT), D_MODEL ** -0.5),
        'w3': nrm(ks[24], (L, N_EXPERTS, D_MODEL, D_EXPERT), D_MODEL ** -0.5),
        'w2': nrm(ks[25], (L, N_EXPERTS, D_EXPERT, D_MODEL), D_EXPERT ** -0.5),
    }


def reference(x, c, w_ada, b_ada, norm1_w, w_in, q_norm_w, k_norm_w, cmp_pos_k, cmp_pos_v,
              cmp_k_w1, cmp_k_w2, cmp_v_w1, cmp_v_w2, conv_w, out_norm_w, w_out, rel_bias,
              norm2_w, w_group, b_group, w_expert, b_expert, w1, w3, w2):
    b, s, _ = x.shape
    cond = jax.nn.silu(c)
    splits = [D_ATTN, D_ATTN + 6 * KV_DIM, D_ATTN + 6 * KV_DIM + 3 * N_HEADS,
              D_ATTN + 6 * KV_DIM + 3 * N_HEADS + D_CONV,
              D_ATTN + 6 * KV_DIM + 3 * N_HEADS + 2 * D_CONV]
    for l in range(DEPTH):
        mod = cond @ w_ada[l] + b_ada[l]
        sh1, sc1, g1, sh2, sc2, g2 = jnp.split(mod[:, None, :], 6, axis=-1)

        h = rms_norm(x, norm1_w[l]) * (1 + sc1) + sh1
        proj = h @ w_in[l]
        q, kvs, gate_logits, b_gate, c_gate, u = jnp.split(proj, splits, axis=-1)
        q = rms_norm(q.reshape(b, s, N_HEADS, HEAD_DIM), q_norm_w[l])
        kv = kvs.reshape(b, s, 6, N_KV, HEAD_DIM)
        k_c = rms_norm(compress(kv[:, :, 0], cmp_pos_k[l], cmp_k_w1[l], cmp_k_w2[l]), k_norm_w[l, 0])
        v_c = compress(kv[:, :, 1], cmp_pos_v[l], cmp_v_w1[l], cmp_v_w2[l])
        k_s = rms_norm(kv[:, :, 2], k_norm_w[l, 1])
        k_w = rms_norm(kv[:, :, 4], k_norm_w[l, 2])
        gates = jax.nn.sigmoid(gate_logits.reshape(b, s, N_HEADS, 3))
        o_attn = nsa_attention(q, gates, k_c, v_c, k_s, kv[:, :, 3], k_w, kv[:, :, 5], rel_bias)
        y_conv = b_gate * short_conv(c_gate * u, conv_w[l])
        mix = jnp.concatenate([o_attn, y_conv], axis=-1).reshape(b, s, N_MIX_GROUPS, HEAD_DIM)
        mix = rms_norm(mix, out_norm_w[l].reshape(N_MIX_GROUPS, HEAD_DIM)).reshape(b, s, D_MIX)
        x = x + g1 * (mix @ w_out[l])

        h2 = rms_norm(x, norm2_w[l]) * (1 + sc2) + sh2
        x = x + g2 * hier_moe(h2, w_group[l], b_group[l], w_expert[l], b_expert[l], w1[l], w3[l], w2[l])
    return x
```

```cpp
#include <hip/hip_runtime.h>
#include <stdint.h>
#include <stdio.h>

#ifndef NAIVE_GEMM
#define NAIVE_GEMM 0
#endif

typedef unsigned short bf16;
typedef short bf16x8 __attribute__((ext_vector_type(8)));
typedef float f32x4 __attribute__((ext_vector_type(4)));
typedef unsigned u32x4 __attribute__((ext_vector_type(4)));
typedef unsigned u32x2 __attribute__((ext_vector_type(2)));

constexpr int BATCH = 2, SEQ = 16384, DM = 1024, T = BATCH * SEQ;
constexpr int NIN = 2840, NINP = 3072;
constexpr int NC = 1023, NCP = 1024, NS = 256;
constexpr int NEXP = 64;
constexpr float EPS = 1e-6f;

constexpr size_t MiB = 1u << 20;
constexpr size_t WS_CTL = 0;
constexpr size_t WS_MOD = 1 * MiB;
constexpr size_t WS_POSB = 1 * MiB + 65536;
constexpr size_t WS_WIN_T = 2 * MiB;
constexpr size_t WS_WOUT_T = 8 * MiB;
constexpr size_t WS_CW1_T = 10 * MiB;
constexpr size_t WS_WR_T = 12 * MiB;
constexpr size_t WS_HID = 13 * MiB;
constexpr size_t WS_KCVC = 21 * MiB;
constexpr size_t WS_GATES = 22 * MiB;
constexpr size_t WS_LOGITS = 25 * MiB;
constexpr size_t WS_LISTS = 41 * MiB;
constexpr size_t WS_ROWW = 57 * MiB;
constexpr size_t WS_XN = 73 * MiB;
constexpr size_t WS_R1 = 137 * MiB;
constexpr size_t WS_W13_T = WS_R1;
constexpr size_t WS_W2_T = WS_R1 + 128 * MiB;
constexpr size_t WS_Q = 329 * MiB;
constexpr size_t WS_KV = 361 * MiB;
constexpr size_t WS_H = 329 * MiB;
constexpr size_t WS_MIX = 410 * MiB;
constexpr size_t WS_END = 474 * MiB;

constexpr int CW_CNT = 0;

struct P {
    const float* in[26];
    float* out;
    unsigned char* ws;
};

__device__ __forceinline__ unsigned f2bf(float f) { unsigned u = __builtin_bit_cast(unsigned, f); return (u + 0x7fffu + ((u >> 16) & 1u)) >> 16; }
__device__ __forceinline__ unsigned pk2(float lo, float hi) { return f2bf(lo) | (f2bf(hi) << 16); }
__device__ __forceinline__ float bf2f(unsigned short h) { return __builtin_bit_cast(float, (unsigned)h << 16); }
__device__ __forceinline__ float bflo(unsigned u) { return __builtin_bit_cast(float, u << 16); }
__device__ __forceinline__ float bfhi(unsigned u) { return __builtin_bit_cast(float, u & 0xffff0000u); }
__device__ __forceinline__ float wave_sum(float v) {
#pragma unroll
    for (int o = 1; o < 64; o <<= 1) v += __shfl_xor(v, o);
    return v;
}
__device__ __forceinline__ float silu_f(float v) { return v / (1.f + __expf(-v)); }
#define LDS_FENCE() asm volatile("s_waitcnt lgkmcnt(0)" ::: "memory")

template <class AR, class BR, class EPI>
__device__ __forceinline__ void wave_gemm_64x64(AR arow, BR brow, int K, EPI epi) {
    const int lane = threadIdx.x & 63, fr = lane & 15, fq = lane >> 4;
#if !NAIVE_GEMM
    const bf16* ap[4]; const bf16* bp[4];
#pragma unroll
    for (int i = 0; i < 4; ++i) { ap[i] = arow(16 * i + fr) + fq * 8; bp[i] = brow(16 * i + fr) + fq * 8; }
    f32x4 acc[4][4];
#pragma unroll
    for (int i = 0; i < 4; ++i)
#pragma unroll
        for (int j = 0; j < 4; ++j) acc[i][j] = (f32x4){0.f, 0.f, 0.f, 0.f};
#pragma unroll 1
    for (int k = 0; k < K; k += 64) {
        bf16x8 a[4][2], b[4][2];
#pragma unroll
        for (int i = 0; i < 4; ++i) {
            a[i][0] = *(const bf16x8*)(ap[i] + k); a[i][1] = *(const bf16x8*)(ap[i] + k + 32);
            b[i][0] = *(const bf16x8*)(bp[i] + k); b[i][1] = *(const bf16x8*)(bp[i] + k + 32);
        }
#pragma unroll
        for (int kk = 0; kk < 2; ++kk)
#pragma unroll
            for (int i = 0; i < 4; ++i)
#pragma unroll
                for (int j = 0; j < 4; ++j) acc[i][j] = __builtin_amdgcn_mfma_f32_16x16x32_bf16(b[j][kk], a[i][kk], acc[i][j], 0, 0, 0);
    }
#pragma unroll
    for (int i = 0; i < 4; ++i)
#pragma unroll
        for (int j = 0; j < 4; ++j) { epi(16 * i + fr, 16 * j + 4 * fq, acc[i][j]); asm volatile("" ::: "memory"); }
#else
    for (int i = 0; i < 4; ++i) {
        const bf16* ar = arow(16 * i + fr);
        for (int j = 0; j < 4; ++j) {
            f32x4 acc = (f32x4){0.f, 0.f, 0.f, 0.f};
#pragma unroll
            for (int r = 0; r < 4; ++r) {
                const bf16* br = brow(16 * j + 4 * fq + r);
                float s = 0.f;
                for (int k = 0; k < K; k += 8) {
                    u32x4 av = *(const u32x4*)(ar + k), bv = *(const u32x4*)(br + k);
#pragma unroll
                    for (int q = 0; q < 4; ++q) { s += bflo(av[q]) * bflo(bv[q]); s += bfhi(av[q]) * bfhi(bv[q]); }
                }
                acc[r] = s;
            }
            epi(16 * i + fr, 16 * j + 4 * fq, acc);
        }
    }
#endif
}

__device__ __forceinline__ void transpose_item(const float* W, int K, int N, bf16* WT, int rmul, int radd, float* scr, int item, int lane) {
    const int nblk = (N + 31) / 32, kb = item / nblk, nb = item % nblk, k0 = 64 * kb, n0 = 32 * nb;
    const int ncol = n0 + (lane & 31);
#pragma unroll 8
    for (int i = 0; i < 32; ++i) { const int kk = 2 * i + (lane >> 5); scr[kk * 33 + (lane & 31)] = ncol < N ? W[(size_t)(k0 + kk) * N + ncol] : 0.f; }
    LDS_FENCE();
    const int c = lane & 7;
#pragma unroll
    for (int j = 0; j < 4; ++j) { const int n = (lane >> 3) + 8 * j; const float* s = scr + (8 * c) * 33 + n;
        u32x4 o; o.x = pk2(s[0 * 33], s[1 * 33]); o.y = pk2(s[2 * 33], s[3 * 33]); o.z = pk2(s[4 * 33], s[5 * 33]); o.w = pk2(s[6 * 33], s[7 * 33]);
        *(u32x4*)(WT + (size_t)(radd + rmul * (n0 + n)) * K + k0 + 8 * c) = o; }
    LDS_FENCE();
}


__device__ void ph_mod(const P& p, int blk, int nblk, float* shb) {
    const float* c = p.in[1]; const float* w_ada = p.in[2]; const float* b_ada = p.in[3];
    float* mod = (float*)(p.ws + WS_MOD);
    const int tid = threadIdx.x, wave = tid >> 6, lane = tid & 63, nw = blockDim.x >> 6;
    for (int task = blk; task < 96; task += nblk) {
        const int col = task * 64 + lane;
        float a0 = 0.f, a1 = 0.f;
        const int kper = 1024 / nw;
        for (int k = wave * kper; k < (wave + 1) * kper; ++k) {
            const float w = w_ada[(size_t)k * 6144 + col];
            a0 += silu_f(c[k]) * w; a1 += silu_f(c[1024 + k]) * w;
        }
        shb[(wave * 2 + 0) * 64 + lane] = a0; shb[(wave * 2 + 1) * 64 + lane] = a1;
        __syncthreads();
        if (wave < 2) { float s = 0.f; for (int w = 0; w < nw; ++w) s += shb[(w * 2 + wave) * 64 + lane]; mod[wave * 6144 + col] = s + b_ada[col]; }
        __syncthreads();
    }
    float* posb = (float*)(p.ws + WS_POSB);
    for (int task = blk; task < 8; task += nblk) {
        const int kv = task >> 2, col = (task & 3) * 64 + lane;
        const float* pos = p.in[8 + kv]; const float* w1 = p.in[kv == 0 ? 10 : 12];
        float a = 0.f; const int kper = 2048 / nw;
        for (int k = wave * kper; k < (wave + 1) * kper; ++k) a += pos[k] * w1[(size_t)k * 256 + col];
        shb[wave * 64 + lane] = a;
        __syncthreads();
        if (wave == 0) { float s = 0.f; for (int w = 0; w < nw; ++w) s += shb[w * 64 + lane]; posb[kv * 256 + col] = s; }
        __syncthreads();
    }
}

__device__ void ph_wprep_a(const P& p, int gw, int ngw, float* scr) {
    const int lane = threadIdx.x & 63;
    bf16* WIN_T = (bf16*)(p.ws + WS_WIN_T); bf16* WOUT_T = (bf16*)(p.ws + WS_WOUT_T); bf16* CW1_T = (bf16*)(p.ws + WS_CW1_T); bf16* WR_T = (bf16*)(p.ws + WS_WR_T);
    constexpr int I_IN = (1024 / 64) * 89, I_OUT = 16 * 32, I_C = (2048 / 64) * 8;
    for (int it = gw; it < I_IN + I_OUT + 2 * I_C; it += ngw) {
        int r = it;
        if (r < I_IN) { transpose_item(p.in[5], 1024, NIN, WIN_T, 1, 0, scr, r, lane); continue; } r -= I_IN;
        if (r < I_OUT) { transpose_item(p.in[16], 1024, 1024, WOUT_T, 1, 0, scr, r, lane); continue; } r -= I_OUT;
        if (r < I_C) { transpose_item(p.in[10], 2048, 256, CW1_T, 1, 0, scr, r, lane); continue; } r -= I_C;
        transpose_item(p.in[12], 2048, 256, CW1_T + 256 * 2048, 1, 0, scr, r, lane);
    }
    for (int i = gw * 64 + lane; i < 224 * 1024 / 8; i += ngw * 64) *(u32x4*)(WIN_T + (size_t)2848 * 1024 + (size_t)i * 8) = (u32x4){0u, 0u, 0u, 0u};
    for (int i = gw * 64 + lane; i < 128 * 1024; i += ngw * 64) {
        const int n = i >> 10, k = i & 1023; float v = 0.f;
        if (n < 8) v = p.in[19][k * 8 + n]; else if (n < 72) v = p.in[21][k * 64 + (n - 8)];
        WR_T[i] = (bf16)f2bf(v);
    }
}
__device__ void ph_wprep_moe(const P& p, int gw, int ngw, float* scr) {
    const int lane = threadIdx.x & 63;
    bf16* W13 = (bf16*)(p.ws + WS_W13_T); bf16* W2T = (bf16*)(p.ws + WS_W2_T);
    constexpr int I_13 = (1024 / 64) * (512 / 32), I_2 = (512 / 64) * (1024 / 32);
    for (int it = gw; it < NEXP * (2 * I_13 + I_2); it += ngw) {
        const int e = it / (2 * I_13 + I_2); int r = it % (2 * I_13 + I_2);
        if (r < I_13) { transpose_item(p.in[23] + (size_t)e * 1024 * 512, 1024, 512, W13 + (size_t)e * 1024 * 1024, 2, 0, scr, r, lane); continue; } r -= I_13;
        if (r < I_13) { transpose_item(p.in[24] + (size_t)e * 1024 * 512, 1024, 512, W13 + (size_t)e * 1024 * 1024, 2, 1, scr, r, lane); continue; } r -= I_13;
        transpose_item(p.in[25] + (size_t)e * 512 * 1024, 512, 1024, W2T + (size_t)e * 1024 * 512, 1, 0, scr, r, lane);
    }
}

__device__ void ph_rownorm(const P& p, int gw, int ngw, const float* src, int which) {
    const int lane = threadIdx.x & 63;
    const float* nw = p.in[which == 0 ? 4 : 18];
    const float* mod = (const float*)(p.ws + WS_MOD);
    bf16* XN = (bf16*)(p.ws + WS_XN);
    f32x4 wv[4];
#pragma unroll
    for (int j = 0; j < 4; ++j) wv[j] = *(const f32x4*)(nw + 4 * lane + 256 * j);
    for (int row = gw; row < T; row += ngw) {
        const int b = row / SEQ;
        const float* sh = mod + b * 6144 + (which == 0 ? 0 : 3072); const float* sc = sh + 1024;
        const f32x4* xr = (const f32x4*)(src + (size_t)row * DM) + lane;
        f32x4 v[4]; float s = 0.f;
#pragma unroll
        for (int j = 0; j < 4; ++j) { v[j] = xr[64 * j]; s += v[j].x * v[j].x + v[j].y * v[j].y + v[j].z * v[j].z + v[j].w * v[j].w; }
        const float rstd = rsqrtf(wave_sum(s) * (1.f / DM) + EPS);
        unsigned long long* o8 = (unsigned long long*)(XN + (size_t)row * DM) + lane;
#pragma unroll
        for (int j = 0; j < 4; ++j) {
            const f32x4 scv = *(const f32x4*)(sc + 4 * lane + 256 * j), shv = *(const f32x4*)(sh + 4 * lane + 256 * j);
            const f32x4 h = v[j] * rstd * wv[j] * (scv + 1.f) + shv;
            o8[64 * j] = (unsigned long long)pk2(h.x, h.y) | ((unsigned long long)pk2(h.z, h.w) << 32);
        }
    }
}

__device__ void ph_gemm_in(const P& p, int gw, int ngw) {
    const bf16* XN = (const bf16*)(p.ws + WS_XN); const bf16* WT = (const bf16*)(p.ws + WS_WIN_T); bf16* RAW = (bf16*)(p.ws + WS_R1);
    constexpr int TN = NINP / 64, TM = T / 64;
    for (int tile = gw; tile < TM * TN; tile += ngw) {
        const int tm = tile / TN, tn = tile % TN;
        wave_gemm_64x64([&](int i) { return XN + (size_t)(tm * 64 + i) * DM; }, [&](int j) { return WT + (size_t)(tn * 64 + j) * DM; }, DM,
            [&](int i, int j0, f32x4 v) { u32x2 o; o.x = pk2(v.x, v.y); o.y = pk2(v.z, v.w); *(u32x2*)(RAW + (size_t)(tm * 64 + i) * NINP + tn * 64 + j0) = o; });
    }
}

__device__ void ph_post(const P& p, int gw, int ngw) {
    const int lane = threadIdx.x & 63;
    const bf16* RAW = (const bf16*)(p.ws + WS_R1);
    bf16* Q = (bf16*)(p.ws + WS_Q); bf16* KV = (bf16*)(p.ws + WS_KV); float* GATES = (float*)(p.ws + WS_GATES); bf16* MIX = (bf16*)(p.ws + WS_MIX);
    const float qw = p.in[6][lane], kw1 = p.in[7][64 + lane], kw2 = p.in[7][128 + lane];
    const float* conv_w = p.in[14]; const float* onw = p.in[15];
    for (int t = gw; t < T; t += ngw) {
        const int b = t / SEQ, s = t % SEQ;
        const bf16* r = RAW + (size_t)t * NINP;
#pragma unroll
        for (int h = 0; h < 8; ++h) {
            const float v = bf2f(r[h * 64 + lane]);
            const float rs = rsqrtf(wave_sum(v * v) * (1.f / 64.f) + EPS);
            Q[((size_t)t * 8 + h) * 64 + lane] = (bf16)f2bf(v * rs * qw);
        }
#pragma unroll
        for (int i = 0; i < 6; ++i)
#pragma unroll
            for (int g = 0; g < 2; ++g) {
                float v = bf2f(r[512 + i * 128 + g * 64 + lane]);
                if (i == 2 || i == 4) { const float rs = rsqrtf(wave_sum(v * v) * (1.f / 64.f) + EPS); v = v * rs * (i == 2 ? kw1 : kw2); }
                KV[((((size_t)i * 2 + b) * 2 + g) * SEQ + s) * 64 + lane] = (bf16)f2bf(v);
            }
        if (lane < 24) GATES[(size_t)t * 24 + lane] = 1.f / (1.f + __expf(-bf2f(r[1280 + lane])));
#pragma unroll
        for (int j = 0; j < 8; ++j) {
            const int c = j * 64 + lane;
            float acc = 0.f;
#pragma unroll
            for (int d = 0; d < 3; ++d) {
                const int sd = s - 2 + d;
                if (sd >= 0) { const bf16* rr = RAW + (size_t)(t - 2 + d) * NINP; acc += conv_w[d * 512 + c] * bf2f(rr[1816 + c]) * bf2f(rr[2328 + c]); }
            }
            const float y = bf2f(r[1304 + c]) * acc;
            const float rs = rsqrtf(wave_sum(y * y) * (1.f / 64.f) + EPS);
            MIX[(size_t)t * DM + 512 + c] = (bf16)f2bf(y * rs * onw[512 + c]);
        }
    }
}

__device__ void ph_cmp_gemm(const P& p, int gw, int ngw) {
    const bf16* KV = (const bf16*)(p.ws + WS_KV); const bf16* CW1 = (const bf16*)(p.ws + WS_CW1_T); float* HID = (float*)(p.ws + WS_HID); const float* posb = (const float*)(p.ws + WS_POSB);
    for (int tile = gw; tile < 2 * 64 * 4; tile += ngw) {
        const int kv = tile / 256, tm = (tile % 256) / 4, tn = tile % 4;
        wave_gemm_64x64(
            [&](int i) { const int row = tm * 64 + i, bg = row >> 10, n = row & 1023; return KV + (((size_t)kv * 4 + bg) * SEQ + 16 * n) * 64; },
            [&](int j) { return CW1 + ((size_t)kv * 256 + tn * 64 + j) * 2048; }, 2048,
            [&](int i, int j0, f32x4 v) { const int row = tm * 64 + i; const f32x4 pb = *(const f32x4*)(posb + kv * 256 + tn * 64 + j0);
                f32x4 o; o.x = silu_f(v.x + pb.x); o.y = silu_f(v.y + pb.y); o.z = silu_f(v.z + pb.z); o.w = silu_f(v.w + pb.w);
                *(f32x4*)(HID + ((size_t)kv * 4096 + row) * 256 + tn * 64 + j0) = o; });
    }
}
__device__ void ph_cmp_fin(const P& p, int gw, int ngw) {
    const int lane = threadIdx.x & 63;
    const float* HID = (const float*)(p.ws + WS_HID); bf16* KCVC = (bf16*)(p.ws + WS_KCVC);
    const float kw0 = p.in[7][lane];
    for (int r = gw; r < 2 * 4096; r += ngw) {
        const int kv = r / 4096, row = r % 4096, n = row & 1023;
        float o = 0.f;
        if (n < NC) {
            const float* w2 = p.in[kv == 0 ? 11 : 13]; const float* h = HID + (size_t)r * 256;
            for (int j = 0; j < 256; ++j) o += h[j] * w2[j * 64 + lane];
            if (kv == 0) { const float rs = rsqrtf(wave_sum(o * o) * (1.f / 64.f) + EPS); o = o * rs * kw0; }
        }
        KCVC[(size_t)r * 64 + lane] = (bf16)f2bf(o);
    }
}

struct AttnLds { float qs[4][64]; float ps[64][4]; float imp[256]; };
__device__ __forceinline__ void attn_qk(const bf16* krow, const float (*qs)[64], float s[4]) {
    s[0] = s[1] = s[2] = s[3] = 0.f;
#pragma unroll 2
    for (int c = 0; c < 8; ++c) {
        asm volatile("" ::: "memory");
        const u32x4 kvv = *(const u32x4*)(krow + 8 * c);
        float kf[8]; kf[0] = bflo(kvv.x); kf[1] = bfhi(kvv.x); kf[2] = bflo(kvv.y); kf[3] = bfhi(kvv.y); kf[4] = bflo(kvv.z); kf[5] = bfhi(kvv.z); kf[6] = bflo(kvv.w); kf[7] = bfhi(kvv.w);
#pragma unroll
        for (int h = 0; h < 4; ++h) {
            const f32x4 q0 = *(const f32x4*)(&qs[h][8 * c]), q1 = *(const f32x4*)(&qs[h][8 * c + 4]);
            s[h] += kf[0] * q0.x + kf[1] * q0.y + kf[2] * q0.z + kf[3] * q0.w + kf[4] * q1.x + kf[5] * q1.y + kf[6] * q1.z + kf[7] * q1.w;
        }
    }
}
__device__ __forceinline__ void attn_pv(const bf16* vbase, const float (*ps)[4], int lane, float o[4]) {
    for (int j = 0; j < 64; ++j) {
        const f32x4 pj = *(const f32x4*)(&ps[j][0]);
        const float v = bf2f(vbase[(size_t)j * 64 + lane]);
        o[0] += pj.x * v; o[1] += pj.y * v; o[2] += pj.z * v; o[3] += pj.w * v;
    }
}
__device__ void ph_attn_naive(const P& p, int gw, int ngw, AttnLds* L, const float* biasT  ) {
    const int lane = threadIdx.x & 63;
    const bf16* Q = (const bf16*)(p.ws + WS_Q); const bf16* KV = (const bf16*)(p.ws + WS_KV); const bf16* KCVC = (const bf16*)(p.ws + WS_KCVC);
    const float* GATES = (const float*)(p.ws + WS_GATES); bf16* MIX = (bf16*)(p.ws + WS_MIX); const float* onw = p.in[15];
    for (int item = gw; item < T * 2; item += ngw) {
        const int t = item >> 1, g = item & 1, b = t / SEQ, pos = t % SEQ, cur = pos >> 6;
#pragma unroll
        for (int h = 0; h < 4; ++h) L->qs[h][lane] = bf2f(Q[((size_t)t * 8 + 4 * g + h) * 64 + lane]) * 0.125f;
        for (int i = lane; i < 256; i += 64) L->imp[i] = 0.f;
        LDS_FENCE();
        const bf16* KC = KCVC + ((size_t)(0 * 4 + b * 2 + g) * NCP) * 64; const bf16* VC = KCVC + ((size_t)(1 * 4 + b * 2 + g) * NCP) * 64;
        auto kvp = [&](int i) { return KV + (((size_t)i * 2 + b) * 2 + g) * SEQ * 64; };
        const int nvis = pos >= 31 ? min((pos - 31) / 16 + 1, NC) : 0;
        float lc[4] = {0.f, 0.f, 0.f, 0.f}, oc[4] = {0.f, 0.f, 0.f, 0.f};
        for (int kb = 0; kb * 64 < nvis; ++kb) {
            const int n = kb * 64 + lane; float s[4]; attn_qk(KC + (size_t)n * 64, L->qs, s);
            const int dist = pos - (16 * n + 31); const bool valid = n < nvis; const int bi = min(max(dist, 0), 128);
#pragma unroll
            for (int h = 0; h < 4; ++h) lc[h] += valid ? __expf(s[h] + biasT[bi * 8 + 4 * g + h]) : 0.f;
        }
        float rlc[4];
#pragma unroll
        for (int h = 0; h < 4; ++h) { lc[h] = wave_sum(lc[h]); rlc[h] = lc[h] > 0.f ? 1.f / lc[h] : 0.f; }
        for (int kb = 0; kb * 64 < nvis; ++kb) {
            const int n = kb * 64 + lane; float s[4]; attn_qk(KC + (size_t)n * 64, L->qs, s);
            const int dist = pos - (16 * n + 31); const bool valid = n < nvis; const int bi = min(max(dist, 0), 128);
            float w = 0.f; float pe[4];
#pragma unroll
            for (int h = 0; h < 4; ++h) { pe[h] = valid ? __expf(s[h] + biasT[bi * 8 + 4 * g + h]) : 0.f; w += pe[h] * rlc[h]; }
            LDS_FENCE();
            *(f32x4*)(&L->ps[lane][0]) = (f32x4){pe[0], pe[1], pe[2], pe[3]};
            if (valid) { atomicAdd(&L->imp[n >> 2], w); if ((n & 3) == 3 && (n >> 2) + 1 < NS) atomicAdd(&L->imp[(n >> 2) + 1], w); }
            LDS_FENCE();
            attn_pv(VC + (size_t)kb * 64 * 64, L->ps, lane, oc);
        }
        LDS_FENCE();
        float sc[4];
#pragma unroll
        for (int j = 0; j < 4; ++j) { const int s = lane * 4 + j; const bool forced = (s == 0) || (s == cur) || (s == cur - 1);
            sc[j] = forced ? 1e4f : (s <= cur ? L->imp[s] : -1.f); }
        float ls[4] = {0.f, 0.f, 0.f, 0.f}, os[4] = {0.f, 0.f, 0.f, 0.f};
        for (int r = 0; r < 16; ++r) {
            float bv = sc[0]; int bi_ = lane * 4;
#pragma unroll
            for (int j = 1; j < 4; ++j) if (sc[j] > bv) { bv = sc[j]; bi_ = lane * 4 + j; }
#pragma unroll
            for (int o = 1; o < 64; o <<= 1) { const float ov = __shfl_xor(bv, o); const int oi = __shfl_xor(bi_, o); if (ov > bv || (ov == bv && oi < bi_)) { bv = ov; bi_ = oi; } }
            if (!(bv >= 0.f)) break;
            if ((bi_ >> 2) == lane) {
#pragma unroll
                for (int j = 0; j < 4; ++j) if ((bi_ & 3) == j) sc[j] = -3.0e38f;
            }
            const int kpos = bi_ * 64 + lane; float s[4]; attn_qk(kvp(2) + (size_t)kpos * 64, L->qs, s);
            const int dist = pos - kpos; const bool valid = dist >= 0; const int bx = min(max(dist, 0), 128);
            float pe[4];
#pragma unroll
            for (int h = 0; h < 4; ++h) { pe[h] = valid ? __expf(s[h] + biasT[bx * 8 + 4 * g + h]) : 0.f; ls[h] += pe[h]; }
            LDS_FENCE();
            *(f32x4*)(&L->ps[lane][0]) = (f32x4){pe[0], pe[1], pe[2], pe[3]};
            LDS_FENCE();
            attn_pv(kvp(3) + (size_t)bi_ * 64 * 64, L->ps, lane, os);
        }
        float lw[4] = {0.f, 0.f, 0.f, 0.f}, ow[4] = {0.f, 0.f, 0.f, 0.f};
        const int kstart = max(0, pos - 511);
        for (int blk = kstart >> 6; blk <= cur; ++blk) {
            const int kpos = blk * 64 + lane; float s[4]; attn_qk(kvp(4) + (size_t)kpos * 64, L->qs, s);
            const int dist = pos - kpos; const bool valid = dist >= 0 && kpos >= kstart; const int bx = min(max(dist, 0), 128);
            float pe[4];
#pragma unroll
            for (int h = 0; h < 4; ++h) { pe[h] = valid ? __expf(s[h] + biasT[bx * 8 + 4 * g + h]) : 0.f; lw[h] += pe[h]; }
            LDS_FENCE();
            *(f32x4*)(&L->ps[lane][0]) = (f32x4){pe[0], pe[1], pe[2], pe[3]};
            LDS_FENCE();
            attn_pv(kvp(5) + (size_t)blk * 64 * 64, L->ps, lane, ow);
        }
        LDS_FENCE();
#pragma unroll
        for (int h = 0; h < 4; ++h) {
            const float l_s = wave_sum(ls[h]), l_w = wave_sum(lw[h]);
            const float* gt = GATES + (size_t)t * 24 + (4 * g + h) * 3;
            const float o = gt[0] * oc[h] * rlc[h] + gt[1] * os[h] * (l_s > 0.f ? 1.f / l_s : 0.f) + gt[2] * ow[h] * (l_w > 0.f ? 1.f / l_w : 0.f);
            const float rs = rsqrtf(wave_sum(o * o) * (1.f / 64.f) + EPS);
            const int c = (4 * g + h) * 64 + lane;
            MIX[(size_t)t * DM + c] = (bf16)f2bf(o * rs * onw[c]);
        }
    }
}
__device__ void build_bias_table(const P& p, float* biasT) {
    for (int i = threadIdx.x; i < 129 * 8; i += blockDim.x) {
        const int d = i >> 3, h = i & 7; int bk;
        if (d < 16) bk = d; else { bk = 16 + (int)(logf((float)d / 16.f) / logf(8.f) * 16.f); bk = min(bk, 31); }
        biasT[i] = p.in[17][bk * 8 + h];
    }
    __syncthreads();
}

__device__ void ph_gemm_out(const P& p, int gw, int ngw) {
    const bf16* MIX = (const bf16*)(p.ws + WS_MIX); const bf16* WT = (const bf16*)(p.ws + WS_WOUT_T); const float* mod = (const float*)(p.ws + WS_MOD);
    const float* x = p.in[0]; float* out = p.out;
    constexpr int TN = DM / 64, TM = T / 64;
    for (int tile = gw; tile < TM * TN; tile += ngw) {
        const int tm = tile / TN, tn = tile % TN;
        wave_gemm_64x64([&](int i) { return MIX + (size_t)(tm * 64 + i) * DM; }, [&](int j) { return WT + (size_t)(tn * 64 + j) * DM; }, DM,
            [&](int i, int j0, f32x4 v) { const int row = tm * 64 + i, col = tn * 64 + j0, b = row / SEQ;
                const f32x4 g1 = *(const f32x4*)(mod + b * 6144 + 2048 + col); const f32x4 xv = *(const f32x4*)(x + (size_t)row * DM + col);
                *(f32x4*)(out + (size_t)row * DM + col) = xv + g1 * v; });
    }
}
__device__ void ph_gemm_router(const P& p, int gw, int ngw) {
    const bf16* XN = (const bf16*)(p.ws + WS_XN); const bf16* WT = (const bf16*)(p.ws + WS_WR_T); float* LG = (float*)(p.ws + WS_LOGITS);
    for (int tile = gw; tile < (T / 64) * 2; tile += ngw) {
        const int tm = tile >> 1, tn = tile & 1;
        wave_gemm_64x64([&](int i) { return XN + (size_t)(tm * 64 + i) * DM; }, [&](int j) { return WT + (size_t)(tn * 64 + j) * DM; }, DM,
            [&](int i, int j0, f32x4 v) { *(f32x4*)(LG + (size_t)(tm * 64 + i) * 128 + tn * 64 + j0) = v; });
    }
}
__device__ void ph_route(const P& p, int gtid, int nthreads) {
    const float* LG = (const float*)(p.ws + WS_LOGITS); unsigned* cnt = (unsigned*)(p.ws + WS_CTL) + CW_CNT;
    int* LISTS = (int*)(p.ws + WS_LISTS); float* ROWW = (float*)(p.ws + WS_ROWW);
    const float* bg = p.in[20]; const float* be = p.in[22];
    for (int t = gtid; t < T; t += nthreads) {
        const float* l = LG + (size_t)t * 128;
        float gl[8]; float gm = -3.0e38f; int gi = 0;
#pragma unroll
        for (int i = 0; i < 8; ++i) { gl[i] = l[i] + bg[i]; if (gl[i] > gm) { gm = gl[i]; gi = i; } }
        float gs = 0.f;
#pragma unroll
        for (int i = 0; i < 8; ++i) gs += __expf(gl[i] - gm);
        const float gp = 1.f / gs;
        float el[8]; float m0 = -3.0e38f, m1 = -3.0e38f; int i0 = 0, i1 = 0;
#pragma unroll
        for (int i = 0; i < 8; ++i) { el[i] = l[8 + gi * 8 + i] + be[gi * 8 + i];
            if (el[i] > m0) { m1 = m0; i1 = i0; m0 = el[i]; i0 = i; } else if (el[i] > m1) { m1 = el[i]; i1 = i; } }
        const float e1 = __expf(m1 - m0); const float p0 = 1.f / (1.f + e1), p1 = e1 / (1.f + e1);
        const int ex0 = gi * 8 + i0, ex1 = gi * 8 + i1;
        const unsigned s0 = atomicAdd(&cnt[ex0], 1u), s1 = atomicAdd(&cnt[64 + ex1], 1u);
        LISTS[(size_t)ex0 * T + s0] = t; ROWW[(size_t)ex0 * T + s0] = gp * p0;
        LISTS[(size_t)(64 + ex1) * T + s1] = t; ROWW[(size_t)(64 + ex1) * T + s1] = gp * p1;
    }
}
__device__ void build_tile_base(const P& p, int* tb) {
    const unsigned* cnt = (const unsigned*)(p.ws + WS_CTL) + CW_CNT;
    if (threadIdx.x == 0) { int s = 0; for (int i = 0; i < 128; ++i) { tb[i] = s; s += ((int)cnt[i] + 63) >> 6; } tb[128] = s; }
    __syncthreads();
}
__device__ __forceinline__ int find_list(const int* tb, int R, int lo, int hi) {
    while (hi - lo > 1) { const int mid = (lo + hi) >> 1; if (tb[mid] <= R) lo = mid; else hi = mid; }
    return lo;
}
__device__ void ph_moe1(const P& p, int gw, int ngw, const int* tb) {
    const bf16* XN = (const bf16*)(p.ws + WS_XN); const bf16* W13 = (const bf16*)(p.ws + WS_W13_T); bf16* H = (bf16*)(p.ws + WS_H);
    const unsigned* cnt = (const unsigned*)(p.ws + WS_CTL) + CW_CNT; const int* LISTS = (const int*)(p.ws + WS_LISTS);
    const int ntile = tb[128] * 16;
    for (int tile = gw; tile < ntile; tile += ngw) {
        const int R = tile >> 4, ct = tile & 15; const int idx = find_list(tb, R, 0, 128), e = idx & 63, rt = R - tb[idx]; const int n = (int)cnt[idx];
        const int* list = LISTS + (size_t)idx * T;
        wave_gemm_64x64([&](int i) { const int r = min(rt * 64 + i, n - 1); return XN + (size_t)list[r] * DM; },
            [&](int j) { return W13 + ((size_t)e * 1024 + ct * 64 + j) * 1024; }, 1024,
            [&](int i, int j0, f32x4 v) { const float h0 = silu_f(v.x) * v.y, h1 = silu_f(v.z) * v.w;
                *(unsigned*)(H + ((size_t)R * 64 + i) * 512 + ((ct * 64 + j0) >> 1)) = pk2(h0, h1); });
    }
}
__device__ void ph_moe2(const P& p, int gw, int ngw, const int* tb, int k) {
    const bf16* H = (const bf16*)(p.ws + WS_H); const bf16* W2T = (const bf16*)(p.ws + WS_W2_T); const float* mod = (const float*)(p.ws + WS_MOD);
    const unsigned* cnt = (const unsigned*)(p.ws + WS_CTL) + CW_CNT; const int* LISTS = (const int*)(p.ws + WS_LISTS); const float* ROWW = (const float*)(p.ws + WS_ROWW);
    float* out = p.out;
    const int R0 = tb[k * 64], ntile = (tb[k * 64 + 64] - R0) * 16;
    for (int tile = gw; tile < ntile; tile += ngw) {
        const int R = R0 + (tile >> 4), ct = tile & 15; const int idx = find_list(tb, R, k * 64, k * 64 + 64), e = idx & 63, rt = R - tb[idx]; const int n = (int)cnt[idx];
        const int* list = LISTS + (size_t)idx * T; const float* roww = ROWW + (size_t)idx * T;
        wave_gemm_64x64([&](int i) { return H + ((size_t)R * 64 + i) * 512; },
            [&](int j) { return W2T + ((size_t)e * 1024 + ct * 64 + j) * 512; }, 512,
            [&](int i, int j0, f32x4 v) { const int r = rt * 64 + i; if (r < n) { const int tok = list[r]; const float w = roww[r]; const int col = ct * 64 + j0, b = tok / SEQ;
                const f32x4 g2 = *(const f32x4*)(mod + b * 6144 + 5120 + col); float* o = out + (size_t)tok * DM + col;
                *(f32x4*)o = *(const f32x4*)o + g2 * (v * w); } });
    }
}

constexpr int NT = 512;
template <int PH> __global__ void __launch_bounds__(NT) phase_kernel(P p) {
    __shared__ __attribute__((aligned(16))) float lds[(8 * 8448 + 8192) / 4];
    const int tid = threadIdx.x, wave = tid >> 6;
    const int gw = blockIdx.x * (NT / 64) + wave, ngw = gridDim.x * (NT / 64);
    float* scr = lds + wave * (8448 / 4); float* shb = lds + 8 * 8448 / 4;
    if (PH == 0) { ph_mod(p, blockIdx.x, gridDim.x, shb); ph_wprep_a(p, gw, ngw, scr); }
    if (PH == 1) ph_rownorm(p, gw, ngw, p.in[0], 0);
    if (PH == 2) ph_gemm_in(p, gw, ngw);
    if (PH == 3) ph_post(p, gw, ngw);
    if (PH == 4) { ph_cmp_gemm(p, gw, ngw); ph_wprep_moe(p, gw, ngw, scr); }
    if (PH == 5) ph_cmp_fin(p, gw, ngw);
    if (PH == 6) { build_bias_table(p, shb); ph_attn_naive(p, gw, ngw, (AttnLds*)scr, shb); }
    if (PH == 7) ph_gemm_out(p, gw, ngw);
    if (PH == 8) ph_rownorm(p, gw, ngw, p.out, 1);
    if (PH == 9) ph_gemm_router(p, gw, ngw);
    if (PH == 10) ph_route(p, blockIdx.x * NT + tid, gridDim.x * NT);
    if (PH == 11) { build_tile_base(p, (int*)shb); ph_moe1(p, gw, ngw, (const int*)shb); }
    if (PH == 12) { build_tile_base(p, (int*)shb); ph_moe2(p, gw, ngw, (const int*)shb, 0); }
    if (PH == 13) { build_tile_base(p, (int*)shb); ph_moe2(p, gw, ngw, (const int*)shb, 1); }
}

extern "C" void kernel_launch(void* const* d_in, const int* in_sizes, int n_in, void* d_out, int out_size, void* d_ws, size_t ws_size, hipStream_t stream) {
    if (n_in != 26 || ws_size < WS_END) { fprintf(stderr, "kernel_launch: bad args n_in=%d ws=%zu\n", n_in, ws_size); return; }
    P p{};
    for (int i = 0; i < 26; ++i) p.in[i] = (const float*)d_in[i];
    p.out = (float*)d_out; p.ws = (unsigned char*)d_ws;
    hipMemsetAsync((char*)d_ws + WS_CTL, 0, 1 * MiB, stream);
    const dim3 g(1024), b(NT);
#define LAUNCH(PH) hipLaunchKernelGGL(phase_kernel<PH>, g, b, 0, stream, p)
    LAUNCH(0); LAUNCH(1); LAUNCH(2); LAUNCH(3); LAUNCH(4); LAUNCH(5); LAUNCH(6); LAUNCH(7); LAUNCH(8); LAUNCH(9); LAUNCH(10); LAUNCH(11); LAUNCH(12); LAUNCH(13);
}
```

```cpp
#include <hip/hip_runtime.h>
#include <stdint.h>
#include <stdio.h>

#ifndef NAIVE_GEMM
#define NAIVE_GEMM 0
#endif

typedef unsigned short bf16;
typedef short bf16x8 __attribute__((ext_vector_type(8)));
typedef float f32x4 __attribute__((ext_vector_type(4)));
typedef unsigned u32x4 __attribute__((ext_vector_type(4)));
typedef unsigned u32x2 __attribute__((ext_vector_type(2)));

constexpr int BATCH = 2, SEQ = 16384, DM = 1024, T = BATCH * SEQ;
constexpr int NIN = 2840, NINP = 3072;
constexpr int NC = 1023, NCP = 1024, NS = 256;
constexpr int NEXP = 64;
constexpr float EPS = 1e-6f;

constexpr size_t MiB = 1u << 20;
constexpr size_t WS_CTL = 0;
constexpr size_t WS_MOD = 1 * MiB;
constexpr size_t WS_POSB = 1 * MiB + 65536;
constexpr size_t WS_WIN_T = 2 * MiB;
constexpr size_t WS_WOUT_T = 8 * MiB;
constexpr size_t WS_CW1_T = 10 * MiB;
constexpr size_t WS_WR_T = 12 * MiB;
constexpr size_t WS_HID = 13 * MiB;
constexpr size_t WS_KCVC = 21 * MiB;
constexpr size_t WS_GATES = 22 * MiB;
constexpr size_t WS_LOGITS = 25 * MiB;
constexpr size_t WS_LISTS = 41 * MiB;
constexpr size_t WS_ROWW = 57 * MiB;
constexpr size_t WS_XN = 73 * MiB;
constexpr size_t WS_R1 = 137 * MiB;
constexpr size_t WS_W13_T = WS_R1;
constexpr size_t WS_W2_T = WS_R1 + 128 * MiB;
constexpr size_t WS_Q = 329 * MiB;
constexpr size_t WS_KV = 361 * MiB;
constexpr size_t WS_H = 329 * MiB;
constexpr size_t WS_MIX = 410 * MiB;
constexpr size_t WS_END = 474 * MiB;

constexpr int CW_CNT = 0;

struct P {
    const float* in[26];
    float* out;
    unsigned char* ws;
};

__device__ __forceinline__ unsigned f2bf(float f) { unsigned u = __builtin_bit_cast(unsigned, f); return (u + 0x7fffu + ((u >> 16) & 1u)) >> 16; }
__device__ __forceinline__ unsigned pk2(float lo, float hi) { return f2bf(lo) | (f2bf(hi) << 16); }
__device__ __forceinline__ float bf2f(unsigned short h) { return __builtin_bit_cast(float, (unsigned)h << 16); }
__device__ __forceinline__ float bflo(unsigned u) { return __builtin_bit_cast(float, u << 16); }
__device__ __forceinline__ float bfhi(unsigned u) { return __builtin_bit_cast(float, u & 0xffff0000u); }
__device__ __forceinline__ float wave_sum(float v) {
#pragma unroll
    for (int o = 1; o < 64; o <<= 1) v += __shfl_xor(v, o);
    return v;
}
__device__ __forceinline__ float silu_f(float v) { return v / (1.f + __expf(-v)); }
#define LDS_FENCE() asm volatile("s_waitcnt lgkmcnt(0)" ::: "memory")

template <class AR, class BR, class EPI>
__device__ __forceinline__ void wave_gemm_64x64(AR arow, BR brow, int K, EPI epi) {
    const int lane = threadIdx.x & 63, fr = lane & 15, fq = lane >> 4;
#if !NAIVE_GEMM
    const bf16* ap[4]; const bf16* bp[4];
#pragma unroll
    for (int i = 0; i < 4; ++i) { ap[i] = arow(16 * i + fr) + fq * 8; bp[i] = brow(16 * i + fr) + fq * 8; }
    f32x4 acc[4][4];
#pragma unroll
    for (int i = 0; i < 4; ++i)
#pragma unroll
        for (int j = 0; j < 4; ++j) acc[i][j] = (f32x4){0.f, 0.f, 0.f, 0.f};
#pragma unroll 1
    for (int k = 0; k < K; k += 64) {
        bf16x8 a[4][2], b[4][2];
#pragma unroll
        for (int i = 0; i < 4; ++i) {
            a[i][0] = *(const bf16x8*)(ap[i] + k); a[i][1] = *(const bf16x8*)(ap[i] + k + 32);
            b[i][0] = *(const bf16x8*)(bp[i] + k); b[i][1] = *(const bf16x8*)(bp[i] + k + 32);
        }
#pragma unroll
        for (int kk = 0; kk < 2; ++kk)
#pragma unroll
            for (int i = 0; i < 4; ++i)
#pragma unroll
                for (int j = 0; j < 4; ++j) acc[i][j] = __builtin_amdgcn_mfma_f32_16x16x32_bf16(b[j][kk], a[i][kk], acc[i][j], 0, 0, 0);
    }
#pragma unroll
    for (int i = 0; i < 4; ++i)
#pragma unroll
        for (int j = 0; j < 4; ++j) { epi(16 * i + fr, 16 * j + 4 * fq, acc[i][j]); asm volatile("" ::: "memory"); }
#else
    for (int i = 0; i < 4; ++i) {
        const bf16* ar = arow(16 * i + fr);
        for (int j = 0; j < 4; ++j) {
            f32x4 acc = (f32x4){0.f, 0.f, 0.f, 0.f};
#pragma unroll
            for (int r = 0; r < 4; ++r) {
                const bf16* br = brow(16 * j + 4 * fq + r);
                float s = 0.f;
                for (int k = 0; k < K; k += 8) {
                    u32x4 av = *(const u32x4*)(ar + k), bv = *(const u32x4*)(br + k);
#pragma unroll
                    for (int q = 0; q < 4; ++q) { s += bflo(av[q]) * bflo(bv[q]); s += bfhi(av[q]) * bfhi(bv[q]); }
                }
                acc[r] = s;
            }
            epi(16 * i + fr, 16 * j + 4 * fq, acc);
        }
    }
#endif
}

__device__ __forceinline__ void transpose_item(const float* W, int K, int N, bf16* WT, int rmul, int radd, float* scr, int item, int lane) {
    const int nblk = (N + 31) / 32, kb = item / nblk, nb = item % nblk, k0 = 64 * kb, n0 = 32 * nb;
    const int ncol = n0 + (lane & 31);
#pragma unroll 8
    for (int i = 0; i < 32; ++i) { const int kk = 2 * i + (lane >> 5); scr[kk * 33 + (lane & 31)] = ncol < N ? W[(size_t)(k0 + kk) * N + ncol] : 0.f; }
    LDS_FENCE();
    const int c = lane & 7;
#pragma unroll
    for (int j = 0; j < 4; ++j) { const int n = (lane >> 3) + 8 * j; const float* s = scr + (8 * c) * 33 + n;
        u32x4 o; o.x = pk2(s[0 * 33], s[1 * 33]); o.y = pk2(s[2 * 33], s[3 * 33]); o.z = pk2(s[4 * 33], s[5 * 33]); o.w = pk2(s[6 * 33], s[7 * 33]);
        *(u32x4*)(WT + (size_t)(radd + rmul * (n0 + n)) * K + k0 + 8 * c) = o; }
    LDS_FENCE();
}


__device__ void ph_mod(const P& p, int blk, int nblk, float* shb) {
    const float* c = p.in[1]; const float* w_ada = p.in[2]; const float* b_ada = p.in[3];
    float* mod = (float*)(p.ws + WS_MOD);
    const int tid = threadIdx.x, wave = tid >> 6, lane = tid & 63, nw = blockDim.x >> 6;
    for (int task = blk; task < 96; task += nblk) {
        const int col = task * 64 + lane;
        float a0 = 0.f, a1 = 0.f;
        const int kper = 1024 / nw;
        for (int k = wave * kper; k < (wave + 1) * kper; ++k) {
            const float w = w_ada[(size_t)k * 6144 + col];
            a0 += silu_f(c[k]) * w; a1 += silu_f(c[1024 + k]) * w;
        }
        shb[(wave * 2 + 0) * 64 + lane] = a0; shb[(wave * 2 + 1) * 64 + lane] = a1;
        __syncthreads();
        if (wave < 2) { float s = 0.f; for (int w = 0; w < nw; ++w) s += shb[(w * 2 + wave) * 64 + lane]; mod[wave * 6144 + col] = s + b_ada[col]; }
        __syncthreads();
    }
    float* posb = (float*)(p.ws + WS_POSB);
    for (int task = blk; task < 8; task += nblk) {
        const int kv = task >> 2, col = (task & 3) * 64 + lane;
        const float* pos = p.in[8 + kv]; const float* w1 = p.in[kv == 0 ? 10 : 12];
        float a = 0.f; const int kper = 2048 / nw;
        for (int k = wave * kper; k < (wave + 1) * kper; ++k) a += pos[k] * w1[(size_t)k * 256 + col];
        shb[wave * 64 + lane] = a;
        __syncthreads();
        if (wave == 0) { float s = 0.f; for (int w = 0; w < nw; ++w) s += shb[w * 64 + lane]; posb[kv * 256 + col] = s; }
        __syncthreads();
    }
}

__device__ void ph_wprep_a(const P& p, int gw, int ngw, float* scr) {
    const int lane = threadIdx.x & 63;
    bf16* WIN_T = (bf16*)(p.ws + WS_WIN_T); bf16* WOUT_T = (bf16*)(p.ws + WS_WOUT_T); bf16* CW1_T = (bf16*)(p.ws + WS_CW1_T); bf16* WR_T = (bf16*)(p.ws + WS_WR_T);
    constexpr int I_IN = (1024 / 64) * 89, I_OUT = 16 * 32, I_C = (2048 / 64) * 8;
    for (int it = gw; it < I_IN + I_OUT + 2 * I_C; it += ngw) {
        int r = it;
        if (r < I_IN) { transpose_item(p.in[5], 1024, NIN, WIN_T, 1, 0, scr, r, lane); continue; } r -= I_IN;
        if (r < I_OUT) { transpose_item(p.in[16], 1024, 1024, WOUT_T, 1, 0, scr, r, lane); continue; } r -= I_OUT;
        if (r < I_C) { transpose_item(p.in[10], 2048, 256, CW1_T, 1, 0, scr, r, lane); continue; } r -= I_C;
        transpose_item(p.in[12], 2048, 256, CW1_T + 256 * 2048, 1, 0, scr, r, lane);
    }
    for (int i = gw * 64 + lane; i < 224 * 1024 / 8; i += ngw * 64) *(u32x4*)(WIN_T + (size_t)2848 * 1024 + (size_t)i * 8) = (u32x4){0u, 0u, 0u, 0u};
    for (int i = gw * 64 + lane; i < 128 * 1024; i += ngw * 64) {
        const int n = i >> 10, k = i & 1023; float v = 0.f;
        if (n < 8) v = p.in[19][k * 8 + n]; else if (n < 72) v = p.in[21][k * 64 + (n - 8)];
        WR_T[i] = (bf16)f2bf(v);
    }
}
__device__ void ph_wprep_moe(const P& p, int gw, int ngw, float* scr) {
    const int lane = threadIdx.x & 63;
    bf16* W13 = (bf16*)(p.ws + WS_W13_T); bf16* W2T = (bf16*)(p.ws + WS_W2_T);
    constexpr int I_13 = (1024 / 64) * (512 / 32), I_2 = (512 / 64) * (1024 / 32);
    for (int it = gw; it < NEXP * (2 * I_13 + I_2); it += ngw) {
        const int e = it / (2 * I_13 + I_2); int r = it % (2 * I_13 + I_2);
        if (r < I_13) { transpose_item(p.in[23] + (size_t)e * 1024 * 512, 1024, 512, W13 + (size_t)e * 1024 * 1024, 2, 0, scr, r, lane); continue; } r -= I_13;
        if (r < I_13) { transpose_item(p.in[24] + (size_t)e * 1024 * 512, 1024, 512, W13 + (size_t)e * 1024 * 1024, 2, 1, scr, r, lane); continue; } r -= I_13;
        transpose_item(p.in[25] + (size_t)e * 512 * 1024, 512, 1024, W2T + (size_t)e * 1024 * 512, 1, 0, scr, r, lane);
    }
}

__device__ void ph_rownorm(const P& p, int gw, int ngw, const float* src, int which) {
    const int lane = threadIdx.x & 63;
    const float* nw = p.in[which == 0 ? 4 : 18];
    const float* mod = (const float*)(p.ws + WS_MOD);
    bf16* XN = (bf16*)(p.ws + WS_XN);
    f32x4 wv[4];
#pragma unroll
    for (int j = 0; j < 4; ++j) wv[j] = *(const f32x4*)(nw + 4 * lane + 256 * j);
    for (int row = gw; row < T; row += ngw) {
        const int b = row / SEQ;
        const float* sh = mod + b * 6144 + (which == 0 ? 0 : 3072); const float* sc = sh + 1024;
        const f32x4* xr = (const f32x4*)(src + (size_t)row * DM) + lane;
        f32x4 v[4]; float s = 0.f;
#pragma unroll
        for (int j = 0; j < 4; ++j) { v[j] = xr[64 * j]; s += v[j].x * v[j].x + v[j].y * v[j].y + v[j].z * v[j].z + v[j].w * v[j].w; }
        const float rstd = rsqrtf(wave_sum(s) * (1.f / DM) + EPS);
        unsigned long long* o8 = (unsigned long long*)(XN + (size_t)row * DM) + lane;
#pragma unroll
        for (int j = 0; j < 4; ++j) {
            const f32x4 scv = *(const f32x4*)(sc + 4 * lane + 256 * j), shv = *(const f32x4*)(sh + 4 * lane + 256 * j);
            const f32x4 h = v[j] * rstd * wv[j] * (scv + 1.f) + shv;
            o8[64 * j] = (unsigned long long)pk2(h.x, h.y) | ((unsigned long long)pk2(h.z, h.w) << 32);
        }
    }
}

__device__ void ph_gemm_in(const P& p, int gw, int ngw) {
    const bf16* XN = (const bf16*)(p.ws + WS_XN); const bf16* WT = (const bf16*)(p.ws + WS_WIN_T); bf16* RAW = (bf16*)(p.ws + WS_R1);
    constexpr int TN = NINP / 64, TM = T / 64;
    for (int tile = gw; tile < TM * TN; tile += ngw) {
        const int tm = tile / TN, tn = tile % TN;
        wave_gemm_64x64([&](int i) { return XN + (size_t)(tm * 64 + i) * DM; }, [&](int j) { return WT + (size_t)(tn * 64 + j) * DM; }, DM,
            [&](int i, int j0, f32x4 v) { u32x2 o; o.x = pk2(v.x, v.y); o.y = pk2(v.z, v.w); *(u32x2*)(RAW + (size_t)(tm * 64 + i) * NINP + tn * 64 + j0) = o; });
    }
}

__device__ void ph_post(const P& p, int gw, int ngw) {
    const int lane = threadIdx.x & 63;
    const bf16* RAW = (const bf16*)(p.ws + WS_R1);
    bf16* Q = (bf16*)(p.ws + WS_Q); bf16* KV = (bf16*)(p.ws + WS_KV); float* GATES = (float*)(p.ws + WS_GATES); bf16* MIX = (bf16*)(p.ws + WS_MIX);
    const float qw = p.in[6][lane], kw1 = p.in[7][64 + lane], kw2 = p.in[7][128 + lane];
    const float* conv_w = p.in[14]; const float* onw = p.in[15];
    for (int t = gw; t < T; t += ngw) {
        const int b = t / SEQ, s = t % SEQ;
        const bf16* r = RAW + (size_t)t * NINP;
#pragma unroll
        for (int h = 0; h < 8; ++h) {
            const float v = bf2f(r[h * 64 + lane]);
            const float rs = rsqrtf(wave_sum(v * v) * (1.f / 64.f) + EPS);
            Q[((size_t)t * 8 + h) * 64 + lane] = (bf16)f2bf(v * rs * qw);
        }
#pragma unroll
        for (int i = 0; i < 6; ++i)
#pragma unroll
            for (int g = 0; g < 2; ++g) {
                float v = bf2f(r[512 + i * 128 + g * 64 + lane]);
                if (i == 2 || i == 4) { const float rs = rsqrtf(wave_sum(v * v) * (1.f / 64.f) + EPS); v = v * rs * (i == 2 ? kw1 : kw2); }
                KV[((((size_t)i * 2 + b) * 2 + g) * SEQ + s) * 64 + lane] = (bf16)f2bf(v);
            }
        if (lane < 24) GATES[(size_t)t * 24 + lane] = 1.f / (1.f + __expf(-bf2f(r[1280 + lane])));
#pragma unroll
        for (int j = 0; j < 8; ++j) {
            const int c = j * 64 + lane;
            float acc = 0.f;
#pragma unroll
            for (int d = 0; d < 3; ++d) {
                const int sd = s - 2 + d;
                if (sd >= 0) { const bf16* rr = RAW + (size_t)(t - 2 + d) * NINP; acc += conv_w[d * 512 + c] * bf2f(rr[1816 + c]) * bf2f(rr[2328 + c]); }
            }
            const float y = bf2f(r[1304 + c]) * acc;
            const float rs = rsqrtf(wave_sum(y * y) * (1.f / 64.f) + EPS);
            MIX[(size_t)t * DM + 512 + c] = (bf16)f2bf(y * rs * onw[512 + c]);
        }
    }
}

__device__ void ph_cmp_gemm(const P& p, int gw, int ngw) {
    const bf16* KV = (const bf16*)(p.ws + WS_KV); const bf16* CW1 = (const bf16*)(p.ws + WS_CW1_T); float* HID = (float*)(p.ws + WS_HID); const float* posb = (const float*)(p.ws + WS_POSB);
    for (int tile = gw; tile < 2 * 64 * 4; tile += ngw) {
        const int kv = tile / 256, tm = (tile % 256) / 4, tn = tile % 4;
        wave_gemm_64x64(
            [&](int i) { const int row = tm * 64 + i, bg = row >> 10, n = row & 1023; return KV + (((size_t)kv * 4 + bg) * SEQ + 16 * n) * 64; },
            [&](int j) { return CW1 + ((size_t)kv * 256 + tn * 64 + j) * 2048; }, 2048,
            [&](int i, int j0, f32x4 v) { const int row = tm * 64 + i; const f32x4 pb = *(const f32x4*)(posb + kv * 256 + tn * 64 + j0);
                f32x4 o; o.x = silu_f(v.x + pb.x); o.y = silu_f(v.y + pb.y); o.z = silu_f(v.z + pb.z); o.w = silu_f(v.w + pb.w);
                *(f32x4*)(HID + ((size_t)kv * 4096 + row) * 256 + tn * 64 + j0) = o; });
    }
}
__device__ void ph_cmp_fin(const P& p, int gw, int ngw) {
    const int lane = threadIdx.x & 63;
    const float* HID = (const float*)(p.ws + WS_HID); bf16* KCVC = (bf16*)(p.ws + WS_KCVC);
    const float kw0 = p.in[7][lane];
    for (int r = gw; r < 2 * 4096; r += ngw) {
        const int kv = r / 4096, row = r % 4096, n = row & 1023;
        float o = 0.f;
        if (n < NC) {
            const float* w2 = p.in[kv == 0 ? 11 : 13]; const float* h = HID + (size_t)r * 256;
            for (int j = 0; j < 256; ++j) o += h[j] * w2[j * 64 + lane];
            if (kv == 0) { const float rs = rsqrtf(wave_sum(o * o) * (1.f / 64.f) + EPS); o = o * rs * kw0; }
        }
        KCVC[(size_t)r * 64 + lane] = (bf16)f2bf(o);
    }
}

struct AttnLds { float qs[4][64]; float ps[64][4]; float imp[256]; };
__device__ __forceinline__ void attn_qk(const bf16* krow, const float (*qs)[64], float s[4]) {
    s[0] = s[1] = s[2] = s[3] = 0.f;
#pragma unroll 2
    for (int c = 0; c < 8; ++c) {
        asm volatile("" ::: "memory");
        const u32x4 kvv = *(const u32x4*)(krow + 8 * c);
        float kf[8]; kf[0] = bflo(kvv.x); kf[1] = bfhi(kvv.x); kf[2] = bflo(kvv.y); kf[3] = bfhi(kvv.y); kf[4] = bflo(kvv.z); kf[5] = bfhi(kvv.z); kf[6] = bflo(kvv.w); kf[7] = bfhi(kvv.w);
#pragma unroll
        for (int h = 0; h < 4; ++h) {
            const f32x4 q0 = *(const f32x4*)(&qs[h][8 * c]), q1 = *(const f32x4*)(&qs[h][8 * c + 4]);
            s[h] += kf[0] * q0.x + kf[1] * q0.y + kf[2] * q0.z + kf[3] * q0.w + kf[4] * q1.x + kf[5] * q1.y + kf[6] * q1.z + kf[7] * q1.w;
        }
    }
}
__device__ __forceinline__ void attn_pv(const bf16* vbase, const float (*ps)[4], int lane, float o[4]) {
    for (int j = 0; j < 64; ++j) {
        const f32x4 pj = *(const f32x4*)(&ps[j][0]);
        const float v = bf2f(vbase[(size_t)j * 64 + lane]);
        o[0] += pj.x * v; o[1] += pj.y * v; o[2] += pj.z * v; o[3] += pj.w * v;
    }
}
__device__ void ph_attn_naive(const P& p, int gw, int ngw, AttnLds* L, const float* biasT  ) {
    const int lane = threadIdx.x & 63;
    const bf16* Q = (const bf16*)(p.ws + WS_Q); const bf16* KV = (const bf16*)(p.ws + WS_KV); const bf16* KCVC = (const bf16*)(p.ws + WS_KCVC);
    const float* GATES = (const float*)(p.ws + WS_GATES); bf16* MIX = (bf16*)(p.ws + WS_MIX); const float* onw = p.in[15];
    for (int item = gw; item < T * 2; item += ngw) {
        const int t = item >> 1, g = item & 1, b = t / SEQ, pos = t % SEQ, cur = pos >> 6;
#pragma unroll
        for (int h = 0; h < 4; ++h) L->qs[h][lane] = bf2f(Q[((size_t)t * 8 + 4 * g + h) * 64 + lane]) * 0.125f;
        for (int i = lane; i < 256; i += 64) L->imp[i] = 0.f;
        LDS_FENCE();
        const bf16* KC = KCVC + ((size_t)(0 * 4 + b * 2 + g) * NCP) * 64; const bf16* VC = KCVC + ((size_t)(1 * 4 + b * 2 + g) * NCP) * 64;
        auto kvp = [&](int i) { return KV + (((size_t)i * 2 + b) * 2 + g) * SEQ * 64; };
        const int nvis = pos >= 31 ? min((pos - 31) / 16 + 1, NC) : 0;
        float lc[4] = {0.f, 0.f, 0.f, 0.f}, oc[4] = {0.f, 0.f, 0.f, 0.f};
        for (int kb = 0; kb * 64 < nvis; ++kb) {
            const int n = kb * 64 + lane; float s[4]; attn_qk(KC + (size_t)n * 64, L->qs, s);
            const int dist = pos - (16 * n + 31); const bool valid = n < nvis; const int bi = min(max(dist, 0), 128);
#pragma unroll
            for (int h = 0; h < 4; ++h) lc[h] += valid ? __expf(s[h] + biasT[bi * 8 + 4 * g + h]) : 0.f;
        }
        float rlc[4];
#pragma unroll
        for (int h = 0; h < 4; ++h) { lc[h] = wave_sum(lc[h]); rlc[h] = lc[h] > 0.f ? 1.f / lc[h] : 0.f; }
        for (int kb = 0; kb * 64 < nvis; ++kb) {
            const int n = kb * 64 + lane; float s[4]; attn_qk(KC + (size_t)n * 64, L->qs, s);
            const int dist = pos - (16 * n + 31); const bool valid = n < nvis; const int bi = min(max(dist, 0), 128);
            float w = 0.f; float pe[4];
#pragma unroll
            for (int h = 0; h < 4; ++h) { pe[h] = valid ? __expf(s[h] + biasT[bi * 8 + 4 * g + h]) : 0.f; w += pe[h] * rlc[h]; }
            LDS_FENCE();
            *(f32x4*)(&L->ps[lane][0]) = (f32x4){pe[0], pe[1], pe[2], pe[3]};
            if (valid) { atomicAdd(&L->imp[n >> 2], w); if ((n & 3) == 3 && (n >> 2) + 1 < NS) atomicAdd(&L->imp[(n >> 2) + 1], w); }
            LDS_FENCE();
            attn_pv(VC + (size_t)kb * 64 * 64, L->ps, lane, oc);
        }
        LDS_FENCE();
        float sc[4];
#pragma unroll
        for (int j = 0; j < 4; ++j) { const int s = lane * 4 + j; const bool forced = (s == 0) || (s == cur) || (s == cur - 1);
            sc[j] = forced ? 1e4f : (s <= cur ? L->imp[s] : -1.f); }
        float ls[4] = {0.f, 0.f, 0.f, 0.f}, os[4] = {0.f, 0.f, 0.f, 0.f};
        for (int r = 0; r < 16; ++r) {
            float bv = sc[0]; int bi_ = lane * 4;
#pragma unroll
            for (int j = 1; j < 4; ++j) if (sc[j] > bv) { bv = sc[j]; bi_ = lane * 4 + j; }
#pragma unroll
            for (int o = 1; o < 64; o <<= 1) { const float ov = __shfl_xor(bv, o); const int oi = __shfl_xor(bi_, o); if (ov > bv || (ov == bv && oi < bi_)) { bv = ov; bi_ = oi; } }
            if (!(bv >= 0.f)) break;
            if ((bi_ >> 2) == lane) {
#pragma unroll
                for (int j = 0; j < 4; ++j) if ((bi_ & 3) == j) sc[j] = -3.0e38f;
            }
            const int kpos = bi_ * 64 + lane; float s[4]; attn_qk(kvp(2) + (size_t)kpos * 64, L->qs, s);
            const int dist = pos - kpos; const bool valid = dist >= 0; const int bx = min(max(dist, 0), 128);
            float pe[4];
#pragma unroll
            for (int h = 0; h < 4; ++h) { pe[h] = valid ? __expf(s[h] + biasT[bx * 8 + 4 * g + h]) : 0.f; ls[h] += pe[h]; }
            LDS_FENCE();
            *(f32x4*)(&L->ps[lane][0]) = (f32x4){pe[0], pe[1], pe[2], pe[3]};
            LDS_FENCE();
            attn_pv(kvp(3) + (size_t)bi_ * 64 * 64, L->ps, lane, os);
        }
        float lw[4] = {0.f, 0.f, 0.f, 0.f}, ow[4] = {0.f, 0.f, 0.f, 0.f};
        const int kstart = max(0, pos - 511);
        for (int blk = kstart >> 6; blk <= cur; ++blk) {
            const int kpos = blk * 64 + lane; float s[4]; attn_qk(kvp(4) + (size_t)kpos * 64, L->qs, s);
            const int dist = pos - kpos; const bool valid = dist >= 0 && kpos >= kstart; const int bx = min(max(dist, 0), 128);
            float pe[4];
#pragma unroll
            for (int h = 0; h < 4; ++h) { pe[h] = valid ? __expf(s[h] + biasT[bx * 8 + 4 * g + h]) : 0.f; lw[h] += pe[h]; }
            LDS_FENCE();
            *(f32x4*)(&L->ps[lane][0]) = (f32x4){pe[0], pe[1], pe[2], pe[3]};
            LDS_FENCE();
            attn_pv(kvp(5) + (size_t)blk * 64 * 64, L->ps, lane, ow);
        }
        LDS_FENCE();
#pragma unroll
        for (int h = 0; h < 4; ++h) {
            const float l_s = wave_sum(ls[h]), l_w = wave_sum(lw[h]);
            const float* gt = GATES + (size_t)t * 24 + (4 * g + h) * 3;
            const float o = gt[0] * oc[h] * rlc[h] + gt[1] * os[h] * (l_s > 0.f ? 1.f / l_s : 0.f) + gt[2] * ow[h] * (l_w > 0.f ? 1.f / l_w : 0.f);
            const float rs = rsqrtf(wave_sum(o * o) * (1.f / 64.f) + EPS);
            const int c = (4 * g + h) * 64 + lane;
            MIX[(size_t)t * DM + c] = (bf16)f2bf(o * rs * onw[c]);
        }
    }
}
__device__ void build_bias_table(const P& p, float* biasT) {
    for (int i = threadIdx.x; i < 129 * 8; i += blockDim.x) {
        const int d = i >> 3, h = i & 7; int bk;
        if (d < 16) bk = d; else { bk = 16 + (int)(logf((float)d / 16.f) / logf(8.f) * 16.f); bk = min(bk, 31); }
        biasT[i] = p.in[17][bk * 8 + h];
    }
    __syncthreads();
}

__device__ void ph_gemm_out(const P& p, int gw, int ngw) {
    const bf16* MIX = (const bf16*)(p.ws + WS_MIX); const bf16* WT = (const bf16*)(p.ws + WS_WOUT_T); const float* mod = (const float*)(p.ws + WS_MOD);
    const float* x = p.in[0]; float* out = p.out;
    constexpr int TN = DM / 64, TM = T / 64;
    for (int tile = gw; tile < TM * TN; tile += ngw) {
        const int tm = tile / TN, tn = tile % TN;
        wave_gemm_64x64([&](int i) { return MIX + (size_t)(tm * 64 + i) * DM; }, [&](int j) { return WT + (size_t)(tn * 64 + j) * DM; }, DM,
            [&](int i, int j0, f32x4 v) { const int row = tm * 64 + i, col = tn * 64 + j0, b = row / SEQ;
                const f32x4 g1 = *(const f32x4*)(mod + b * 6144 + 2048 + col); const f32x4 xv = *(const f32x4*)(x + (size_t)row * DM + col);
                *(f32x4*)(out + (size_t)row * DM + col) = xv + g1 * v; });
    }
}
__device__ void ph_gemm_router(const P& p, int gw, int ngw) {
    const bf16* XN = (const bf16*)(p.ws + WS_XN); const bf16* WT = (const bf16*)(p.ws + WS_WR_T); float* LG = (float*)(p.ws + WS_LOGITS);
    for (int tile = gw; tile < (T / 64) * 2; tile += ngw) {
        const int tm = tile >> 1, tn = tile & 1;
        wave_gemm_64x64([&](int i) { return XN + (size_t)(tm * 64 + i) * DM; }, [&](int j) { return WT + (size_t)(tn * 64 + j) * DM; }, DM,
            [&](int i, int j0, f32x4 v) { *(f32x4*)(LG + (size_t)(tm * 64 + i) * 128 + tn * 64 + j0) = v; });
    }
}
__device__ void ph_route(const P& p, int gtid, int nthreads) {
    const float* LG = (const float*)(p.ws + WS_LOGITS); unsigned* cnt = (unsigned*)(p.ws + WS_CTL) + CW_CNT;
    int* LISTS = (int*)(p.ws + WS_LISTS); float* ROWW = (float*)(p.ws + WS_ROWW);
    const float* bg = p.in[20]; const float* be = p.in[22];
    for (int t = gtid; t < T; t += nthreads) {
        const float* l = LG + (size_t)t * 128;
        float gl[8]; float gm = -3.0e38f; int gi = 0;
#pragma unroll
        for (int i = 0; i < 8; ++i) { gl[i] = l[i] + bg[i]; if (gl[i] > gm) { gm = gl[i]; gi = i; } }
        float gs = 0.f;
#pragma unroll
        for (int i = 0; i < 8; ++i) gs += __expf(gl[i] - gm);
        const float gp = 1.f / gs;
        float el[8]; float m0 = -3.0e38f, m1 = -3.0e38f; int i0 = 0, i1 = 0;
#pragma unroll
        for (int i = 0; i < 8; ++i) { el[i] = l[8 + gi * 8 + i] + be[gi * 8 + i];
            if (el[i] > m0) { m1 = m0; i1 = i0; m0 = el[i]; i0 = i; } else if (el[i] > m1) { m1 = el[i]; i1 = i; } }
        const float e1 = __expf(m1 - m0); const float p0 = 1.f / (1.f + e1), p1 = e1 / (1.f + e1);
        const int ex0 = gi * 8 + i0, ex1 = gi * 8 + i1;
        const unsigned s0 = atomicAdd(&cnt[ex0], 1u), s1 = atomicAdd(&cnt[64 + ex1], 1u);
        LISTS[(size_t)ex0 * T + s0] = t; ROWW[(size_t)ex0 * T + s0] = gp * p0;
        LISTS[(size_t)(64 + ex1) * T + s1] = t; ROWW[(size_t)(64 + ex1) * T + s1] = gp * p1;
    }
}
__device__ void build_tile_base(const P& p, int* tb) {
    const unsigned* cnt = (const unsigned*)(p.ws + WS_CTL) + CW_CNT;
    if (threadIdx.x == 0) { int s = 0; for (int i = 0; i < 128; ++i) { tb[i] = s; s += ((int)cnt[i] + 63) >> 6; } tb[128] = s; }
    __syncthreads();
}
__device__ __forceinline__ int find_list(const int* tb, int R, int lo, int hi) {
    while (hi - lo > 1) { const int mid = (lo + hi) >> 1; if (tb[mid] <= R) lo = mid; else hi = mid; }
    return lo;
}
__device__ void ph_moe1(const P& p, int gw, int ngw, const int* tb) {
    const bf16* XN = (const bf16*)(p.ws + WS_XN); const bf16* W13 = (const bf16*)(p.ws + WS_W13_T); bf16* H = (bf16*)(p.ws + WS_H);
    const unsigned* cnt = (const unsigned*)(p.ws + WS_CTL) + CW_CNT; const int* LISTS = (const int*)(p.ws + WS_LISTS);
    const int ntile = tb[128] * 16;
    for (int tile = gw; tile < ntile; tile += ngw) {
        const int R = tile >> 4, ct = tile & 15; const int idx = find_list(tb, R, 0, 128), e = idx & 63, rt = R - tb[idx]; const int n = (int)cnt[idx];
        const int* list = LISTS + (size_t)idx * T;
        wave_gemm_64x64([&](int i) { const int r = min(rt * 64 + i, n - 1); return XN + (size_t)list[r] * DM; },
            [&](int j) { return W13 + ((size_t)e * 1024 + ct * 64 + j) * 1024; }, 1024,
            [&](int i, int j0, f32x4 v) { const float h0 = silu_f(v.x) * v.y, h1 = silu_f(v.z) * v.w;
                *(unsigned*)(H + ((size_t)R * 64 + i) * 512 + ((ct * 64 + j0) >> 1)) = pk2(h0, h1); });
    }
}
__device__ void ph_moe2(const P& p, int gw, int ngw, const int* tb, int k) {
    const bf16* H = (const bf16*)(p.ws + WS_H); const bf16* W2T = (const bf16*)(p.ws + WS_W2_T); const float* mod = (const float*)(p.ws + WS_MOD);
    const unsigned* cnt = (const unsigned*)(p.ws + WS_CTL) + CW_CNT; const int* LISTS = (const int*)(p.ws + WS_LISTS); const float* ROWW = (const float*)(p.ws + WS_ROWW);
    float* out = p.out;
    const int R0 = tb[k * 64], ntile = (tb[k * 64 + 64] - R0) * 16;
    for (int tile = gw; tile < ntile; tile += ngw) {
        const int R = R0 + (tile >> 4), ct = tile & 15; const int idx = find_list(tb, R, k * 64, k * 64 + 64), e = idx & 63, rt = R - tb[idx]; const int n = (int)cnt[idx];
        const int* list = LISTS + (size_t)idx * T; const float* roww = ROWW + (size_t)idx * T;
        wave_gemm_64x64([&](int i) { return H + ((size_t)R * 64 + i) * 512; },
            [&](int j) { return W2T + ((size_t)e * 1024 + ct * 64 + j) * 512; }, 512,
            [&](int i, int j0, f32x4 v) { const int r = rt * 64 + i; if (r < n) { const int tok = list[r]; const float w = roww[r]; const int col = ct * 64 + j0, b = tok / SEQ;
                const f32x4 g2 = *(const f32x4*)(mod + b * 6144 + 5120 + col); float* o = out + (size_t)tok * DM + col;
                *(f32x4*)o = *(const f32x4*)o + g2 * (v * w); } });
    }
}

#define LAS __attribute__((address_space(3)))
#define XB_TMO      128
#define XB_XCNT(j)  (256  + 64 * (j))
#define XB_XSUB(j)  (1280 + 64 * (j))
#define XB_XGEN(j)  (2304 + 64 * (j))
#define XB_TOP      3328
#define XB_TOPGEN   3392
#define XCD_BAR_WORDS 3456
#define XB_SPIN_CAP (1u << 18)
constexpr int CW_BAR = 4096;
__device__ __forceinline__ unsigned xb_ld(unsigned* p)              { return __hip_atomic_load(p, __ATOMIC_RELAXED, __HIP_MEMORY_SCOPE_AGENT); }
__device__ __forceinline__ unsigned xb_add(unsigned* p, unsigned v) { return __hip_atomic_fetch_add(p, v, __ATOMIC_RELAXED, __HIP_MEMORY_SCOPE_AGENT); }
__device__ __forceinline__ unsigned xb_xcc_id() { return (unsigned)__builtin_amdgcn_s_getreg((3 << 11) | 20) & 0xFu; }
#define XB_SPIN(cond, bar) do { unsigned _sp = 0; while (cond) { __builtin_amdgcn_s_sleep(1); \
    if ((++_sp & 255u) == 0u) { if (xb_ld(&(bar)[XB_TMO])) break; if (_sp > XB_SPIN_CAP) { atomicAdd(&(bar)[XB_TMO], 1u); break; } } } } while (0)
struct XcdBarrier { unsigned* bar; unsigned x; volatile LAS unsigned* st; };
__device__ __forceinline__ XcdBarrier xcd_barrier_post(unsigned* bar, volatile LAS unsigned* st) {
    XcdBarrier b; b.bar = bar; b.x = xb_xcc_id(); b.st = st;
    if (threadIdx.x == 0) (void)xb_add(&bar[XB_XCNT(b.x)], 1u);
    return b;
}
__device__ __forceinline__ void xcd_barrier_complete(unsigned* bar, unsigned x, unsigned& nloc, unsigned& nx) {
    const unsigned G = gridDim.x * gridDim.y * gridDim.z;
    unsigned sum, cnt, mine, sp = 0u;
    for (;;) {
        sum = 0u; cnt = 0u; mine = 0u;
#pragma unroll
        for (unsigned j = 0; j < 16; ++j) { const unsigned c = xb_ld(&bar[XB_XCNT(j)]); sum += c; cnt += (c > 0u) ? 1u : 0u; mine = (j == x) ? c : mine; }
        if (sum == G) break;
        __builtin_amdgcn_s_sleep(1);
        if ((++sp & 255u) == 0u) { if (xb_ld(&bar[XB_TMO])) break; if (sp > XB_SPIN_CAP) { atomicAdd(&bar[XB_TMO], 1u); break; } }
    }
    nloc = mine > 0u ? mine : 1u; nx = cnt > 0u ? cnt : 1u;
}
__device__ __forceinline__ void xcd_barrier(const XcdBarrier& b) {
    asm volatile("s_waitcnt vmcnt(0)" ::: "memory");
    __syncthreads();
    if (threadIdx.x == 0) {
        unsigned* bar = b.bar;
        __builtin_amdgcn_s_waitcnt(0);
        unsigned nloc = b.st[0], nx = b.st[1];
        if (nloc == 0u) { xcd_barrier_complete(bar, b.x, nloc, nx); b.st[0] = nloc; b.st[1] = nx; }
        const unsigned old = xb_add(&bar[XB_XSUB(b.x)], 1u);
        const unsigned gen = old / nloc;
        if (old + 1u == (gen + 1u) * nloc) {
            __builtin_amdgcn_fence(__ATOMIC_RELEASE, "agent");
            asm volatile("s_waitcnt vmcnt(0)" ::: "memory");
            const unsigned og = xb_add(&bar[XB_TOP], 1u);
            const unsigned tg = og / nx;
            if (og + 1u == (tg + 1u) * nx) xb_add(&bar[XB_TOPGEN], 1u);
            else XB_SPIN(xb_ld(&bar[XB_TOPGEN]) == tg, bar);
            __builtin_amdgcn_fence(__ATOMIC_ACQUIRE, "agent");
            xb_add(&bar[XB_XGEN(b.x)], 1u);
            asm volatile("s_waitcnt vmcnt(0)" ::: "memory");
        } else {
            XB_SPIN(xb_ld(&bar[XB_XGEN(b.x)]) == gen, bar);
            __builtin_amdgcn_fence(__ATOMIC_ACQUIRE, "agent");
            asm volatile("s_waitcnt vmcnt(0)" ::: "memory");
        }
    }
    __syncthreads();
}

constexpr int NT = 512;
constexpr int LDS_SCR = 0, LDS_SHB = 8 * 8448, LDS_MISC = LDS_SHB + 8192, LDS_BYTES = 147456;
__global__ void __launch_bounds__(NT) mega(P p) {
    extern __shared__ __attribute__((aligned(16))) unsigned char ldsb[];
    float* lds = (float*)ldsb;
    const int tid = threadIdx.x, wave = tid >> 6;
    const int gw = blockIdx.x * (NT / 64) + wave, ngw = gridDim.x * (NT / 64);
    float* scr = lds + wave * (8448 / 4); float* shb = lds + LDS_SHB / 4;
    volatile LAS unsigned* misc = (volatile LAS unsigned*)((LAS unsigned char*)ldsb + LDS_MISC);
    if (tid < 16) misc[tid] = 0u;
    __syncthreads();
    XcdBarrier bar = xcd_barrier_post((unsigned*)(p.ws + WS_CTL) + CW_BAR, misc);
#define GB() xcd_barrier(bar)
    ph_mod(p, blockIdx.x, gridDim.x, shb); ph_wprep_a(p, gw, ngw, scr); GB();
    ph_rownorm(p, gw, ngw, p.in[0], 0); GB();
    ph_gemm_in(p, gw, ngw); GB();
    ph_post(p, gw, ngw); GB();
    ph_cmp_gemm(p, gw, ngw); ph_wprep_moe(p, gw, ngw, scr); GB();
    ph_cmp_fin(p, gw, ngw); GB();
    build_bias_table(p, shb); ph_attn_naive(p, gw, ngw, (AttnLds*)scr, shb); GB();
    ph_gemm_out(p, gw, ngw); GB();
    ph_rownorm(p, gw, ngw, p.out, 1); GB();
    ph_gemm_router(p, gw, ngw); GB();
    ph_route(p, blockIdx.x * NT + tid, gridDim.x * NT); GB();
    build_tile_base(p, (int*)shb); ph_moe1(p, gw, ngw, (const int*)shb); GB();
    ph_moe2(p, gw, ngw, (const int*)shb, 0); GB();
    ph_moe2(p, gw, ngw, (const int*)shb, 1);
}

extern "C" void kernel_launch(void* const* d_in, const int* in_sizes, int n_in, void* d_out, int out_size, void* d_ws, size_t ws_size, hipStream_t stream) {
    static int ready = 0;
    if (ready == 0) {
        if (n_in != 26 || ws_size < WS_END) { fprintf(stderr, "kernel_launch: bad args n_in=%d ws=%zu\n", n_in, ws_size); ready = -1; return; }
        if (hipFuncSetAttribute((const void*)mega, hipFuncAttributeMaxDynamicSharedMemorySize, LDS_BYTES) != hipSuccess) { fprintf(stderr, "kernel_launch: hipFuncSetAttribute failed\n"); ready = -1; return; }
        ready = 1;
    }
    if (ready < 0) return;
    P p{};
    for (int i = 0; i < 26; ++i) p.in[i] = (const float*)d_in[i];
    p.out = (float*)d_out; p.ws = (unsigned char*)d_ws;
    (void)hipMemsetAsync((char*)d_ws + WS_CTL, 0, 1 * MiB, stream);
    hipLaunchKernelGGL(mega, dim3(256), dim3(NT), LDS_BYTES, stream, p);
}
```

```cpp
#include <hip/hip_runtime.h>
#include <stdint.h>
#include <stdio.h>

#ifndef NAIVE_GEMM
#define NAIVE_GEMM 0
#endif

typedef unsigned short bf16;
typedef short bf16x8 __attribute__((ext_vector_type(8)));
typedef float f32x4 __attribute__((ext_vector_type(4)));
typedef unsigned u32x4 __attribute__((ext_vector_type(4)));
typedef unsigned u32x2 __attribute__((ext_vector_type(2)));

constexpr int BATCH = 2, SEQ = 16384, DM = 1024, T = BATCH * SEQ;
constexpr int NIN = 2840, NINP = 3072;
constexpr int NC = 1023, NCP = 1024, NS = 256;
constexpr int NEXP = 64;
constexpr float EPS = 1e-6f;

constexpr size_t MiB = 1u << 20;
constexpr size_t WS_CTL = 0;
constexpr size_t WS_MOD = 1 * MiB;
constexpr size_t WS_POSB = 1 * MiB + 65536;
constexpr size_t WS_WIN_T = 2 * MiB;
constexpr size_t WS_WOUT_T = 8 * MiB;
constexpr size_t WS_CW1_T = 10 * MiB;
constexpr size_t WS_WR_T = 12 * MiB;
constexpr size_t WS_HID = 13 * MiB;
constexpr size_t WS_KCVC = 21 * MiB;
constexpr size_t WS_GATES = 22 * MiB;
constexpr size_t WS_LOGITS = 25 * MiB;
constexpr size_t WS_LISTS = 41 * MiB;
constexpr size_t WS_ROWW = 57 * MiB;
constexpr size_t WS_XN = 73 * MiB;
constexpr size_t WS_R1 = 137 * MiB;
constexpr size_t WS_W13_T = WS_R1;
constexpr size_t WS_W2_T = WS_R1 + 128 * MiB;
constexpr size_t WS_Q = 329 * MiB;
constexpr size_t WS_KV = 361 * MiB;
constexpr size_t WS_H = 329 * MiB;
constexpr size_t WS_MIX = 410 * MiB;
constexpr size_t WS_END = 474 * MiB;

constexpr int CW_CNT = 0;

struct P {
    const float* in[26];
    float* out;
    unsigned char* ws;
};

__device__ __forceinline__ unsigned f2bf(float f) { unsigned u = __builtin_bit_cast(unsigned, f); return (u + 0x7fffu + ((u >> 16) & 1u)) >> 16; }
__device__ __forceinline__ unsigned pk2(float lo, float hi) { return f2bf(lo) | (f2bf(hi) << 16); }
__device__ __forceinline__ float bf2f(unsigned short h) { return __builtin_bit_cast(float, (unsigned)h << 16); }
__device__ __forceinline__ float bflo(unsigned u) { return __builtin_bit_cast(float, u << 16); }
__device__ __forceinline__ float bfhi(unsigned u) { return __builtin_bit_cast(float, u & 0xffff0000u); }
__device__ __forceinline__ float wave_sum(float v) {
#pragma unroll
    for (int o = 1; o < 64; o <<= 1) v += __shfl_xor(v, o);
    return v;
}
__device__ __forceinline__ float silu_f(float v) { return v / (1.f + __expf(-v)); }
#define LDS_FENCE() asm volatile("s_waitcnt lgkmcnt(0)" ::: "memory")

template <class AR, class BR, class EPI>
__device__ __forceinline__ void wave_gemm_64x64(AR arow, BR brow, int K, EPI epi) {
    const int lane = threadIdx.x & 63, fr = lane & 15, fq = lane >> 4;
#if !NAIVE_GEMM
    const bf16* ap[4]; const bf16* bp[4];
#pragma unroll
    for (int i = 0; i < 4; ++i) { ap[i] = arow(16 * i + fr) + fq * 8; bp[i] = brow(16 * i + fr) + fq * 8; }
    f32x4 acc[4][4];
#pragma unroll
    for (int i = 0; i < 4; ++i)
#pragma unroll
        for (int j = 0; j < 4; ++j) acc[i][j] = (f32x4){0.f, 0.f, 0.f, 0.f};
#pragma unroll 1
    for (int k = 0; k < K; k += 64) {
        bf16x8 a[4][2], b[4][2];
#pragma unroll
        for (int i = 0; i < 4; ++i) {
            a[i][0] = *(const bf16x8*)(ap[i] + k); a[i][1] = *(const bf16x8*)(ap[i] + k + 32);
            b[i][0] = *(const bf16x8*)(bp[i] + k); b[i][1] = *(const bf16x8*)(bp[i] + k + 32);
        }
#pragma unroll
        for (int kk = 0; kk < 2; ++kk)
#pragma unroll
            for (int i = 0; i < 4; ++i)
#pragma unroll
                for (int j = 0; j < 4; ++j) acc[i][j] = __builtin_amdgcn_mfma_f32_16x16x32_bf16(b[j][kk], a[i][kk], acc[i][j], 0, 0, 0);
    }
#pragma unroll
    for (int i = 0; i < 4; ++i)
#pragma unroll
        for (int j = 0; j < 4; ++j) { epi(16 * i + fr, 16 * j + 4 * fq, acc[i][j]); asm volatile("" ::: "memory"); }
#else
    for (int i = 0; i < 4; ++i) {
        const bf16* ar = arow(16 * i + fr);
        for (int j = 0; j < 4; ++j) {
            f32x4 acc = (f32x4){0.f, 0.f, 0.f, 0.f};
#pragma unroll
            for (int r = 0; r < 4; ++r) {
                const bf16* br = brow(16 * j + 4 * fq + r);
                float s = 0.f;
                for (int k = 0; k < K; k += 8) {
                    u32x4 av = *(const u32x4*)(ar + k), bv = *(const u32x4*)(br + k);
#pragma unroll
                    for (int q = 0; q < 4; ++q) { s += bflo(av[q]) * bflo(bv[q]); s += bfhi(av[q]) * bfhi(bv[q]); }
                }
                acc[r] = s;
            }
            epi(16 * i + fr, 16 * j + 4 * fq, acc);
        }
    }
#endif
}

__device__ __forceinline__ void transpose_item(const float* W, int K, int N, bf16* WT, int rmul, int radd, float* scr, int item, int lane) {
    const int nblk = (N + 31) / 32, kb = item / nblk, nb = item % nblk, k0 = 64 * kb, n0 = 32 * nb;
    const int ncol = n0 + (lane & 31);
#pragma unroll 8
    for (int i = 0; i < 32; ++i) { const int kk = 2 * i + (lane >> 5); scr[kk * 33 + (lane & 31)] = ncol < N ? W[(size_t)(k0 + kk) * N + ncol] : 0.f; }
    LDS_FENCE();
    const int c = lane & 7;
#pragma unroll
    for (int j = 0; j < 4; ++j) { const int n = (lane >> 3) + 8 * j; const float* s = scr + (8 * c) * 33 + n;
        u32x4 o; o.x = pk2(s[0 * 33], s[1 * 33]); o.y = pk2(s[2 * 33], s[3 * 33]); o.z = pk2(s[4 * 33], s[5 * 33]); o.w = pk2(s[6 * 33], s[7 * 33]);
        *(u32x4*)(WT + (size_t)(radd + rmul * (n0 + n)) * K + k0 + 8 * c) = o; }
    LDS_FENCE();
}

namespace pg8 {
#define PG8_LAS __attribute__((address_space(3)))
constexpr int BM = 256, BK = 64, HALF = 128, HTB = HALF * BK * 2, STAGE_BYTES = 8 * HTB, NXCD = 8, WGM = 8;
__host__ __device__ __forceinline__ int lds_byte(int r, int c) { const int st = (r >> 4) * 2 + (c >> 5), rr = r & 15, cc = c & 31, ob = rr * 64 + cc * 2; return st * 1024 + (ob ^ (((ob >> 9) & 1) << 5)); }
__host__ __device__ __forceinline__ void stage_rc(int b, int& R, int& C) { const int st = b / 1024, sb = b % 1024, swz = sb ^ (((sb >> 9) & 1) << 5); R = (st >> 1) * 16 + swz / 64; C = (st & 1) * 32 + (swz % 64) / 2; }
__host__ __device__ __forceinline__ int perm32(int rho) { const int n = rho >> 4, i = rho & 15; return 8 * (i >> 2) + 4 * n + (i & 3); }

struct Unit { const char* A; const char* B; const int* list; int r0, nrows; int pm, pn, aux; };

struct StaticOrder {
    const char* A; const char* B; int lda, K; int nM, nN, nwg, G, c;
    __device__ void init(const void* A_, const void* B_, int lda_, int K_, int M, int N, int G_, int c_) { A = (const char*)A_; B = (const char*)B_; lda = lda_; K = K_; nM = M / BM; nN = N / BM; nwg = nM * nN; G = G_; c = c_; }
    __device__ bool next(int i, Unit& u) const {
        const long L = (long)i * G + c; if (L >= nwg) return false;
        int wgid = (int)L; { const int q = nwg / NXCD, r = nwg % NXCD, xcd = wgid % NXCD, off = wgid / NXCD; wgid = (xcd < r ? xcd * (q + 1) : r * (q + 1) + (xcd - r) * q) + off; }
        const int nig = WGM * nN, gid = wgid / nig, fm = gid * WGM, gsz = (nM - fm) < WGM ? (nM - fm) : WGM;
        u.pm = fm + ((wgid % nig) % gsz); u.pn = (wgid % nig) / gsz;
        u.A = A + (size_t)u.pm * BM * lda * 2; u.B = B + (size_t)u.pn * BM * K * 2; u.list = nullptr; u.r0 = 0; u.nrows = BM; u.aux = 0; return true;
    }
};

__device__ __forceinline__ unsigned cvt_pk_bf16(float lo, float hi) { unsigned r; asm volatile("v_cvt_pk_bf16_f32 %0, %1, %2" : "=v"(r) : "v"(lo), "v"(hi)); return r; }

template <class Epi, class Sched, bool GATHER, bool ALIGN_EPI = true>
__device__ __forceinline__ void gemm_phase(PG8_LAS unsigned char* lds, const int K, const int lda, const Sched& S, const Epi& E) {
    const int tid = threadIdx.x, wid = __builtin_amdgcn_readfirstlane(tid >> 6), lane = tid & 63, wr = wid >> 2, wc = wid & 3, fr = lane & 15, fq = lane >> 4;
    const int nt = K / BK;
    int RA[2], CA[2]; unsigned voffA[2], voffB[2];
#pragma unroll
    for (int i = 0; i < 2; ++i) { int R, C; stage_rc(tid * 16 + i * 8192, R, C); const int Rb = Epi::PERM ? ((R & ~31) + perm32(R & 31)) : R;
        RA[i] = R; CA[i] = C; voffA[i] = (unsigned)(R * lda + C) * 2u; voffB[i] = (unsigned)(Rb * K + C) * 2u; }
    const size_t kstep = (size_t)(BK * 2);
    const size_t hstepA = (size_t)HALF * lda * 2, hstepB = (size_t)HALF * K * 2;
    const unsigned ldsw = (unsigned)wid * 1024u;
    const int aoff = lds_byte(wr * 64 + fr, fq * 8), boff = lds_byte(wc * 32 + fr, fq * 8);
    unsigned offC[2][2], offN[2][2];
#define PG8_SA(b, h) (((b) * 2 + (h)) * HTB)
#define PG8_SB(b, h) ((4 + (b) * 2 + (h)) * HTB)
#define PG8_GL(ptr, bufoff, i_) __builtin_amdgcn_global_load_lds((const unsigned*)(ptr), (PG8_LAS unsigned*)(lds + (bufoff) + ldsw + (i_) * 8192), 16, 0, 0)
#define PG8_STAGE_B(bufoff, gbase) do { _Pragma("unroll") for (int _i = 0; _i < 2; ++_i) PG8_GL((const char*)(gbase) + voffB[_i], bufoff, _i); } while (0)
#define PG8_STAGE_A(bufoff, h, kb, NX) do { const char* _b = (NX) ? nA : cA; _Pragma("unroll") for (int _i = 0; _i < 2; ++_i) { \
        if constexpr (GATHER) { if (NX) PG8_GL(_b + (kb) + offN[h][_i], bufoff, _i); else PG8_GL(_b + (kb) + offC[h][_i], bufoff, _i); } \
        else PG8_GL(_b + (kb) + (h) * hstepA + voffA[_i], bufoff, _i); } } while (0)
#define PG8_LDA(dst, b, h) do { _Pragma("unroll") for (int m = 0; m < 4; ++m) _Pragma("unroll") for (int k = 0; k < 2; ++k) dst[m][k] = *(const PG8_LAS bf16x8*)(lds + PG8_SA(b, h) + aoff + m * 2048 + k * 1024); } while (0)
#define PG8_LDB(dst, b, h) do { _Pragma("unroll") for (int n = 0; n < 2; ++n) _Pragma("unroll") for (int k = 0; k < 2; ++k) dst[n][k] = *(const PG8_LAS bf16x8*)(lds + PG8_SB(b, h) + boff + n * 2048 + k * 1024); } while (0)
#define PG8_MMA(ai, bj, At, Bt) do { __builtin_amdgcn_s_setprio(1); _Pragma("unroll") for (int m = 0; m < 4; ++m) _Pragma("unroll") for (int n = 0; n < 2; ++n) _Pragma("unroll") for (int k = 0; k < 2; ++k) \
        acc[ai][bj][m][n] = __builtin_amdgcn_mfma_f32_16x16x32_bf16(Bt[n][k], At[m][k], acc[ai][bj][m][n], 0, 0, 0); __builtin_amdgcn_s_setprio(0); } while (0)
#define PG8_WAIT_V(n) asm volatile("s_waitcnt vmcnt(" #n ")" ::: "memory")
#define PG8_WAIT_L(n) asm volatile("s_waitcnt lgkmcnt(" #n ")" ::: "memory")
#define PG8_BAR __builtin_amdgcn_s_barrier()
#define PG8_SCHED __builtin_amdgcn_sched_barrier(0)
#define PG8_GOFF(dst, u) do { if constexpr (GATHER) { _Pragma("unroll") for (int _h = 0; _h < 2; ++_h) _Pragma("unroll") for (int _i = 0; _i < 2; ++_i) { \
        int _r = (u).r0 + _h * HALF + RA[_i]; _r = _r < (u).nrows ? _r : (u).nrows - 1; dst[_h][_i] = (unsigned)((u).list[_r] * lda + CA[_i]) * 2u; } } } while (0)
    Unit cur, nxt; int ui = 0;
    if (!S.next(0, cur)) return;
    f32x4 acc[2][2][4][2];
#pragma unroll
    for (int a = 0; a < 2; ++a)
#pragma unroll
        for (int b = 0; b < 2; ++b)
#pragma unroll
            for (int m = 0; m < 4; ++m)
#pragma unroll
                for (int n = 0; n < 2; ++n) acc[a][b][m][n] = (f32x4){0.f, 0.f, 0.f, 0.f};
    bf16x8 At[4][2], B0[2][2], B1[2][2];
    const char* cA = cur.A; const char* cB = cur.B; const char* nA = cA; const char* nB = cB;
    PG8_GOFF(offC, cur); PG8_GOFF(offN, cur);
    PG8_STAGE_B(PG8_SB(0, 0), cB); PG8_STAGE_B(PG8_SB(0, 1), cB + hstepB); PG8_STAGE_A(PG8_SA(0, 0), 0, 0, false); PG8_STAGE_A(PG8_SA(0, 1), 1, 0, false);
    if (wr == 1) PG8_BAR;
    PG8_WAIT_V(2); PG8_BAR;
    PG8_STAGE_B(PG8_SB(1, 0), cB + kstep); PG8_STAGE_A(PG8_SA(1, 0), 0, kstep, false); PG8_STAGE_B(PG8_SB(1, 1), cB + hstepB + kstep);
    PG8_WAIT_V(6); PG8_BAR;
    for (;;) {
        const bool has_next = S.next(ui + 1, nxt);
        nA = has_next ? nxt.A : cA; nB = has_next ? nxt.B : cB;
        if (has_next) PG8_GOFF(offN, nxt); else { if constexpr (GATHER) { _Pragma("unroll") for (int _h = 0; _h < 2; ++_h) _Pragma("unroll") for (int _i = 0; _i < 2; ++_i) offN[_h][_i] = offC[_h][_i]; } }
        for (int t = 0; t < nt; t += 2) {
            const bool last = (t == nt - 2);
            const size_t k1 = (size_t)(t + 1) * kstep;
            const size_t k2 = last ? 0 : (size_t)(t + 2) * kstep, k3 = k2 + kstep;
            const char* b2 = last ? nB : cB + (size_t)(t + 2) * kstep; const char* b3 = b2 + kstep;
            PG8_LDB(B0, 0, 0); PG8_LDB(B1, 0, 1); PG8_SCHED; PG8_LDA(At, 0, 0); PG8_STAGE_A(PG8_SA(1, 1), 1, k1, false);
            PG8_WAIT_V(8); PG8_WAIT_L(0); PG8_BAR; PG8_MMA(0, 0, At, B0); PG8_MMA(0, 1, At, B1); PG8_BAR; PG8_SCHED;
            PG8_LDA(At, 0, 1); PG8_STAGE_B(PG8_SB(0, 0), b2); PG8_STAGE_B(PG8_SB(0, 1), b2 + hstepB); PG8_STAGE_A(PG8_SA(0, 0), 0, k2, last);
            PG8_WAIT_V(8); PG8_WAIT_L(0); PG8_BAR; PG8_MMA(1, 0, At, B0); PG8_MMA(1, 1, At, B1); PG8_BAR; PG8_SCHED;
            PG8_LDB(B0, 1, 0); PG8_LDB(B1, 1, 1); PG8_SCHED; PG8_LDA(At, 1, 0); PG8_STAGE_A(PG8_SA(0, 1), 1, k2, last);
            PG8_WAIT_V(8); PG8_WAIT_L(0); PG8_BAR; PG8_MMA(0, 0, At, B0); PG8_MMA(0, 1, At, B1); PG8_BAR; PG8_SCHED;
            PG8_LDA(At, 1, 1); PG8_STAGE_B(PG8_SB(1, 0), b3); PG8_STAGE_B(PG8_SB(1, 1), b3 + hstepB); PG8_STAGE_A(PG8_SA(1, 0), 0, k3, last);
            PG8_WAIT_V(8); PG8_WAIT_L(0); PG8_BAR; PG8_MMA(1, 0, At, B0); PG8_MMA(1, 1, At, B1); PG8_BAR; PG8_SCHED;
        }
        if constexpr (ALIGN_EPI) { if (wr == 0) PG8_BAR; }
        E(acc, cur, wr, wc, fr, fq);
        if (!has_next) break;
#pragma unroll
        for (int a = 0; a < 2; ++a)
#pragma unroll
            for (int b = 0; b < 2; ++b)
#pragma unroll
                for (int m = 0; m < 4; ++m)
#pragma unroll
                    for (int n = 0; n < 2; ++n) acc[a][b][m][n] = (f32x4){0.f, 0.f, 0.f, 0.f};
        cur = nxt; cA = nA; cB = nB; ++ui;
        if constexpr (GATHER) { _Pragma("unroll") for (int _h = 0; _h < 2; ++_h) _Pragma("unroll") for (int _i = 0; _i < 2; ++_i) offC[_h][_i] = offN[_h][_i]; }
        if constexpr (ALIGN_EPI) { if (wr == 1) PG8_BAR; }
    }
    PG8_WAIT_V(0);
    if constexpr (!ALIGN_EPI) { if (wr == 0) PG8_BAR; }
    PG8_BAR;
#undef PG8_SA
#undef PG8_SB
#undef PG8_GL
#undef PG8_STAGE_A
#undef PG8_STAGE_B
#undef PG8_LDA
#undef PG8_LDB
#undef PG8_MMA
#undef PG8_WAIT_V
#undef PG8_WAIT_L
#undef PG8_BAR
#undef PG8_SCHED
#undef PG8_GOFF
}
struct EpiRaw {
    static constexpr bool PERM = true; bf16* O; int ldc;
    __device__ __forceinline__ void operator()(const f32x4 (&acc)[2][2][4][2], const Unit& u, int wr, int wc, int fr, int fq) const {
#pragma unroll
        for (int ai = 0; ai < 2; ++ai)
#pragma unroll
            for (int m = 0; m < 4; ++m) { bf16* rowp = O + (size_t)(u.pm * BM + ai * HALF + wr * 64 + m * 16 + fr) * ldc + u.pn * BM + wc * 32 + 8 * fq;
#pragma unroll
                for (int bj = 0; bj < 2; ++bj) { const f32x4 v0 = acc[ai][bj][m][0], v1 = acc[ai][bj][m][1];
                    u32x4 w; w.x = cvt_pk_bf16(v0[0], v0[1]); w.y = cvt_pk_bf16(v0[2], v0[3]); w.z = cvt_pk_bf16(v1[0], v1[1]); w.w = cvt_pk_bf16(v1[2], v1[3]);
                    *(u32x4*)(rowp + bj * HALF) = w; } }
    }
};
struct EpiOutRes {
    static constexpr bool PERM = false; const float* x; float* out; const float* mod;
    __device__ __forceinline__ void operator()(const f32x4 (&acc)[2][2][4][2], const Unit& u, int wr, int wc, int fr, int fq) const {
        const int b = (u.pm * BM) / SEQ; const int col0 = u.pn * BM + wc * 32 + 4 * fq;
        f32x4 g[2][2];
#pragma unroll
        for (int bj = 0; bj < 2; ++bj)
#pragma unroll
            for (int n = 0; n < 2; ++n) g[bj][n] = *(const f32x4*)(mod + b * 6144 + 2048 + col0 + bj * HALF + n * 16);
#pragma unroll
        for (int ai = 0; ai < 2; ++ai)
#pragma unroll
            for (int m = 0; m < 4; ++m) { const size_t off = (size_t)(u.pm * BM + ai * HALF + wr * 64 + m * 16 + fr) * DM + col0;
#pragma unroll
                for (int bj = 0; bj < 2; ++bj)
#pragma unroll
                    for (int n = 0; n < 2; ++n) { const f32x4 xv = *(const f32x4*)(x + off + bj * HALF + n * 16); *(f32x4*)(out + off + bj * HALF + n * 16) = xv + g[bj][n] * acc[ai][bj][m][n]; }
                asm volatile("" ::: "memory"); }
    }
};
struct EpiRouter {
    static constexpr bool PERM = false; float* LG;
    __device__ __forceinline__ void operator()(const f32x4 (&acc)[2][2][4][2], const Unit& u, int wr, int wc, int fr, int fq) const {
#pragma unroll
        for (int ai = 0; ai < 2; ++ai)
#pragma unroll
            for (int m = 0; m < 4; ++m)
#pragma unroll
                for (int n = 0; n < 2; ++n) *(f32x4*)(LG + (size_t)(u.pm * BM + ai * HALF + wr * 64 + m * 16 + fr) * 128 + wc * 32 + n * 16 + 4 * fq) = acc[ai][0][m][n];
    }
};
struct EpiCmp {
    static constexpr bool PERM = false; float* HID; const float* posb;
    __device__ __forceinline__ void operator()(const f32x4 (&acc)[2][2][4][2], const Unit& u, int wr, int wc, int fr, int fq) const {
        const int kv = u.pm >= 16 ? 1 : 0; const int col0 = wc * 32 + 4 * fq;
#pragma unroll
        for (int bj = 0; bj < 2; ++bj)
#pragma unroll
            for (int n = 0; n < 2; ++n) { const f32x4 pb = *(const f32x4*)(posb + kv * 256 + col0 + bj * HALF + n * 16);
#pragma unroll
                for (int ai = 0; ai < 2; ++ai)
#pragma unroll
                    for (int m = 0; m < 4; ++m) { const f32x4 v = acc[ai][bj][m][n] + pb; f32x4 o; o.x = silu_f(v.x); o.y = silu_f(v.y); o.z = silu_f(v.z); o.w = silu_f(v.w);
                        *(f32x4*)(HID + (size_t)(u.pm * BM + ai * HALF + wr * 64 + m * 16 + fr) * 256 + col0 + bj * HALF + n * 16) = o; } }
    }
};
struct EpiMoe1 {
    static constexpr bool PERM = true; bf16* H;
    __device__ __forceinline__ void operator()(const f32x4 (&acc)[2][2][4][2], const Unit& u, int wr, int wc, int fr, int fq) const {
#pragma unroll
        for (int ai = 0; ai < 2; ++ai)
#pragma unroll
            for (int m = 0; m < 4; ++m) { bf16* rowp = H + (size_t)(u.aux + ai * HALF + wr * 64 + m * 16 + fr) * 512 + ((u.pn * BM + wc * 32 + 8 * fq) >> 1);
#pragma unroll
                for (int bj = 0; bj < 2; ++bj) { const f32x4 v0 = acc[ai][bj][m][0], v1 = acc[ai][bj][m][1];
                    u32x2 w; w.x = cvt_pk_bf16(silu_f(v0[0]) * v0[1], silu_f(v0[2]) * v0[3]); w.y = cvt_pk_bf16(silu_f(v1[0]) * v1[1], silu_f(v1[2]) * v1[3]);
                    *(u32x2*)(rowp + bj * (HALF / 2)) = w; } }
    }
};
struct EpiMoe2 {
    static constexpr bool PERM = false; float* out; const float* mod;
    __device__ __forceinline__ void operator()(const f32x4 (&acc)[2][2][4][2], const Unit& u, int wr, int wc, int fr, int fq) const {
        const int col0 = u.pn * BM + wc * 32 + 4 * fq; const float* roww = (const float*)((const char*)u.list + (WS_ROWW - WS_LISTS));
#pragma unroll
        for (int ai = 0; ai < 2; ++ai)
#pragma unroll
            for (int m = 0; m < 4; ++m) { const int r = u.r0 + ai * HALF + wr * 64 + m * 16 + fr;
                if (r < u.nrows) { const int tok = u.list[r]; const float w = roww[r]; const int b = tok / SEQ; float* o = out + (size_t)tok * DM + col0; const float* g2 = mod + b * 6144 + 5120 + col0;
#pragma unroll
                    for (int bj = 0; bj < 2; ++bj)
#pragma unroll
                        for (int n = 0; n < 2; ++n) { const f32x4 gv = *(const f32x4*)(g2 + bj * HALF + n * 16); f32x4* op = (f32x4*)(o + bj * HALF + n * 16); *op = *op + gv * (acc[ai][bj][m][n] * w); } }
                asm volatile("" ::: "memory"); }
    }
};
__device__ __forceinline__ int xcd_remap(int L, int total) { const int q = total / NXCD, r = total % NXCD, xcd = L % NXCD, off = L / NXCD; return (xcd < r ? xcd * (q + 1) : r * (q + 1) + (xcd - r) * q) + off; }
__device__ __forceinline__ int find_list(const int* tb, int R, int lo, int hi) { while (hi - lo > 1) { const int mid = (lo + hi) >> 1; if (tb[mid] <= R) lo = mid; else hi = mid; } return lo; }
struct CmpOrder {
    const char* A; const char* B; int c;
    __device__ bool next(int i, Unit& u) const { if (i > 0 || c >= 32) return false; u.pm = c; u.pn = 0; u.A = A + (size_t)c * BM * 1024 * 2; u.B = B + (size_t)(c >= 16 ? 1 : 0) * 256 * 2048 * 2; u.list = nullptr; u.r0 = 0; u.nrows = BM; u.aux = 0; return true; }
};
struct MoeOrder1 {
    const char* XNb; const char* W13; const int* LISTS; const unsigned* cnt; const int* tb; int G, c;
    __device__ bool next(int i, Unit& u) const {
        const int total = tb[128] * 4; const long L0 = (long)i * G + c; if (L0 >= total) return false;
        const int L = xcd_remap((int)L0, total); const int R = L >> 2, pn = L & 3, idx = find_list(tb, R, 0, 128), e = idx & 63;
        u.pm = R; u.pn = pn; u.A = XNb; u.B = W13 + ((size_t)e * 1024 + pn * BM) * 1024 * 2; u.list = LISTS + (size_t)idx * T; u.r0 = (R - tb[idx]) * BM; u.nrows = (int)cnt[idx]; u.aux = R * BM; return true;
    }
};
struct MoeOrder2 {
    const char* Hb; const char* W2T; const int* LISTS; const unsigned* cnt; const int* tb; int G, c, k;
    __device__ bool next(int i, Unit& u) const {
        const int R0 = tb[64 * k], total = (tb[64 * k + 64] - R0) * 4; const long L0 = (long)i * G + c; if (L0 >= total) return false;
        const int L = xcd_remap((int)L0, total); const int R = R0 + (L >> 2), pn = L & 3, idx = find_list(tb, R, 64 * k, 64 * k + 64), e = idx & 63;
        u.pm = R; u.pn = pn; u.A = Hb + (size_t)R * BM * 512 * 2; u.B = W2T + ((size_t)e * 1024 + pn * BM) * 512 * 2; u.list = LISTS + (size_t)idx * T; u.r0 = (R - tb[idx]) * BM; u.nrows = (int)cnt[idx]; u.aux = 0; return true;
    }
};
}


__device__ void ph_mod(const P& p, int blk, int nblk, float* shb) {
    const float* c = p.in[1]; const float* w_ada = p.in[2]; const float* b_ada = p.in[3];
    float* mod = (float*)(p.ws + WS_MOD);
    const int tid = threadIdx.x, wave = tid >> 6, lane = tid & 63, nw = blockDim.x >> 6;
    for (int task = blk; task < 96; task += nblk) {
        const int col = task * 64 + lane;
        float a0 = 0.f, a1 = 0.f;
        const int kper = 1024 / nw;
        for (int k = wave * kper; k < (wave + 1) * kper; ++k) {
            const float w = w_ada[(size_t)k * 6144 + col];
            a0 += silu_f(c[k]) * w; a1 += silu_f(c[1024 + k]) * w;
        }
        shb[(wave * 2 + 0) * 64 + lane] = a0; shb[(wave * 2 + 1) * 64 + lane] = a1;
        __syncthreads();
        if (wave < 2) { float s = 0.f; for (int w = 0; w < nw; ++w) s += shb[(w * 2 + wave) * 64 + lane]; mod[wave * 6144 + col] = s + b_ada[col]; }
        __syncthreads();
    }
    float* posb = (float*)(p.ws + WS_POSB);
    for (int task = blk; task < 8; task += nblk) {
        const int kv = task >> 2, col = (task & 3) * 64 + lane;
        const float* pos = p.in[8 + kv]; const float* w1 = p.in[kv == 0 ? 10 : 12];
        float a = 0.f; const int kper = 2048 / nw;
        for (int k = wave * kper; k < (wave + 1) * kper; ++k) a += pos[k] * w1[(size_t)k * 256 + col];
        shb[wave * 64 + lane] = a;
        __syncthreads();
        if (wave == 0) { float s = 0.f; for (int w = 0; w < nw; ++w) s += shb[w * 64 + lane]; posb[kv * 256 + col] = s; }
        __syncthreads();
    }
}

__device__ void ph_wprep_a(const P& p, int gw, int ngw, float* scr) {
    const int lane = threadIdx.x & 63;
    bf16* WIN_T = (bf16*)(p.ws + WS_WIN_T); bf16* WOUT_T = (bf16*)(p.ws + WS_WOUT_T); bf16* CW1_T = (bf16*)(p.ws + WS_CW1_T); bf16* WR_T = (bf16*)(p.ws + WS_WR_T);
    constexpr int I_IN = (1024 / 64) * 89, I_OUT = 16 * 32, I_C = (2048 / 64) * 8;
    for (int it = gw; it < I_IN + I_OUT + 2 * I_C; it += ngw) {
        int r = it;
        if (r < I_IN) { transpose_item(p.in[5], 1024, NIN, WIN_T, 1, 0, scr, r, lane); continue; } r -= I_IN;
        if (r < I_OUT) { transpose_item(p.in[16], 1024, 1024, WOUT_T, 1, 0, scr, r, lane); continue; } r -= I_OUT;
        if (r < I_C) { transpose_item(p.in[10], 2048, 256, CW1_T, 1, 0, scr, r, lane); continue; } r -= I_C;
        transpose_item(p.in[12], 2048, 256, CW1_T + 256 * 2048, 1, 0, scr, r, lane);
    }
    for (int i = gw * 64 + lane; i < 224 * 1024 / 8; i += ngw * 64) *(u32x4*)(WIN_T + (size_t)2848 * 1024 + (size_t)i * 8) = (u32x4){0u, 0u, 0u, 0u};
    for (int i = gw * 64 + lane; i < 256 * 1024; i += ngw * 64) {
        const int n = i >> 10, k = i & 1023; float v = 0.f;
        if (n < 8) v = p.in[19][k * 8 + n]; else if (n < 72) v = p.in[21][k * 64 + (n - 8)];
        WR_T[i] = (bf16)f2bf(v);
    }
}
__device__ void ph_wprep_moe(const P& p, int gw, int ngw, float* scr) {
    const int lane = threadIdx.x & 63;
    bf16* W13 = (bf16*)(p.ws + WS_W13_T); bf16* W2T = (bf16*)(p.ws + WS_W2_T);
    constexpr int I_13 = (1024 / 64) * (512 / 32), I_2 = (512 / 64) * (1024 / 32);
    for (int it = gw; it < NEXP * (2 * I_13 + I_2); it += ngw) {
        const int e = it / (2 * I_13 + I_2); int r = it % (2 * I_13 + I_2);
        if (r < I_13) { transpose_item(p.in[23] + (size_t)e * 1024 * 512, 1024, 512, W13 + (size_t)e * 1024 * 1024, 2, 0, scr, r, lane); continue; } r -= I_13;
        if (r < I_13) { transpose_item(p.in[24] + (size_t)e * 1024 * 512, 1024, 512, W13 + (size_t)e * 1024 * 1024, 2, 1, scr, r, lane); continue; } r -= I_13;
        transpose_item(p.in[25] + (size_t)e * 512 * 1024, 512, 1024, W2T + (size_t)e * 1024 * 512, 1, 0, scr, r, lane);
    }
}

__device__ void ph_rownorm(const P& p, int gw, int ngw, const float* src, int which) {
    const int lane = threadIdx.x & 63;
    const float* nw = p.in[which == 0 ? 4 : 18];
    const float* mod = (const float*)(p.ws + WS_MOD);
    bf16* XN = (bf16*)(p.ws + WS_XN);
    f32x4 wv[4];
#pragma unroll
    for (int j = 0; j < 4; ++j) wv[j] = *(const f32x4*)(nw + 4 * lane + 256 * j);
    for (int row = gw; row < T; row += ngw) {
        const int b = row / SEQ;
        const float* sh = mod + b * 6144 + (which == 0 ? 0 : 3072); const float* sc = sh + 1024;
        const f32x4* xr = (const f32x4*)(src + (size_t)row * DM) + lane;
        f32x4 v[4]; float s = 0.f;
#pragma unroll
        for (int j = 0; j < 4; ++j) { v[j] = xr[64 * j]; s += v[j].x * v[j].x + v[j].y * v[j].y + v[j].z * v[j].z + v[j].w * v[j].w; }
        const float rstd = rsqrtf(wave_sum(s) * (1.f / DM) + EPS);
        unsigned long long* o8 = (unsigned long long*)(XN + (size_t)row * DM) + lane;
#pragma unroll
        for (int j = 0; j < 4; ++j) {
            const f32x4 scv = *(const f32x4*)(sc + 4 * lane + 256 * j), shv = *(const f32x4*)(sh + 4 * lane + 256 * j);
            const f32x4 h = v[j] * rstd * wv[j] * (scv + 1.f) + shv;
            o8[64 * j] = (unsigned long long)pk2(h.x, h.y) | ((unsigned long long)pk2(h.z, h.w) << 32);
        }
    }
}

__device__ void ph_post(const P& p, int gw, int ngw) {
    const int lane = threadIdx.x & 63;
    const bf16* RAW = (const bf16*)(p.ws + WS_R1);
    bf16* Q = (bf16*)(p.ws + WS_Q); bf16* KV = (bf16*)(p.ws + WS_KV); float* GATES = (float*)(p.ws + WS_GATES); bf16* MIX = (bf16*)(p.ws + WS_MIX);
    const float qw = p.in[6][lane], kw1 = p.in[7][64 + lane], kw2 = p.in[7][128 + lane];
    const float* conv_w = p.in[14]; const float* onw = p.in[15];
    for (int t = gw; t < T; t += ngw) {
        const int b = t / SEQ, s = t % SEQ;
        const bf16* r = RAW + (size_t)t * NINP;
#pragma unroll
        for (int h = 0; h < 8; ++h) {
            const float v = bf2f(r[h * 64 + lane]);
            const float rs = rsqrtf(wave_sum(v * v) * (1.f / 64.f) + EPS);
            Q[((size_t)t * 8 + h) * 64 + lane] = (bf16)f2bf(v * rs * qw);
        }
#pragma unroll
        for (int i = 0; i < 6; ++i)
#pragma unroll
            for (int g = 0; g < 2; ++g) {
                float v = bf2f(r[512 + i * 128 + g * 64 + lane]);
                if (i == 2 || i == 4) { const float rs = rsqrtf(wave_sum(v * v) * (1.f / 64.f) + EPS); v = v * rs * (i == 2 ? kw1 : kw2); }
                KV[((((size_t)i * 2 + b) * 2 + g) * SEQ + s) * 64 + lane] = (bf16)f2bf(v);
            }
        if (lane < 24) GATES[(size_t)t * 24 + lane] = 1.f / (1.f + __expf(-bf2f(r[1280 + lane])));
#pragma unroll
        for (int j = 0; j < 8; ++j) {
            const int c = j * 64 + lane;
            float acc = 0.f;
#pragma unroll
            for (int d = 0; d < 3; ++d) {
                const int sd = s - 2 + d;
                if (sd >= 0) { const bf16* rr = RAW + (size_t)(t - 2 + d) * NINP; acc += conv_w[d * 512 + c] * bf2f(rr[1816 + c]) * bf2f(rr[2328 + c]); }
            }
            const float y = bf2f(r[1304 + c]) * acc;
            const float rs = rsqrtf(wave_sum(y * y) * (1.f / 64.f) + EPS);
            MIX[(size_t)t * DM + 512 + c] = (bf16)f2bf(y * rs * onw[512 + c]);
        }
    }
}

__device__ void ph_cmp_fin(const P& p, int gw, int ngw) {
    const int lane = threadIdx.x & 63;
    const float* HID = (const float*)(p.ws + WS_HID); bf16* KCVC = (bf16*)(p.ws + WS_KCVC);
    const float kw0 = p.in[7][lane];
    for (int r = gw; r < 2 * 4096; r += ngw) {
        const int kv = r / 4096, row = r % 4096, n = row & 1023;
        float o = 0.f;
        if (n < NC) {
            const float* w2 = p.in[kv == 0 ? 11 : 13]; const float* h = HID + (size_t)r * 256;
            for (int j = 0; j < 256; ++j) o += h[j] * w2[j * 64 + lane];
            if (kv == 0) { const float rs = rsqrtf(wave_sum(o * o) * (1.f / 64.f) + EPS); o = o * rs * kw0; }
        }
        KCVC[(size_t)r * 64 + lane] = (bf16)f2bf(o);
    }
}

struct AttnLds { float qs[4][64]; float ps[64][4]; float imp[256]; };
__device__ __forceinline__ void attn_qk(const bf16* krow, const float (*qs)[64], float s[4]) {
    s[0] = s[1] = s[2] = s[3] = 0.f;
#pragma unroll 2
    for (int c = 0; c < 8; ++c) {
        asm volatile("" ::: "memory");
        const u32x4 kvv = *(const u32x4*)(krow + 8 * c);
        float kf[8]; kf[0] = bflo(kvv.x); kf[1] = bfhi(kvv.x); kf[2] = bflo(kvv.y); kf[3] = bfhi(kvv.y); kf[4] = bflo(kvv.z); kf[5] = bfhi(kvv.z); kf[6] = bflo(kvv.w); kf[7] = bfhi(kvv.w);
#pragma unroll
        for (int h = 0; h < 4; ++h) {
            const f32x4 q0 = *(const f32x4*)(&qs[h][8 * c]), q1 = *(const f32x4*)(&qs[h][8 * c + 4]);
            s[h] += kf[0] * q0.x + kf[1] * q0.y + kf[2] * q0.z + kf[3] * q0.w + kf[4] * q1.x + kf[5] * q1.y + kf[6] * q1.z + kf[7] * q1.w;
        }
    }
}
__device__ __forceinline__ void attn_pv(const bf16* vbase, const float (*ps)[4], int lane, float o[4]) {
    for (int j = 0; j < 64; ++j) {
        const f32x4 pj = *(const f32x4*)(&ps[j][0]);
        const float v = bf2f(vbase[(size_t)j * 64 + lane]);
        o[0] += pj.x * v; o[1] += pj.y * v; o[2] += pj.z * v; o[3] += pj.w * v;
    }
}
__device__ void ph_attn_naive(const P& p, int gw, int ngw, AttnLds* L, const float* biasT  ) {
    const int lane = threadIdx.x & 63;
    const bf16* Q = (const bf16*)(p.ws + WS_Q); const bf16* KV = (const bf16*)(p.ws + WS_KV); const bf16* KCVC = (const bf16*)(p.ws + WS_KCVC);
    const float* GATES = (const float*)(p.ws + WS_GATES); bf16* MIX = (bf16*)(p.ws + WS_MIX); const float* onw = p.in[15];
    for (int item = gw; item < T * 2; item += ngw) {
        const int t = item >> 1, g = item & 1, b = t / SEQ, pos = t % SEQ, cur = pos >> 6;
#pragma unroll
        for (int h = 0; h < 4; ++h) L->qs[h][lane] = bf2f(Q[((size_t)t * 8 + 4 * g + h) * 64 + lane]) * 0.125f;
        for (int i = lane; i < 256; i += 64) L->imp[i] = 0.f;
        LDS_FENCE();
        const bf16* KC = KCVC + ((size_t)(0 * 4 + b * 2 + g) * NCP) * 64; const bf16* VC = KCVC + ((size_t)(1 * 4 + b * 2 + g) * NCP) * 64;
        auto kvp = [&](int i) { return KV + (((size_t)i * 2 + b) * 2 + g) * SEQ * 64; };
        const int nvis = pos >= 31 ? min((pos - 31) / 16 + 1, NC) : 0;
        float lc[4] = {0.f, 0.f, 0.f, 0.f}, oc[4] = {0.f, 0.f, 0.f, 0.f};
        for (int kb = 0; kb * 64 < nvis; ++kb) {
            const int n = kb * 64 + lane; float s[4]; attn_qk(KC + (size_t)n * 64, L->qs, s);
            const int dist = pos - (16 * n + 31); const bool valid = n < nvis; const int bi = min(max(dist, 0), 128);
#pragma unroll
            for (int h = 0; h < 4; ++h) lc[h] += valid ? __expf(s[h] + biasT[bi * 8 + 4 * g + h]) : 0.f;
        }
        float rlc[4];
#pragma unroll
        for (int h = 0; h < 4; ++h) { lc[h] = wave_sum(lc[h]); rlc[h] = lc[h] > 0.f ? 1.f / lc[h] : 0.f; }
        for (int kb = 0; kb * 64 < nvis; ++kb) {
            const int n = kb * 64 + lane; float s[4]; attn_qk(KC + (size_t)n * 64, L->qs, s);
            const int dist = pos - (16 * n + 31); const bool valid = n < nvis; const int bi = min(max(dist, 0), 128);
            float w = 0.f; float pe[4];
#pragma unroll
            for (int h = 0; h < 4; ++h) { pe[h] = valid ? __expf(s[h] + biasT[bi * 8 + 4 * g + h]) : 0.f; w += pe[h] * rlc[h]; }
            LDS_FENCE();
            *(f32x4*)(&L->ps[lane][0]) = (f32x4){pe[0], pe[1], pe[2], pe[3]};
            if (valid) { atomicAdd(&L->imp[n >> 2], w); if ((n & 3) == 3 && (n >> 2) + 1 < NS) atomicAdd(&L->imp[(n >> 2) + 1], w); }
            LDS_FENCE();
            attn_pv(VC + (size_t)kb * 64 * 64, L->ps, lane, oc);
        }
        LDS_FENCE();
        float sc[4];
#pragma unroll
        for (int j = 0; j < 4; ++j) { const int s = lane * 4 + j; const bool forced = (s == 0) || (s == cur) || (s == cur - 1);
            sc[j] = forced ? 1e4f : (s <= cur ? L->imp[s] : -1.f); }
        float ls[4] = {0.f, 0.f, 0.f, 0.f}, os[4] = {0.f, 0.f, 0.f, 0.f};
        for (int r = 0; r < 16; ++r) {
            float bv = sc[0]; int bi_ = lane * 4;
#pragma unroll
            for (int j = 1; j < 4; ++j) if (sc[j] > bv) { bv = sc[j]; bi_ = lane * 4 + j; }
#pragma unroll
            for (int o = 1; o < 64; o <<= 1) { const float ov = __shfl_xor(bv, o); const int oi = __shfl_xor(bi_, o); if (ov > bv || (ov == bv && oi < bi_)) { bv = ov; bi_ = oi; } }
            if (!(bv >= 0.f)) break;
            if ((bi_ >> 2) == lane) {
#pragma unroll
                for (int j = 0; j < 4; ++j) if ((bi_ & 3) == j) sc[j] = -3.0e38f;
            }
            const int kpos = bi_ * 64 + lane; float s[4]; attn_qk(kvp(2) + (size_t)kpos * 64, L->qs, s);
            const int dist = pos - kpos; const bool valid = dist >= 0; const int bx = min(max(dist, 0), 128);
            float pe[4];
#pragma unroll
            for (int h = 0; h < 4; ++h) { pe[h] = valid ? __expf(s[h] + biasT[bx * 8 + 4 * g + h]) : 0.f; ls[h] += pe[h]; }
            LDS_FENCE();
            *(f32x4*)(&L->ps[lane][0]) = (f32x4){pe[0], pe[1], pe[2], pe[3]};
            LDS_FENCE();
            attn_pv(kvp(3) + (size_t)bi_ * 64 * 64, L->ps, lane, os);
        }
        float lw[4] = {0.f, 0.f, 0.f, 0.f}, ow[4] = {0.f, 0.f, 0.f, 0.f};
        const int kstart = max(0, pos - 511);
        for (int blk = kstart >> 6; blk <= cur; ++blk) {
            const int kpos = blk * 64 + lane; float s[4]; attn_qk(kvp(4) + (size_t)kpos * 64, L->qs, s);
            const int dist = pos - kpos; const bool valid = dist >= 0 && kpos >= kstart; const int bx = min(max(dist, 0), 128);
            float pe[4];
#pragma unroll
            for (int h = 0; h < 4; ++h) { pe[h] = valid ? __expf(s[h] + biasT[bx * 8 + 4 * g + h]) : 0.f; lw[h] += pe[h]; }
            LDS_FENCE();
            *(f32x4*)(&L->ps[lane][0]) = (f32x4){pe[0], pe[1], pe[2], pe[3]};
            LDS_FENCE();
            attn_pv(kvp(5) + (size_t)blk * 64 * 64, L->ps, lane, ow);
        }
        LDS_FENCE();
#pragma unroll
        for (int h = 0; h < 4; ++h) {
            const float l_s = wave_sum(ls[h]), l_w = wave_sum(lw[h]);
            const float* gt = GATES + (size_t)t * 24 + (4 * g + h) * 3;
            const float o = gt[0] * oc[h] * rlc[h] + gt[1] * os[h] * (l_s > 0.f ? 1.f / l_s : 0.f) + gt[2] * ow[h] * (l_w > 0.f ? 1.f / l_w : 0.f);
            const float rs = rsqrtf(wave_sum(o * o) * (1.f / 64.f) + EPS);
            const int c = (4 * g + h) * 64 + lane;
            MIX[(size_t)t * DM + c] = (bf16)f2bf(o * rs * onw[c]);
        }
    }
}
__device__ void build_bias_table(const P& p, float* biasT) {
    for (int i = threadIdx.x; i < 129 * 8; i += blockDim.x) {
        const int d = i >> 3, h = i & 7; int bk;
        if (d < 16) bk = d; else { bk = 16 + (int)(logf((float)d / 16.f) / logf(8.f) * 16.f); bk = min(bk, 31); }
        biasT[i] = p.in[17][bk * 8 + h];
    }
    __syncthreads();
}

__device__ void ph_route(const P& p, int gtid, int nthreads) {
    const float* LG = (const float*)(p.ws + WS_LOGITS); unsigned* cnt = (unsigned*)(p.ws + WS_CTL) + CW_CNT;
    int* LISTS = (int*)(p.ws + WS_LISTS); float* ROWW = (float*)(p.ws + WS_ROWW);
    const float* bg = p.in[20]; const float* be = p.in[22];
    for (int t = gtid; t < T; t += nthreads) {
        const float* l = LG + (size_t)t * 128;
        float gl[8]; float gm = -3.0e38f; int gi = 0;
#pragma unroll
        for (int i = 0; i < 8; ++i) { gl[i] = l[i] + bg[i]; if (gl[i] > gm) { gm = gl[i]; gi = i; } }
        float gs = 0.f;
#pragma unroll
        for (int i = 0; i < 8; ++i) gs += __expf(gl[i] - gm);
        const float gp = 1.f / gs;
        float el[8]; float m0 = -3.0e38f, m1 = -3.0e38f; int i0 = 0, i1 = 0;
#pragma unroll
        for (int i = 0; i < 8; ++i) { el[i] = l[8 + gi * 8 + i] + be[gi * 8 + i];
            if (el[i] > m0) { m1 = m0; i1 = i0; m0 = el[i]; i0 = i; } else if (el[i] > m1) { m1 = el[i]; i1 = i; } }
        const float e1 = __expf(m1 - m0); const float p0 = 1.f / (1.f + e1), p1 = e1 / (1.f + e1);
        const int ex0 = gi * 8 + i0, ex1 = gi * 8 + i1;
        const unsigned s0 = atomicAdd(&cnt[ex0], 1u), s1 = atomicAdd(&cnt[64 + ex1], 1u);
        LISTS[(size_t)ex0 * T + s0] = t; ROWW[(size_t)ex0 * T + s0] = gp * p0;
        LISTS[(size_t)(64 + ex1) * T + s1] = t; ROWW[(size_t)(64 + ex1) * T + s1] = gp * p1;
    }
}
__device__ void build_tile_base(const P& p, int* tb) {
    const unsigned* cnt = (const unsigned*)(p.ws + WS_CTL) + CW_CNT;
    if (threadIdx.x == 0) { int s = 0; for (int i = 0; i < 128; ++i) { tb[i] = s; s += ((int)cnt[i] + 255) >> 8; } tb[128] = s; }
    __syncthreads();
}
#define LAS __attribute__((address_space(3)))
#define XB_TMO      128
#define XB_XCNT(j)  (256  + 64 * (j))
#define XB_XSUB(j)  (1280 + 64 * (j))
#define XB_XGEN(j)  (2304 + 64 * (j))
#define XB_TOP      3328
#define XB_TOPGEN   3392
#define XCD_BAR_WORDS 3456
#define XB_SPIN_CAP (1u << 18)
constexpr int CW_BAR = 4096;
__device__ __forceinline__ unsigned xb_ld(unsigned* p)              { return __hip_atomic_load(p, __ATOMIC_RELAXED, __HIP_MEMORY_SCOPE_AGENT); }
__device__ __forceinline__ unsigned xb_add(unsigned* p, unsigned v) { return __hip_atomic_fetch_add(p, v, __ATOMIC_RELAXED, __HIP_MEMORY_SCOPE_AGENT); }
__device__ __forceinline__ unsigned xb_xcc_id() { return (unsigned)__builtin_amdgcn_s_getreg((3 << 11) | 20) & 0xFu; }
#define XB_SPIN(cond, bar) do { unsigned _sp = 0; while (cond) { __builtin_amdgcn_s_sleep(1); \
    if ((++_sp & 255u) == 0u) { if (xb_ld(&(bar)[XB_TMO])) break; if (_sp > XB_SPIN_CAP) { atomicAdd(&(bar)[XB_TMO], 1u); break; } } } } while (0)
struct XcdBarrier { unsigned* bar; unsigned x; volatile LAS unsigned* st; };
__device__ __forceinline__ XcdBarrier xcd_barrier_post(unsigned* bar, volatile LAS unsigned* st) {
    XcdBarrier b; b.bar = bar; b.x = xb_xcc_id(); b.st = st;
    if (threadIdx.x == 0) (void)xb_add(&bar[XB_XCNT(b.x)], 1u);
    return b;
}
__device__ __forceinline__ void xcd_barrier_complete(unsigned* bar, unsigned x, unsigned& nloc, unsigned& nx) {
    const unsigned G = gridDim.x * gridDim.y * gridDim.z;
    unsigned sum, cnt, mine, sp = 0u;
    for (;;) {
        sum = 0u; cnt = 0u; mine = 0u;
#pragma unroll
        for (unsigned j = 0; j < 16; ++j) { const unsigned c = xb_ld(&bar[XB_XCNT(j)]); sum += c; cnt += (c > 0u) ? 1u : 0u; mine = (j == x) ? c : mine; }
        if (sum == G) break;
        __builtin_amdgcn_s_sleep(1);
        if ((++sp & 255u) == 0u) { if (xb_ld(&bar[XB_TMO])) break; if (sp > XB_SPIN_CAP) { atomicAdd(&bar[XB_TMO], 1u); break; } }
    }
    nloc = mine > 0u ? mine : 1u; nx = cnt > 0u ? cnt : 1u;
}
__device__ __forceinline__ void xcd_barrier(const XcdBarrier& b) {
    asm volatile("s_waitcnt vmcnt(0)" ::: "memory");
    __syncthreads();
    if (threadIdx.x == 0) {
        unsigned* bar = b.bar;
        __builtin_amdgcn_s_waitcnt(0);
        unsigned nloc = b.st[0], nx = b.st[1];
        if (nloc == 0u) { xcd_barrier_complete(bar, b.x, nloc, nx); b.st[0] = nloc; b.st[1] = nx; }
        const unsigned old = xb_add(&bar[XB_XSUB(b.x)], 1u);
        const unsigned gen = old / nloc;
        if (old + 1u == (gen + 1u) * nloc) {
            __builtin_amdgcn_fence(__ATOMIC_RELEASE, "agent");
            asm volatile("s_waitcnt vmcnt(0)" ::: "memory");
            const unsigned og = xb_add(&bar[XB_TOP], 1u);
            const unsigned tg = og / nx;
            if (og + 1u == (tg + 1u) * nx) xb_add(&bar[XB_TOPGEN], 1u);
            else XB_SPIN(xb_ld(&bar[XB_TOPGEN]) == tg, bar);
            __builtin_amdgcn_fence(__ATOMIC_ACQUIRE, "agent");
            xb_add(&bar[XB_XGEN(b.x)], 1u);
            asm volatile("s_waitcnt vmcnt(0)" ::: "memory");
        } else {
            XB_SPIN(xb_ld(&bar[XB_XGEN(b.x)]) == gen, bar);
            __builtin_amdgcn_fence(__ATOMIC_ACQUIRE, "agent");
            asm volatile("s_waitcnt vmcnt(0)" ::: "memory");
        }
    }
    __syncthreads();
}

constexpr int NT = 512;
constexpr int LDS_SCR = 0, LDS_SHB = 131072, LDS_MISC = LDS_SHB + 8192, LDS_BYTES = 147456;
__global__ void __launch_bounds__(NT) mega(P p) {
    extern __shared__ __attribute__((aligned(16))) unsigned char ldsb[];
    float* lds = (float*)ldsb;
    const int tid = threadIdx.x, wave = tid >> 6;
    const int gw = blockIdx.x * (NT / 64) + wave, ngw = gridDim.x * (NT / 64);
    float* scr = lds + wave * (8448 / 4); float* shb = lds + LDS_SHB / 4;
    volatile LAS unsigned* misc = (volatile LAS unsigned*)((LAS unsigned char*)ldsb + LDS_MISC);
    if (tid < 16) misc[tid] = 0u;
    __syncthreads();
    XcdBarrier bar = xcd_barrier_post((unsigned*)(p.ws + WS_CTL) + CW_BAR, misc);
#define GB() xcd_barrier(bar)
    PG8_LAS unsigned char* ring = (PG8_LAS unsigned char*)ldsb;
    const int G = gridDim.x, cb = blockIdx.x;
    ph_mod(p, blockIdx.x, gridDim.x, shb); ph_wprep_a(p, gw, ngw, scr); GB();
    ph_rownorm(p, gw, ngw, p.in[0], 0); GB();
    { pg8::StaticOrder S; S.init(p.ws + WS_XN, p.ws + WS_WIN_T, DM, DM, T, NINP, G, cb); pg8::EpiRaw E{(bf16*)(p.ws + WS_R1), NINP};
      pg8::gemm_phase<pg8::EpiRaw, pg8::StaticOrder, false>(ring, DM, DM, S, E); } GB();
    ph_post(p, gw, ngw); GB();
    if (cb < 32) { pg8::CmpOrder S{(const char*)(p.ws + WS_KV), (const char*)(p.ws + WS_CW1_T), cb}; pg8::EpiCmp E{(float*)(p.ws + WS_HID), (const float*)(p.ws + WS_POSB)};
      pg8::gemm_phase<pg8::EpiCmp, pg8::CmpOrder, false>(ring, 2048, 1024, S, E); }
    else ph_wprep_moe(p, gw - 32 * (NT / 64), ngw - 32 * (NT / 64), scr);
    GB();
    ph_cmp_fin(p, gw, ngw); GB();
    build_bias_table(p, shb); ph_attn_naive(p, gw, ngw, (AttnLds*)scr, shb); GB();
    { pg8::StaticOrder S; S.init(p.ws + WS_MIX, p.ws + WS_WOUT_T, DM, DM, T, DM, G, cb); pg8::EpiOutRes E{p.in[0], p.out, (const float*)(p.ws + WS_MOD)};
      pg8::gemm_phase<pg8::EpiOutRes, pg8::StaticOrder, false>(ring, DM, DM, S, E); } GB();
    ph_rownorm(p, gw, ngw, p.out, 1); GB();
    { pg8::StaticOrder S; S.init(p.ws + WS_XN, p.ws + WS_WR_T, DM, DM, T, 256, G, cb); pg8::EpiRouter E{(float*)(p.ws + WS_LOGITS)};
      pg8::gemm_phase<pg8::EpiRouter, pg8::StaticOrder, false>(ring, DM, DM, S, E); } GB();
    ph_route(p, blockIdx.x * NT + tid, gridDim.x * NT); GB();
    build_tile_base(p, (int*)shb);
    const unsigned* cnt = (const unsigned*)(p.ws + WS_CTL) + CW_CNT;
    { pg8::MoeOrder1 S{(const char*)(p.ws + WS_XN), (const char*)(p.ws + WS_W13_T), (const int*)(p.ws + WS_LISTS), cnt, (const int*)shb, G, cb}; pg8::EpiMoe1 E{(bf16*)(p.ws + WS_H)};
      pg8::gemm_phase<pg8::EpiMoe1, pg8::MoeOrder1, true>(ring, DM, DM, S, E); } GB();
    { pg8::MoeOrder2 S{(const char*)(p.ws + WS_H), (const char*)(p.ws + WS_W2_T), (const int*)(p.ws + WS_LISTS), cnt, (const int*)shb, G, cb, 0}; pg8::EpiMoe2 E{p.out, (const float*)(p.ws + WS_MOD)};
      pg8::gemm_phase<pg8::EpiMoe2, pg8::MoeOrder2, false>(ring, 512, 512, S, E); } GB();
    { pg8::MoeOrder2 S{(const char*)(p.ws + WS_H), (const char*)(p.ws + WS_W2_T), (const int*)(p.ws + WS_LISTS), cnt, (const int*)shb, G, cb, 1}; pg8::EpiMoe2 E{p.out, (const float*)(p.ws + WS_MOD)};
      pg8::gemm_phase<pg8::EpiMoe2, pg8::MoeOrder2, false>(ring, 512, 512, S, E); }
}

extern "C" void kernel_launch(void* const* d_in, const int* in_sizes, int n_in, void* d_out, int out_size, void* d_ws, size_t ws_size, hipStream_t stream) {
    static int ready = 0;
    if (ready == 0) {
        if (n_in != 26 || ws_size < WS_END) { fprintf(stderr, "kernel_launch: bad args n_in=%d ws=%zu\n", n_in, ws_size); ready = -1; return; }
        if (hipFuncSetAttribute((const void*)mega, hipFuncAttributeMaxDynamicSharedMemorySize, LDS_BYTES) != hipSuccess) { fprintf(stderr, "kernel_launch: hipFuncSetAttribute failed\n"); ready = -1; return; }
        ready = 1;
    }
    if (ready < 0) return;
    P p{};
    for (int i = 0; i < 26; ++i) p.in[i] = (const float*)d_in[i];
    p.out = (float*)d_out; p.ws = (unsigned char*)d_ws;
    (void)hipMemsetAsync((char*)d_ws + WS_CTL, 0, 1 * MiB, stream);
    hipLaunchKernelGGL(mega, dim3(256), dim3(NT), LDS_BYTES, stream, p);
}
```

```cpp
#include <hip/hip_runtime.h>
#include <stdint.h>
#include <stdio.h>

#ifndef NAIVE_GEMM
#define NAIVE_GEMM 0
#endif

typedef unsigned short bf16;
typedef short bf16x8 __attribute__((ext_vector_type(8)));
typedef float f32x4 __attribute__((ext_vector_type(4)));
typedef unsigned u32x4 __attribute__((ext_vector_type(4)));
typedef unsigned u32x2 __attribute__((ext_vector_type(2)));

constexpr int BATCH = 2, SEQ = 16384, DM = 1024, T = BATCH * SEQ;
constexpr int NIN = 2840, NINP = 3072;
constexpr int NC = 1023, NCP = 1024, NS = 256;
constexpr int NEXP = 64;
constexpr float EPS = 1e-6f;

constexpr size_t MiB = 1u << 20;
constexpr size_t WS_CTL = 0;
constexpr size_t WS_MOD = 1 * MiB;
constexpr size_t WS_POSB = 1 * MiB + 65536;
constexpr size_t WS_WIN_T = 2 * MiB;
constexpr size_t WS_WOUT_T = 8 * MiB;
constexpr size_t WS_CW1_T = 10 * MiB;
constexpr size_t WS_WR_T = 12 * MiB;
constexpr size_t WS_HID = 13 * MiB;
constexpr size_t WS_KCVC = 21 * MiB;
constexpr size_t WS_GATES = 22 * MiB;
constexpr size_t WS_LOGITS = 25 * MiB;
constexpr size_t WS_LISTS = 41 * MiB;
constexpr size_t WS_ROWW = 57 * MiB;
constexpr size_t WS_XN = 73 * MiB;
constexpr size_t WS_R1 = 137 * MiB;
constexpr size_t WS_W13_T = WS_R1;
constexpr size_t WS_W2_T = WS_R1 + 128 * MiB;
constexpr size_t WS_Q = 329 * MiB;
constexpr size_t WS_KV = 361 * MiB;
constexpr size_t WS_H = 329 * MiB;
constexpr size_t WS_MIX = 418 * MiB;
constexpr size_t WS_END = 482 * MiB;

constexpr int CW_CNT = 0;

struct P {
    const float* in[26];
    float* out;
    unsigned char* ws;
};

__device__ __forceinline__ unsigned f2bf(float f) { unsigned u = __builtin_bit_cast(unsigned, f); return (u + 0x7fffu + ((u >> 16) & 1u)) >> 16; }
__device__ __forceinline__ unsigned pk2(float lo, float hi) { return f2bf(lo) | (f2bf(hi) << 16); }
__device__ __forceinline__ float bf2f(unsigned short h) { return __builtin_bit_cast(float, (unsigned)h << 16); }
__device__ __forceinline__ float bflo(unsigned u) { return __builtin_bit_cast(float, u << 16); }
__device__ __forceinline__ float bfhi(unsigned u) { return __builtin_bit_cast(float, u & 0xffff0000u); }
__device__ __forceinline__ float wave_sum(float v) {
#pragma unroll
    for (int o = 1; o < 64; o <<= 1) v += __shfl_xor(v, o);
    return v;
}
__device__ __forceinline__ float silu_f(float v) { return v / (1.f + __expf(-v)); }
#define LDS_FENCE() asm volatile("s_waitcnt lgkmcnt(0)" ::: "memory")
__device__ __forceinline__ int opq_tid() { int t = threadIdx.x; asm volatile("" : "+v"(t)); return t; }

template <class AR, class BR, class EPI>
__device__ __forceinline__ void wave_gemm_64x64(AR arow, BR brow, int K, EPI epi) {
    const int lane = threadIdx.x & 63, fr = lane & 15, fq = lane >> 4;
#if !NAIVE_GEMM
    const bf16* ap[4]; const bf16* bp[4];
#pragma unroll
    for (int i = 0; i < 4; ++i) { ap[i] = arow(16 * i + fr) + fq * 8; bp[i] = brow(16 * i + fr) + fq * 8; }
    f32x4 acc[4][4];
#pragma unroll
    for (int i = 0; i < 4; ++i)
#pragma unroll
        for (int j = 0; j < 4; ++j) acc[i][j] = (f32x4){0.f, 0.f, 0.f, 0.f};
#pragma unroll 1
    for (int k = 0; k < K; k += 64) {
        bf16x8 a[4][2], b[4][2];
#pragma unroll
        for (int i = 0; i < 4; ++i) {
            a[i][0] = *(const bf16x8*)(ap[i] + k); a[i][1] = *(const bf16x8*)(ap[i] + k + 32);
            b[i][0] = *(const bf16x8*)(bp[i] + k); b[i][1] = *(const bf16x8*)(bp[i] + k + 32);
        }
#pragma unroll
        for (int kk = 0; kk < 2; ++kk)
#pragma unroll
            for (int i = 0; i < 4; ++i)
#pragma unroll
                for (int j = 0; j < 4; ++j) acc[i][j] = __builtin_amdgcn_mfma_f32_16x16x32_bf16(b[j][kk], a[i][kk], acc[i][j], 0, 0, 0);
    }
#pragma unroll
    for (int i = 0; i < 4; ++i)
#pragma unroll
        for (int j = 0; j < 4; ++j) { epi(16 * i + fr, 16 * j + 4 * fq, acc[i][j]); asm volatile("" ::: "memory"); }
#else
    for (int i = 0; i < 4; ++i) {
        const bf16* ar = arow(16 * i + fr);
        for (int j = 0; j < 4; ++j) {
            f32x4 acc = (f32x4){0.f, 0.f, 0.f, 0.f};
#pragma unroll
            for (int r = 0; r < 4; ++r) {
                const bf16* br = brow(16 * j + 4 * fq + r);
                float s = 0.f;
                for (int k = 0; k < K; k += 8) {
                    u32x4 av = *(const u32x4*)(ar + k), bv = *(const u32x4*)(br + k);
#pragma unroll
                    for (int q = 0; q < 4; ++q) { s += bflo(av[q]) * bflo(bv[q]); s += bfhi(av[q]) * bfhi(bv[q]); }
                }
                acc[r] = s;
            }
            epi(16 * i + fr, 16 * j + 4 * fq, acc);
        }
    }
#endif
}

__device__ __forceinline__ void transpose_item(const float* W, int K, int N, bf16* WT, int rmul, int radd, float* scr, int item, int lane) {
    const int nblk = (N + 31) / 32, kb = item / nblk, nb = item % nblk, k0 = 64 * kb, n0 = 32 * nb;
    const int ncol = n0 + (lane & 31);
#pragma unroll 8
    for (int i = 0; i < 32; ++i) { const int kk = 2 * i + (lane >> 5); scr[kk * 33 + (lane & 31)] = ncol < N ? W[(size_t)(k0 + kk) * N + ncol] : 0.f; }
    LDS_FENCE();
    const int c = lane & 7;
#pragma unroll
    for (int j = 0; j < 4; ++j) { const int n = (lane >> 3) + 8 * j; const float* s = scr + (8 * c) * 33 + n;
        u32x4 o; o.x = pk2(s[0 * 33], s[1 * 33]); o.y = pk2(s[2 * 33], s[3 * 33]); o.z = pk2(s[4 * 33], s[5 * 33]); o.w = pk2(s[6 * 33], s[7 * 33]);
        *(u32x4*)(WT + (size_t)(radd + rmul * (n0 + n)) * K + k0 + 8 * c) = o; }
    LDS_FENCE();
}

namespace pg8 {
#define PG8_LAS __attribute__((address_space(3)))
constexpr int BM = 256, BK = 64, HALF = 128, HTB = HALF * BK * 2, STAGE_BYTES = 8 * HTB, NXCD = 8, WGM = 8;
__host__ __device__ __forceinline__ int lds_byte(int r, int c) { const int st = (r >> 4) * 2 + (c >> 5), rr = r & 15, cc = c & 31, ob = rr * 64 + cc * 2; return st * 1024 + (ob ^ (((ob >> 9) & 1) << 5)); }
__host__ __device__ __forceinline__ void stage_rc(int b, int& R, int& C) { const int st = b / 1024, sb = b % 1024, swz = sb ^ (((sb >> 9) & 1) << 5); R = (st >> 1) * 16 + swz / 64; C = (st & 1) * 32 + (swz % 64) / 2; }
__host__ __device__ __forceinline__ int perm32(int rho) { const int n = rho >> 4, i = rho & 15; return 8 * (i >> 2) + 4 * n + (i & 3); }

struct Unit { const char* A; const char* B; const int* list; int r0, nrows; int pm, pn, aux; };

struct StaticOrder {
    const char* A; const char* B; int lda, K; int nM, nN, nwg, G, c;
    __device__ void init(const void* A_, const void* B_, int lda_, int K_, int M, int N, int G_, int c_) { A = (const char*)A_; B = (const char*)B_; lda = lda_; K = K_; nM = M / BM; nN = N / BM; nwg = nM * nN; G = G_; c = c_; }
    __device__ bool next(int i, Unit& u) const {
        const long L = (long)i * G + c; if (L >= nwg) return false;
        int wgid = (int)L; { const int q = nwg / NXCD, r = nwg % NXCD, xcd = wgid % NXCD, off = wgid / NXCD; wgid = (xcd < r ? xcd * (q + 1) : r * (q + 1) + (xcd - r) * q) + off; }
        const int nig = WGM * nN, gid = wgid / nig, fm = gid * WGM, gsz = (nM - fm) < WGM ? (nM - fm) : WGM;
        u.pm = fm + ((wgid % nig) % gsz); u.pn = (wgid % nig) / gsz;
        u.A = A + (size_t)u.pm * BM * lda * 2; u.B = B + (size_t)u.pn * BM * K * 2; u.list = nullptr; u.r0 = 0; u.nrows = BM; u.aux = 0; return true;
    }
};

__device__ __forceinline__ unsigned cvt_pk_bf16(float lo, float hi) { unsigned r; asm volatile("v_cvt_pk_bf16_f32 %0, %1, %2" : "=v"(r) : "v"(lo), "v"(hi)); return r; }

template <class Epi, class Sched, bool GATHER, bool ALIGN_EPI = true>
__device__ __forceinline__ void gemm_phase(PG8_LAS unsigned char* lds, const int K, const int lda, const Sched& S, const Epi& E) {
    const int tid = opq_tid(), wid = __builtin_amdgcn_readfirstlane(tid >> 6), lane = tid & 63, wr = wid >> 2, wc = wid & 3, fr = lane & 15, fq = lane >> 4;
    const int nt = K / BK;
    int RA[2], CA[2]; unsigned voffA[2], voffB[2];
#pragma unroll
    for (int i = 0; i < 2; ++i) { int R, C; stage_rc(tid * 16 + i * 8192, R, C); const int Rb = Epi::PERM ? ((R & ~31) + perm32(R & 31)) : R;
        RA[i] = R; CA[i] = C; voffA[i] = (unsigned)(R * lda + C) * 2u; voffB[i] = (unsigned)(Rb * K + C) * 2u; }
    const size_t kstep = (size_t)(BK * 2);
    const size_t hstepA = (size_t)HALF * lda * 2, hstepB = (size_t)HALF * K * 2;
    const unsigned ldsw = (unsigned)wid * 1024u;
    const int aoff = lds_byte(wr * 64 + fr, fq * 8), boff = lds_byte(wc * 32 + fr, fq * 8);
    unsigned offC[2][2], offN[2][2];
#define PG8_SA(b, h) (((b) * 2 + (h)) * HTB)
#define PG8_SB(b, h) ((4 + (b) * 2 + (h)) * HTB)
#define PG8_GL(ptr, bufoff, i_) __builtin_amdgcn_global_load_lds((const unsigned*)(ptr), (PG8_LAS unsigned*)(lds + (bufoff) + ldsw + (i_) * 8192), 16, 0, 0)
#define PG8_STAGE_B(bufoff, gbase) do { _Pragma("unroll") for (int _i = 0; _i < 2; ++_i) PG8_GL((const char*)(gbase) + voffB[_i], bufoff, _i); } while (0)
#define PG8_STAGE_A(bufoff, h, kb, NX) do { const char* _b = (NX) ? nA : cA; _Pragma("unroll") for (int _i = 0; _i < 2; ++_i) { \
        if constexpr (GATHER) { if (NX) PG8_GL(_b + (kb) + offN[h][_i], bufoff, _i); else PG8_GL(_b + (kb) + offC[h][_i], bufoff, _i); } \
        else PG8_GL(_b + (kb) + (h) * hstepA + voffA[_i], bufoff, _i); } } while (0)
#define PG8_LDA(dst, b, h) do { _Pragma("unroll") for (int m = 0; m < 4; ++m) _Pragma("unroll") for (int k = 0; k < 2; ++k) dst[m][k] = *(const PG8_LAS bf16x8*)(lds + PG8_SA(b, h) + aoff + m * 2048 + k * 1024); } while (0)
#define PG8_LDB(dst, b, h) do { _Pragma("unroll") for (int n = 0; n < 2; ++n) _Pragma("unroll") for (int k = 0; k < 2; ++k) dst[n][k] = *(const PG8_LAS bf16x8*)(lds + PG8_SB(b, h) + boff + n * 2048 + k * 1024); } while (0)
#define PG8_MMA(ai, bj, At, Bt) do { __builtin_amdgcn_s_setprio(1); _Pragma("unroll") for (int m = 0; m < 4; ++m) _Pragma("unroll") for (int n = 0; n < 2; ++n) _Pragma("unroll") for (int k = 0; k < 2; ++k) \
        acc[ai][bj][m][n] = __builtin_amdgcn_mfma_f32_16x16x32_bf16(Bt[n][k], At[m][k], acc[ai][bj][m][n], 0, 0, 0); __builtin_amdgcn_s_setprio(0); } while (0)
#define PG8_WAIT_V(n) asm volatile("s_waitcnt vmcnt(" #n ")" ::: "memory")
#define PG8_WAIT_L(n) asm volatile("s_waitcnt lgkmcnt(" #n ")" ::: "memory")
#define PG8_BAR __builtin_amdgcn_s_barrier()
#define PG8_SCHED __builtin_amdgcn_sched_barrier(0)
#define PG8_GOFF(dst, u) do { if constexpr (GATHER) { _Pragma("unroll") for (int _h = 0; _h < 2; ++_h) _Pragma("unroll") for (int _i = 0; _i < 2; ++_i) { \
        int _r = (u).r0 + _h * HALF + RA[_i]; _r = _r < (u).nrows ? _r : (u).nrows - 1; dst[_h][_i] = (unsigned)((u).list[_r] * lda + CA[_i]) * 2u; } } } while (0)
    Unit cur, nxt; int ui = 0;
    if (!S.next(0, cur)) return;
    f32x4 acc[2][2][4][2];
#pragma unroll
    for (int a = 0; a < 2; ++a)
#pragma unroll
        for (int b = 0; b < 2; ++b)
#pragma unroll
            for (int m = 0; m < 4; ++m)
#pragma unroll
                for (int n = 0; n < 2; ++n) acc[a][b][m][n] = (f32x4){0.f, 0.f, 0.f, 0.f};
    bf16x8 At[4][2], B0[2][2], B1[2][2];
    const char* cA = cur.A; const char* cB = cur.B; const char* nA = cA; const char* nB = cB;
    PG8_GOFF(offC, cur); PG8_GOFF(offN, cur);
    PG8_STAGE_B(PG8_SB(0, 0), cB); PG8_STAGE_B(PG8_SB(0, 1), cB + hstepB); PG8_STAGE_A(PG8_SA(0, 0), 0, 0, false); PG8_STAGE_A(PG8_SA(0, 1), 1, 0, false);
    if (wr == 1) PG8_BAR;
    PG8_WAIT_V(2); PG8_BAR;
    PG8_STAGE_B(PG8_SB(1, 0), cB + kstep); PG8_STAGE_A(PG8_SA(1, 0), 0, kstep, false); PG8_STAGE_B(PG8_SB(1, 1), cB + hstepB + kstep);
    PG8_WAIT_V(6); PG8_BAR;
    for (;;) {
        const bool has_next = S.next(ui + 1, nxt);
        nA = has_next ? nxt.A : cA; nB = has_next ? nxt.B : cB;
        if (has_next) PG8_GOFF(offN, nxt); else { if constexpr (GATHER) { _Pragma("unroll") for (int _h = 0; _h < 2; ++_h) _Pragma("unroll") for (int _i = 0; _i < 2; ++_i) offN[_h][_i] = offC[_h][_i]; } }
        for (int t = 0; t < nt; t += 2) {
            const bool last = (t == nt - 2);
            const size_t k1 = (size_t)(t + 1) * kstep;
            const size_t k2 = last ? 0 : (size_t)(t + 2) * kstep, k3 = k2 + kstep;
            const char* b2 = last ? nB : cB + (size_t)(t + 2) * kstep; const char* b3 = b2 + kstep;
            PG8_LDB(B0, 0, 0); PG8_LDB(B1, 0, 1); PG8_SCHED; PG8_LDA(At, 0, 0); PG8_STAGE_A(PG8_SA(1, 1), 1, k1, false);
            PG8_WAIT_V(8); PG8_WAIT_L(0); PG8_BAR; PG8_MMA(0, 0, At, B0); PG8_MMA(0, 1, At, B1); PG8_BAR; PG8_SCHED;
            PG8_LDA(At, 0, 1); PG8_STAGE_B(PG8_SB(0, 0), b2); PG8_STAGE_B(PG8_SB(0, 1), b2 + hstepB); PG8_STAGE_A(PG8_SA(0, 0), 0, k2, last);
            PG8_WAIT_V(8); PG8_WAIT_L(0); PG8_BAR; PG8_MMA(1, 0, At, B0); PG8_MMA(1, 1, At, B1); PG8_BAR; PG8_SCHED;
            PG8_LDB(B0, 1, 0); PG8_LDB(B1, 1, 1); PG8_SCHED; PG8_LDA(At, 1, 0); PG8_STAGE_A(PG8_SA(0, 1), 1, k2, last);
            PG8_WAIT_V(8); PG8_WAIT_L(0); PG8_BAR; PG8_MMA(0, 0, At, B0); PG8_MMA(0, 1, At, B1); PG8_BAR; PG8_SCHED;
            PG8_LDA(At, 1, 1); PG8_STAGE_B(PG8_SB(1, 0), b3); PG8_STAGE_B(PG8_SB(1, 1), b3 + hstepB); PG8_STAGE_A(PG8_SA(1, 0), 0, k3, last);
            PG8_WAIT_V(8); PG8_WAIT_L(0); PG8_BAR; PG8_MMA(1, 0, At, B0); PG8_MMA(1, 1, At, B1); PG8_BAR; PG8_SCHED;
        }
        if constexpr (ALIGN_EPI) { if (wr == 0) PG8_BAR; }
        E(acc, cur, wr, wc, fr, fq);
        if (!has_next) break;
#pragma unroll
        for (int a = 0; a < 2; ++a)
#pragma unroll
            for (int b = 0; b < 2; ++b)
#pragma unroll
                for (int m = 0; m < 4; ++m)
#pragma unroll
                    for (int n = 0; n < 2; ++n) acc[a][b][m][n] = (f32x4){0.f, 0.f, 0.f, 0.f};
        cur = nxt; cA = nA; cB = nB; ++ui;
        if constexpr (GATHER) { _Pragma("unroll") for (int _h = 0; _h < 2; ++_h) _Pragma("unroll") for (int _i = 0; _i < 2; ++_i) offC[_h][_i] = offN[_h][_i]; }
        if constexpr (ALIGN_EPI) { if (wr == 1) PG8_BAR; }
    }
    PG8_WAIT_V(0);
    if constexpr (!ALIGN_EPI) { if (wr == 0) PG8_BAR; }
    PG8_BAR;
#undef PG8_SA
#undef PG8_SB
#undef PG8_GL
#undef PG8_STAGE_A
#undef PG8_STAGE_B
#undef PG8_LDA
#undef PG8_LDB
#undef PG8_MMA
#undef PG8_WAIT_V
#undef PG8_WAIT_L
#undef PG8_BAR
#undef PG8_SCHED
#undef PG8_GOFF
}
struct EpiRaw {
    static constexpr bool PERM = true; bf16* O; int ldc;
    __device__ __forceinline__ void operator()(const f32x4 (&acc)[2][2][4][2], const Unit& u, int wr, int wc, int fr, int fq) const {
#pragma unroll
        for (int ai = 0; ai < 2; ++ai)
#pragma unroll
            for (int m = 0; m < 4; ++m) { bf16* rowp = O + (size_t)(u.pm * BM + ai * HALF + wr * 64 + m * 16 + fr) * ldc + u.pn * BM + wc * 32 + 8 * fq;
#pragma unroll
                for (int bj = 0; bj < 2; ++bj) { const f32x4 v0 = acc[ai][bj][m][0], v1 = acc[ai][bj][m][1];
                    u32x4 w; w.x = cvt_pk_bf16(v0[0], v0[1]); w.y = cvt_pk_bf16(v0[2], v0[3]); w.z = cvt_pk_bf16(v1[0], v1[1]); w.w = cvt_pk_bf16(v1[2], v1[3]);
                    *(u32x4*)(rowp + bj * HALF) = w; } }
    }
};
struct EpiOutRes {
    static constexpr bool PERM = false; const float* x; float* out; const float* mod;
    __device__ __forceinline__ void operator()(const f32x4 (&acc)[2][2][4][2], const Unit& u, int wr, int wc, int fr, int fq) const {
        const int b = (u.pm * BM) / SEQ; const int col0 = u.pn * BM + wc * 32 + 4 * fq;
        f32x4 g[2][2];
#pragma unroll
        for (int bj = 0; bj < 2; ++bj)
#pragma unroll
            for (int n = 0; n < 2; ++n) g[bj][n] = *(const f32x4*)(mod + b * 6144 + 2048 + col0 + bj * HALF + n * 16);
#pragma unroll
        for (int ai = 0; ai < 2; ++ai)
#pragma unroll
            for (int m = 0; m < 4; ++m) { const size_t off = (size_t)(u.pm * BM + ai * HALF + wr * 64 + m * 16 + fr) * DM + col0;
#pragma unroll
                for (int bj = 0; bj < 2; ++bj)
#pragma unroll
                    for (int n = 0; n < 2; ++n) { const f32x4 xv = *(const f32x4*)(x + off + bj * HALF + n * 16); *(f32x4*)(out + off + bj * HALF + n * 16) = xv + g[bj][n] * acc[ai][bj][m][n]; }
                asm volatile("" ::: "memory"); }
    }
};
struct EpiRouter {
    static constexpr bool PERM = false; float* LG;
    __device__ __forceinline__ void operator()(const f32x4 (&acc)[2][2][4][2], const Unit& u, int wr, int wc, int fr, int fq) const {
#pragma unroll
        for (int ai = 0; ai < 2; ++ai)
#pragma unroll
            for (int m = 0; m < 4; ++m)
#pragma unroll
                for (int n = 0; n < 2; ++n) *(f32x4*)(LG + (size_t)(u.pm * BM + ai * HALF + wr * 64 + m * 16 + fr) * 128 + wc * 32 + n * 16 + 4 * fq) = acc[ai][0][m][n];
    }
};
struct EpiCmp {
    static constexpr bool PERM = false; float* HID; const float* posb;
    __device__ __forceinline__ void operator()(const f32x4 (&acc)[2][2][4][2], const Unit& u, int wr, int wc, int fr, int fq) const {
        const int kv = u.pm >= 16 ? 1 : 0; const int col0 = wc * 32 + 4 * fq;
#pragma unroll
        for (int bj = 0; bj < 2; ++bj)
#pragma unroll
            for (int n = 0; n < 2; ++n) { const f32x4 pb = *(const f32x4*)(posb + kv * 256 + col0 + bj * HALF + n * 16);
#pragma unroll
                for (int ai = 0; ai < 2; ++ai)
#pragma unroll
                    for (int m = 0; m < 4; ++m) { const f32x4 v = acc[ai][bj][m][n] + pb; f32x4 o; o.x = silu_f(v.x); o.y = silu_f(v.y); o.z = silu_f(v.z); o.w = silu_f(v.w);
                        *(f32x4*)(HID + (size_t)(u.pm * BM + ai * HALF + wr * 64 + m * 16 + fr) * 256 + col0 + bj * HALF + n * 16) = o; } }
    }
};
struct EpiMoe1 {
    static constexpr bool PERM = true; bf16* H;
    __device__ __forceinline__ void operator()(const f32x4 (&acc)[2][2][4][2], const Unit& u, int wr, int wc, int fr, int fq) const {
#pragma unroll
        for (int ai = 0; ai < 2; ++ai)
#pragma unroll
            for (int m = 0; m < 4; ++m) { bf16* rowp = H + (size_t)(u.aux + ai * HALF + wr * 64 + m * 16 + fr) * 512 + ((u.pn * BM + wc * 32 + 8 * fq) >> 1);
#pragma unroll
                for (int bj = 0; bj < 2; ++bj) { const f32x4 v0 = acc[ai][bj][m][0], v1 = acc[ai][bj][m][1];
                    u32x2 w; w.x = cvt_pk_bf16(silu_f(v0[0]) * v0[1], silu_f(v0[2]) * v0[3]); w.y = cvt_pk_bf16(silu_f(v1[0]) * v1[1], silu_f(v1[2]) * v1[3]);
                    *(u32x2*)(rowp + bj * (HALF / 2)) = w; } }
    }
};
struct EpiMoe2 {
    static constexpr bool PERM = false; float* out; const float* mod;
    __device__ __forceinline__ void operator()(const f32x4 (&acc)[2][2][4][2], const Unit& u, int wr, int wc, int fr, int fq) const {
        const int col0 = u.pn * BM + wc * 32 + 4 * fq; const float* roww = (const float*)((const char*)u.list + (WS_ROWW - WS_LISTS));
#pragma unroll
        for (int ai = 0; ai < 2; ++ai)
#pragma unroll
            for (int m = 0; m < 4; ++m) { const int r = u.r0 + ai * HALF + wr * 64 + m * 16 + fr;
                if (r < u.nrows) { const int tok = u.list[r]; const float w = roww[r]; const int b = tok / SEQ; float* o = out + (size_t)tok * DM + col0; const float* g2 = mod + b * 6144 + 5120 + col0;
#pragma unroll
                    for (int bj = 0; bj < 2; ++bj)
#pragma unroll
                        for (int n = 0; n < 2; ++n) { const f32x4 gv = *(const f32x4*)(g2 + bj * HALF + n * 16); f32x4* op = (f32x4*)(o + bj * HALF + n * 16); *op = *op + gv * (acc[ai][bj][m][n] * w); } }
                asm volatile("" ::: "memory"); }
    }
};
__device__ __forceinline__ int xcd_remap(int L, int total) { const int q = total / NXCD, r = total % NXCD, xcd = L % NXCD, off = L / NXCD; return (xcd < r ? xcd * (q + 1) : r * (q + 1) + (xcd - r) * q) + off; }
__device__ __forceinline__ int find_list(const int* tb, int R, int lo, int hi) { while (hi - lo > 1) { const int mid = (lo + hi) >> 1; if (tb[mid] <= R) lo = mid; else hi = mid; } return lo; }
struct CmpOrder {
    const char* A; const char* B; int c;
    __device__ bool next(int i, Unit& u) const { if (i > 0 || c >= 32) return false; u.pm = c; u.pn = 0; u.A = A + (size_t)c * BM * 1024 * 2; u.B = B + (size_t)(c >= 16 ? 1 : 0) * 256 * 2048 * 2; u.list = nullptr; u.r0 = 0; u.nrows = BM; u.aux = 0; return true; }
};
struct MoeOrder1 {
    const char* XNb; const char* W13; const int* LISTS; const unsigned* cnt; const int* tb; int G, c;
    __device__ bool next(int i, Unit& u) const {
        const int total = tb[128] * 4; const long L0 = (long)i * G + c; if (L0 >= total) return false;
        const int L = xcd_remap((int)L0, total); const int R = L >> 2, pn = L & 3, idx = find_list(tb, R, 0, 128), e = idx & 63;
        u.pm = R; u.pn = pn; u.A = XNb; u.B = W13 + ((size_t)e * 1024 + pn * BM) * 1024 * 2; u.list = LISTS + (size_t)idx * T; u.r0 = (R - tb[idx]) * BM; u.nrows = (int)cnt[idx]; u.aux = R * BM; return true;
    }
};
struct MoeOrder2 {
    const char* Hb; const char* W2T; const int* LISTS; const unsigned* cnt; const int* tb; int G, c, k;
    __device__ bool next(int i, Unit& u) const {
        const int R0 = tb[64 * k], total = (tb[64 * k + 64] - R0) * 4; const long L0 = (long)i * G + c; if (L0 >= total) return false;
        const int L = xcd_remap((int)L0, total); const int R = R0 + (L >> 2), pn = L & 3, idx = find_list(tb, R, 64 * k, 64 * k + 64), e = idx & 63;
        u.pm = R; u.pn = pn; u.A = Hb + (size_t)R * BM * 512 * 2; u.B = W2T + ((size_t)e * 1024 + pn * BM) * 512 * 2; u.list = LISTS + (size_t)idx * T; u.r0 = (R - tb[idx]) * BM; u.nrows = (int)cnt[idx]; u.aux = 0; return true;
    }
};
}


__device__ void ph_mod(const P& p, int blk, int nblk, float* shb) {
    const float* c = p.in[1]; const float* w_ada = p.in[2]; const float* b_ada = p.in[3];
    float* mod = (float*)(p.ws + WS_MOD);
    const int tid = opq_tid(), wave = tid >> 6, lane = tid & 63, nw = blockDim.x >> 6;
    for (int task = blk; task < 96; task += nblk) {
        const int col = task * 64 + lane;
        float a0 = 0.f, a1 = 0.f;
        const int kper = 1024 / nw;
        for (int k = wave * kper; k < (wave + 1) * kper; ++k) {
            const float w = w_ada[(size_t)k * 6144 + col];
            a0 += silu_f(c[k]) * w; a1 += silu_f(c[1024 + k]) * w;
        }
        shb[(wave * 2 + 0) * 64 + lane] = a0; shb[(wave * 2 + 1) * 64 + lane] = a1;
        __syncthreads();
        if (wave < 2) { float s = 0.f; for (int w = 0; w < nw; ++w) s += shb[(w * 2 + wave) * 64 + lane]; mod[wave * 6144 + col] = s + b_ada[col]; }
        __syncthreads();
    }
    float* posb = (float*)(p.ws + WS_POSB);
    for (int task = blk; task < 8; task += nblk) {
        const int kv = task >> 2, col = (task & 3) * 64 + lane;
        const float* pos = p.in[8 + kv]; const float* w1 = p.in[kv == 0 ? 10 : 12];
        float a = 0.f; const int kper = 2048 / nw;
        for (int k = wave * kper; k < (wave + 1) * kper; ++k) a += pos[k] * w1[(size_t)k * 256 + col];
        shb[wave * 64 + lane] = a;
        __syncthreads();
        if (wave == 0) { float s = 0.f; for (int w = 0; w < nw; ++w) s += shb[w * 64 + lane]; posb[kv * 256 + col] = s; }
        __syncthreads();
    }
}

__device__ void ph_wprep_a(const P& p, int gw, int ngw, float* scr) {
    const int lane = opq_tid() & 63;
    bf16* WIN_T = (bf16*)(p.ws + WS_WIN_T); bf16* WOUT_T = (bf16*)(p.ws + WS_WOUT_T); bf16* CW1_T = (bf16*)(p.ws + WS_CW1_T); bf16* WR_T = (bf16*)(p.ws + WS_WR_T);
    constexpr int I_IN = (1024 / 64) * 89, I_OUT = 16 * 32, I_C = (2048 / 64) * 8;
    for (int it = gw; it < I_IN + I_OUT + 2 * I_C; it += ngw) {
        int r = it;
        if (r < I_IN) { transpose_item(p.in[5], 1024, NIN, WIN_T, 1, 0, scr, r, lane); continue; } r -= I_IN;
        if (r < I_OUT) { transpose_item(p.in[16], 1024, 1024, WOUT_T, 1, 0, scr, r, lane); continue; } r -= I_OUT;
        if (r < I_C) { transpose_item(p.in[10], 2048, 256, CW1_T, 1, 0, scr, r, lane); continue; } r -= I_C;
        transpose_item(p.in[12], 2048, 256, CW1_T + 256 * 2048, 1, 0, scr, r, lane);
    }
    for (int i = gw * 64 + lane; i < 224 * 1024 / 8; i += ngw * 64) *(u32x4*)(WIN_T + (size_t)2848 * 1024 + (size_t)i * 8) = (u32x4){0u, 0u, 0u, 0u};
    for (int i = gw * 64 + lane; i < 256 * 1024; i += ngw * 64) {
        const int n = i >> 10, k = i & 1023; float v = 0.f;
        if (n < 8) v = p.in[19][k * 8 + n]; else if (n < 72) v = p.in[21][k * 64 + (n - 8)];
        WR_T[i] = (bf16)f2bf(v);
    }
}
__device__ void ph_wprep_moe(const P& p, int gw, int ngw, float* scr) {
    const int lane = opq_tid() & 63;
    bf16* W13 = (bf16*)(p.ws + WS_W13_T); bf16* W2T = (bf16*)(p.ws + WS_W2_T);
    constexpr int I_13 = (1024 / 64) * (512 / 32), I_2 = (512 / 64) * (1024 / 32);
    for (int it = gw; it < NEXP * (2 * I_13 + I_2); it += ngw) {
        const int e = it / (2 * I_13 + I_2); int r = it % (2 * I_13 + I_2);
        if (r < I_13) { transpose_item(p.in[23] + (size_t)e * 1024 * 512, 1024, 512, W13 + (size_t)e * 1024 * 1024, 2, 0, scr, r, lane); continue; } r -= I_13;
        if (r < I_13) { transpose_item(p.in[24] + (size_t)e * 1024 * 512, 1024, 512, W13 + (size_t)e * 1024 * 1024, 2, 1, scr, r, lane); continue; } r -= I_13;
        transpose_item(p.in[25] + (size_t)e * 512 * 1024, 512, 1024, W2T + (size_t)e * 1024 * 512, 1, 0, scr, r, lane);
    }
}

__device__ void ph_rownorm(const P& p, int gw, int ngw, const float* src, int which) {
    const int lane = opq_tid() & 63;
    const float* nw = p.in[which == 0 ? 4 : 18];
    const float* mod = (const float*)(p.ws + WS_MOD);
    bf16* XN = (bf16*)(p.ws + WS_XN);
    f32x4 wv[4];
#pragma unroll
    for (int j = 0; j < 4; ++j) wv[j] = *(const f32x4*)(nw + 4 * lane + 256 * j);
    for (int row = gw; row < T; row += ngw) {
        const int b = row / SEQ;
        const float* sh = mod + b * 6144 + (which == 0 ? 0 : 3072); const float* sc = sh + 1024;
        const f32x4* xr = (const f32x4*)(src + (size_t)row * DM) + lane;
        f32x4 v[4]; float s = 0.f;
#pragma unroll
        for (int j = 0; j < 4; ++j) { v[j] = xr[64 * j]; s += v[j].x * v[j].x + v[j].y * v[j].y + v[j].z * v[j].z + v[j].w * v[j].w; }
        const float rstd = rsqrtf(wave_sum(s) * (1.f / DM) + EPS);
        unsigned long long* o8 = (unsigned long long*)(XN + (size_t)row * DM) + lane;
#pragma unroll
        for (int j = 0; j < 4; ++j) {
            const f32x4 scv = *(const f32x4*)(sc + 4 * lane + 256 * j), shv = *(const f32x4*)(sh + 4 * lane + 256 * j);
            const f32x4 h = v[j] * rstd * wv[j] * (scv + 1.f) + shv;
            o8[64 * j] = (unsigned long long)pk2(h.x, h.y) | ((unsigned long long)pk2(h.z, h.w) << 32);
        }
    }
}

constexpr float QSCALE = 0.125f * 1.4426950408889634f;
__device__ __forceinline__ int vt32_slot(int kk) { const int s = kk >> 4, rem = kk & 15, h = (rem >> 2) & 1, j = ((rem >> 3) << 2) | (rem & 3); return 16 * s + 8 * h + j; }
__device__ __forceinline__ int vt16_slot(int kk) { const int ks = kk >> 5, rem = kk & 31, hi = rem >> 4, r2 = rem & 15, qr = r2 >> 2, j = (r2 & 3) + 4 * hi; return 32 * ks + 8 * qr + j; }
__device__ void ph_post(const P& p, int gw, int ngw) {
    const int lane = opq_tid() & 63;
    const bf16* RAW = (const bf16*)(p.ws + WS_R1);
    bf16* Q = (bf16*)(p.ws + WS_Q); bf16* KV = (bf16*)(p.ws + WS_KV); float* GATES = (float*)(p.ws + WS_GATES); bf16* MIX = (bf16*)(p.ws + WS_MIX);
    const float qw = p.in[6][lane], kw1 = p.in[7][64 + lane], kw2 = p.in[7][128 + lane];
    const float* conv_w = p.in[14]; const float* onw = p.in[15];
    for (int t = gw; t < T; t += ngw) {
        const int b = t / SEQ, s = t % SEQ;
        const bf16* r = RAW + (size_t)t * NINP;
#pragma unroll
        for (int h = 0; h < 8; ++h) {
            const float v = bf2f(r[h * 64 + lane]);
            const float rs = rsqrtf(wave_sum(v * v) * (1.f / 64.f) + EPS);
            Q[((size_t)t * 8 + h) * 64 + lane] = (bf16)f2bf(v * rs * qw * QSCALE);
        }
#pragma unroll
        for (int i = 0; i < 6; ++i)
#pragma unroll
            for (int g = 0; g < 2; ++g) {
                float v = bf2f(r[512 + i * 128 + g * 64 + lane]);
                if (i == 2 || i == 4) { const float rs = rsqrtf(wave_sum(v * v) * (1.f / 64.f) + EPS); v = v * rs * (i == 2 ? kw1 : kw2); }
                bf16* base = KV + (((size_t)i * 2 + b) * 2 + g) * SEQ * 64;
                if (i == 3 || i == 5) {
                    base[(size_t)(s >> 5) * 2048 + lane * 32 + vt32_slot(s & 31)] = (bf16)f2bf(v);
                    if (i == 3) (KV + (((size_t)6 * 2 + b) * 2 + g) * SEQ * 64)[(size_t)(s >> 6) * 4096 + lane * 64 + vt16_slot(s & 63)] = (bf16)f2bf(v);
                } else base[(size_t)s * 64 + lane] = (bf16)f2bf(v);
            }
        if (lane < 24) GATES[(size_t)t * 24 + lane] = 1.f / (1.f + __expf(-bf2f(r[1280 + lane])));
#pragma unroll
        for (int j = 0; j < 8; ++j) {
            const int c = j * 64 + lane;
            float acc = 0.f;
#pragma unroll
            for (int d = 0; d < 3; ++d) {
                const int sd = s - 2 + d;
                if (sd >= 0) { const bf16* rr = RAW + (size_t)(t - 2 + d) * NINP; acc += conv_w[d * 512 + c] * bf2f(rr[1816 + c]) * bf2f(rr[2328 + c]); }
            }
            const float y = bf2f(r[1304 + c]) * acc;
            const float rs = rsqrtf(wave_sum(y * y) * (1.f / 64.f) + EPS);
            MIX[(size_t)t * DM + 512 + c] = (bf16)f2bf(y * rs * onw[512 + c]);
        }
    }
}

__device__ void ph_cmp_fin(const P& p, int gw, int ngw) {
    const int lane = opq_tid() & 63;
    const float* HID = (const float*)(p.ws + WS_HID); bf16* KCVC = (bf16*)(p.ws + WS_KCVC);
    const float kw0 = p.in[7][lane];
    for (int r = gw; r < 2 * 4096; r += ngw) {
        const int kv = r / 4096, row = r % 4096, n = row & 1023;
        float o = 0.f;
        if (n < NC) {
            const float* w2 = p.in[kv == 0 ? 11 : 13]; const float* h = HID + (size_t)r * 256;
            for (int j = 0; j < 256; ++j) o += h[j] * w2[j * 64 + lane];
            if (kv == 0) { const float rs = rsqrtf(wave_sum(o * o) * (1.f / 64.f) + EPS); o = o * rs * kw0; }
        }
        if (kv == 0) KCVC[(size_t)r * 64 + lane] = (bf16)f2bf(o);
        else KCVC[(size_t)(r - n) * 64 + (size_t)(n >> 5) * 2048 + lane * 32 + vt32_slot(n & 31)] = (bf16)f2bf(o);
    }
}

typedef float f32x16 __attribute__((ext_vector_type(16)));
typedef float f32x2_t __attribute__((ext_vector_type(2))); typedef __bf16 bf16x2_t __attribute__((ext_vector_type(2)));
#define MFMA32(a, b, c) __builtin_amdgcn_mfma_f32_32x32x16_bf16((a), (b), (c), 0, 0, 0)
#define MFMA16(a, b, c) __builtin_amdgcn_mfma_f32_16x16x32_bf16((a), (b), (c), 0, 0, 0)
__device__ __forceinline__ unsigned cvtpk(float lo, float hi) { f32x2_t v = {lo, hi}; bf16x2_t b = __builtin_convertvector(v, bf16x2_t); return __builtin_bit_cast(unsigned, b); }
__device__ __forceinline__ int crow(int i, int h) { return (i & 3) + 8 * (i >> 2) + 4 * h; }
#define PACK8(x, s) __builtin_bit_cast(bf16x8, (u32x4){cvtpk(x[8 * (s)], x[8 * (s) + 1]), cvtpk(x[8 * (s) + 2], x[8 * (s) + 3]), cvtpk(x[8 * (s) + 4], x[8 * (s) + 5]), cvtpk(x[8 * (s) + 6], x[8 * (s) + 7])})
constexpr int AL_Q = 0, AL_ACC = 32768, AL_SEL = 98304, AL_NSEL = 99328, AL_ROWS = 100352;

__device__ void build_bias_table(const P& p, float* biasL) {
    for (int i = threadIdx.x; i < 129 * 8; i += blockDim.x) {
        const int d = i >> 3, h = i & 7; int bk;
        if (d < 16) bk = d; else { bk = 16 + (int)(logf((float)d / 16.f) / logf(8.f) * 16.f); bk = min(bk, 31); }
        if (d >= 128) bk = 31;
        biasL[i] = (p.in[17][bk * 8 + h] - p.in[17][31 * 8 + h]) * 1.4426950408889634f;
    }
    __syncthreads();
}
__device__ __forceinline__ f32x16 qk_tile(const bf16* krow, const bf16x8 (&qf)[4]) {
    f32x16 s;
#pragma unroll
    for (int i = 0; i < 16; ++i) s[i] = 0.f;
#pragma unroll
    for (int k = 0; k < 4; ++k) { const bf16x8 kf = *(const bf16x8*)(krow + 16 * k); s = MFMA32(kf, qf[k], s); }
    return s;
}
__device__ __forceinline__ void pv_tile(const f32x16& P, const bf16* vl, f32x16 (&O)[2]) {
    const bf16x8 pa0 = PACK8(P, 0), pa1 = PACK8(P, 1);
#pragma unroll
    for (int d0 = 0; d0 < 2; ++d0) { const bf16x8 v0 = *(const bf16x8*)(vl + d0 * 1024), v1 = *(const bf16x8*)(vl + d0 * 1024 + 16);
        O[d0] = MFMA32(pa0, v0, O[d0]); O[d0] = MFMA32(pa1, v1, O[d0]); }
}
template <int KIND> __device__ __forceinline__ float apply_p(f32x16& S, int key0, int h, int pos, int head, bool near, const float* biasL) {
    float sum = 0.f;
    if (!near) {
#pragma unroll
        for (int i = 0; i < 16; ++i) { S[i] = __builtin_amdgcn_exp2f(S[i]); sum += S[i]; }
    } else {
#pragma unroll
        for (int i = 0; i < 16; ++i) { const int key = key0 + crow(i, h); const int dist = KIND == 0 ? pos - 16 * key - 31 : pos - key;
            const bool vis = dist >= 0 && (KIND != 1 || dist < 512); const int bi = min(max(dist, 0), 128);
            const float v = __builtin_amdgcn_exp2f(S[i] + biasL[bi * 8 + head]); S[i] = vis ? v : 0.f; sum += S[i]; }
    }
    return sum;
}
__device__ void attn_unit(const P& p, const int b, const int g, const int cur, unsigned char* ring, const float* biasL) {
    const int tid = opq_tid(), lane = tid & 63, w = tid >> 6, c = lane & 31, h = lane >> 5;
    const int t0 = cur * 64; const size_t tbase = (size_t)b * SEQ;
    bf16* Qs = (bf16*)(ring + AL_Q); float* ACC = (float*)(ring + AL_ACC) + w * 2048; unsigned char* SEL = ring + AL_SEL; int* NSEL = (int*)(ring + AL_NSEL);
    float* RS = (float*)(ring + AL_ROWS) + w * 256;
    const bf16* Qg = (const bf16*)(p.ws + WS_Q) + ((tbase + t0) * 8 + 4 * g) * 64;
    const bf16* KVall = (const bf16*)(p.ws + WS_KV);
    auto kvb = [&](int i) { return KVall + (((size_t)i * 2 + b) * 2 + g) * SEQ * 64; };
    const bf16* KC = (const bf16*)(p.ws + WS_KCVC) + (size_t)(b * 2 + g) * NCP * 64; const bf16* VCt = (const bf16*)(p.ws + WS_KCVC) + (size_t)(4 + b * 2 + g) * NCP * 64;
    const float* GATES = (const float*)(p.ws + WS_GATES);
#pragma unroll
    for (int k = 0; k < 4; ++k) { const int ci = tid + 512 * k, ql = ci >> 5, rem = ci & 31;
        *(u32x4*)(Qs + (size_t)ci * 8) = *(const u32x4*)(Qg + (size_t)(ql * 8 + (rem >> 3)) * 64 + (rem & 7) * 8); }
    const int row = 32 * w + c, ql = row >> 2, hl = row & 3, pos = t0 + ql, head = 4 * g + hl;
    const int pos_lo = t0 + 8 * w, pos_hi = pos_lo + 7;
    bf16x8 qf[4];
#pragma unroll
    for (int k = 0; k < 4; ++k) qf[k] = *(const bf16x8*)(Qg + (size_t)(ql * 8 + hl) * 64 + 16 * k + 8 * h);
    const float* gt = GATES + (tbase + pos) * 24 + head * 3;
    __syncthreads();
    const int NTc = (4 * cur + 3 + 31) >> 5;
    float lsum = 0.f;
    for (int kt = 0; kt < NTc; ++kt) {
        f32x16 S = qk_tile(KC + (size_t)(kt * 32 + c) * 64 + 8 * h, qf);
        const bool near = !(pos_lo - 16 * (32 * kt + 31) - 31 >= 128);
        lsum += apply_p<0>(S, 32 * kt, h, pos, head, near, biasL);
    }
    lsum += __shfl_xor(lsum, 32);
    const float rlc = lsum > 0.f ? 1.f / lsum : 0.f;
    f32x16 Ocw[2];
#pragma unroll
    for (int i = 0; i < 16; ++i) { Ocw[0][i] = 0.f; Ocw[1][i] = 0.f; }
    float carry = 0.f;
    for (int kt = 0; kt < NTc; ++kt) {
        f32x16 S = qk_tile(KC + (size_t)(kt * 32 + c) * 64 + 8 * h, qf);
        const bool near = !(pos_lo - 16 * (32 * kt + 31) - 31 >= 128);
        (void)apply_p<0>(S, 32 * kt, h, pos, head, near, biasL);
        pv_tile(S, VCt + (size_t)kt * 2048 + c * 32 + 8 * h, Ocw);
        float G[4], E[4], Eo[4];
#pragma unroll
        for (int m = 0; m < 4; ++m) { G[m] = (S[4 * m] + S[4 * m + 1] + S[4 * m + 2] + S[4 * m + 3]) * rlc; E[m] = S[4 * m + 3] * rlc;
            G[m] += __shfl_xor(G[m], 1); G[m] += __shfl_xor(G[m], 2); E[m] += __shfl_xor(E[m], 1); E[m] += __shfl_xor(E[m], 2); Eo[m] = __shfl_xor(E[m], 32); }
        if (h == 1) {
#pragma unroll
            for (int m = 0; m < 4; ++m) G[m] += Eo[m];
        } else { G[0] += carry; G[1] += Eo[0]; G[2] += Eo[1]; G[3] += Eo[2]; carry = Eo[3]; }
        if ((c & 3) == 0) {
#pragma unroll
            for (int m = 0; m < 4; ++m) ACC[(c >> 2) * 256 + kt * 8 + 2 * m + h] = G[m];
        }
    }
    if (h == 0) RS[c] = gt[0] * rlc;
    LDS_FENCE();
#pragma unroll
    for (int i = 0; i < 16; ++i) { const float a = RS[crow(i, h)]; Ocw[0][i] *= a; Ocw[1][i] *= a; }
    if (cur >= 16) {
        for (int qi = 0; qi < 8; ++qi) {
            unsigned key[4];
#pragma unroll
            for (int j = 0; j < 4; ++j) { const int s = lane + 64 * j; const float v = ACC[qi * 256 + s];
                key[j] = (s >= 1 && s <= cur - 2) ? ((__float_as_uint(v) & 0xFFFFFE00u) | 0x100u | (unsigned)(255 - s)) : 0u; }
            int n = 0;
            for (int r = 0; r < 13; ++r) {
                unsigned m = max(max(key[0], key[1]), max(key[2], key[3]));
#pragma unroll
                for (int o = 1; o < 64; o <<= 1) m = max(m, (unsigned)__shfl_xor((int)m, o));
                if (m == 0u) break;
                if (lane == 0) SEL[(8 * w + qi) * 16 + r] = (unsigned char)(255u - (m & 0xFFu));
#pragma unroll
                for (int j = 0; j < 4; ++j) key[j] = key[j] == m ? 0u : key[j];
                ++n;
            }
            if (lane == 0) NSEL[8 * w + qi] = n;
        }
    }
    LDS_FENCE();
    f32x16 Ob[2];
#pragma unroll
    for (int i = 0; i < 16; ++i) { Ob[0][i] = 0.f; Ob[1][i] = 0.f; }
    lsum = 0.f;
    {
        const bf16* KW = kvb(4); const bf16* VWt = kvb(5);
        const int k_lo = max(0, pos_lo - 511) >> 5, k_hi = pos_hi >> 5;
        for (int kt = k_lo; kt <= k_hi; ++kt) {
            f32x16 S = qk_tile(KW + (size_t)(kt * 32 + c) * 64 + 8 * h, qf);
            const bool full = (32 * kt + 31 <= pos_lo - 128) && (32 * kt >= pos_hi - 511);
            lsum += apply_p<1>(S, 32 * kt, h, pos, head, !full, biasL);
            pv_tile(S, VWt + (size_t)kt * 2048 + c * 32 + 8 * h, Ob);
        }
    }
    lsum += __shfl_xor(lsum, 32);
    if (h == 0) RS[32 + c] = gt[2] * (lsum > 0.f ? 1.f / lsum : 0.f);
    LDS_FENCE();
#pragma unroll
    for (int i = 0; i < 16; ++i) { const float a = RS[32 + crow(i, h)]; Ocw[0][i] += Ob[0][i] * a; Ocw[1][i] += Ob[1][i] * a; }
#pragma unroll
    for (int i = 0; i < 16; ++i) { Ob[0][i] = 0.f; Ob[1][i] = 0.f; }
    lsum = 0.f;
    {
        const bf16* KS = kvb(2); const bf16* VSt = kvb(3);
        const int nb = cur <= 15 ? cur + 1 : 3;
        for (int bi_ = 0; bi_ < nb; ++bi_) {
            const int blk = cur <= 15 ? bi_ : (bi_ == 0 ? 0 : cur - 2 + bi_);
#pragma unroll
            for (int hh = 0; hh < 2; ++hh) {
                const int kt = 2 * blk + hh;
                f32x16 S = qk_tile(KS + (size_t)(kt * 32 + c) * 64 + 8 * h, qf);
                const bool far = (32 * kt + 31 <= pos_lo - 128);
                lsum += apply_p<2>(S, 32 * kt, h, pos, head, !far, biasL);
                pv_tile(S, VSt + (size_t)kt * 2048 + c * 32 + 8 * h, Ob);
            }
        }
    }
    lsum += __shfl_xor(lsum, 32);
    {
        const int kr = lane & 15, qr = lane >> 4;
        const bf16* KS = kvb(2); const bf16* VS16 = kvb(6);
        for (int qi = 0; qi < 8; ++qi) {
            const int q = 8 * w + qi; const int n = cur >= 16 ? NSEL[q] : 0; const int qpos = t0 + q;
            f32x4 OT[4]; float lg = 0.f;
#pragma unroll
            for (int d = 0; d < 4; ++d) OT[d] = (f32x4){0.f, 0.f, 0.f, 0.f};
            bf16x8 qb[2];
#pragma unroll
            for (int ks = 0; ks < 2; ++ks) qb[ks] = *(const bf16x8*)(Qs + (size_t)(q * 4 + (kr & 3)) * 64 + 32 * ks + 8 * qr);
            for (int r = 0; r < n; ++r) {
                const int sblk = SEL[q * 16 + r];
                f32x4 St[4];
#pragma unroll
                for (int kg = 0; kg < 4; ++kg) { St[kg] = (f32x4){0.f, 0.f, 0.f, 0.f};
#pragma unroll
                    for (int ks = 0; ks < 2; ++ks) { const bf16x8 kf = *(const bf16x8*)(KS + (size_t)(sblk * 64 + 16 * kg + kr) * 64 + 32 * ks + 8 * qr); St[kg] = MFMA16(kf, qb[ks], St[kg]); } }
                const bool near = (sblk >= cur - 2);
#pragma unroll
                for (int kg = 0; kg < 4; ++kg)
#pragma unroll
                    for (int e = 0; e < 4; ++e) { float x = St[kg][e];
                        if (near) { const int dist = qpos - (sblk * 64 + 16 * kg + 4 * qr + e); x += biasL[min(max(dist, 0), 128) * 8 + 4 * g + (kr & 3)]; }
                        x = __builtin_amdgcn_exp2f(x); St[kg][e] = x; lg += x; }
#pragma unroll
                for (int ks = 0; ks < 2; ++ks) {
                    const bf16x8 pb = __builtin_bit_cast(bf16x8, (u32x4){cvtpk(St[2 * ks][0], St[2 * ks][1]), cvtpk(St[2 * ks][2], St[2 * ks][3]), cvtpk(St[2 * ks + 1][0], St[2 * ks + 1][1]), cvtpk(St[2 * ks + 1][2], St[2 * ks + 1][3])});
#pragma unroll
                    for (int dg = 0; dg < 4; ++dg) { const bf16x8 vf = *(const bf16x8*)(VS16 + (size_t)(sblk * 64 + 16 * dg + kr) * 64 + 32 * ks + 8 * qr); OT[dg] = MFMA16(vf, pb, OT[dg]); }
                }
            }
            lg += __shfl_xor(lg, 16); lg += __shfl_xor(lg, 32);
            if (kr < 4) {
#pragma unroll
                for (int dg = 0; dg < 4; ++dg) *(f32x4*)(ACC + (size_t)(qi * 4 + kr) * 64 + 16 * dg + 4 * qr) = OT[dg];
                if (qr == 0) RS[128 + qi * 4 + kr] = lg;
            }
        }
    }
    LDS_FENCE();
    if (h == 0) { const float ls = lsum + RS[128 + c]; RS[64 + c] = gt[1] * (ls > 0.f ? 1.f / ls : 0.f); }
    LDS_FENCE();
#pragma unroll
    for (int i = 0; i < 16; ++i) { const int r = crow(i, h); const float a = RS[64 + r];
#pragma unroll
        for (int d0 = 0; d0 < 2; ++d0) { float* ap = ACC + r * 64 + 32 * d0 + c; *ap = Ocw[d0][i] + a * (Ob[d0][i] + *ap); } }
    LDS_FENCE();
    {
        const int r = lane >> 1, hf = lane & 1; const float* src = ACC + r * 64 + 32 * hf;
        f32x4 v[8]; float ss = 0.f;
#pragma unroll
        for (int k = 0; k < 8; ++k) { v[k] = *(const f32x4*)(src + 4 * k); ss += v[k].x * v[k].x + v[k].y * v[k].y + v[k].z * v[k].z + v[k].w * v[k].w; }
        ss += __shfl_xor(ss, 1);
        const float rstd = rsqrtf(ss * (1.f / 64.f) + EPS);
        const int rq = (32 * w + r) >> 2, rh = (32 * w + r) & 3; const int col = (4 * g + rh) * 64 + 32 * hf;
        const float* onw = p.in[15] + col; bf16* dst = (bf16*)(p.ws + WS_MIX) + (tbase + t0 + rq) * DM + col;
#pragma unroll
        for (int k = 0; k < 4; ++k) { const f32x4 w0 = *(const f32x4*)(onw + 8 * k), w1 = *(const f32x4*)(onw + 8 * k + 4); const f32x4 a0 = v[2 * k] * rstd * w0, a1 = v[2 * k + 1] * rstd * w1;
            *(u32x4*)(dst + 8 * k) = (u32x4){cvtpk(a0.x, a0.y), cvtpk(a0.z, a0.w), cvtpk(a1.x, a1.y), cvtpk(a1.z, a1.w)}; }
    }
    __syncthreads();
}
__device__ void ph_attn(const P& p, unsigned char* ring, float* biasL) {
    build_bias_table(p, biasL);
    const int bx = blockIdx.x, vcu = (bx & 7) * 32 + (bx >> 3), bg = vcu >> 6, si = vcu & 63;
    for (int ui = 0; ui < 4; ++ui) {
        const int cur = ui == 0 ? si : ui == 1 ? 127 - si : ui == 2 ? 128 + si : 255 - si;
        attn_unit(p, bg >> 1, bg & 1, cur, ring, biasL);
    }
}

__device__ void ph_route(const P& p, int gtid, int nthreads) {
    const float* LG = (const float*)(p.ws + WS_LOGITS); unsigned* cnt = (unsigned*)(p.ws + WS_CTL) + CW_CNT;
    int* LISTS = (int*)(p.ws + WS_LISTS); float* ROWW = (float*)(p.ws + WS_ROWW);
    const float* bg = p.in[20]; const float* be = p.in[22];
    for (int t = gtid; t < T; t += nthreads) {
        const float* l = LG + (size_t)t * 128;
        float gl[8]; float gm = -3.0e38f; int gi = 0;
#pragma unroll
        for (int i = 0; i < 8; ++i) { gl[i] = l[i] + bg[i]; if (gl[i] > gm) { gm = gl[i]; gi = i; } }
        float gs = 0.f;
#pragma unroll
        for (int i = 0; i < 8; ++i) gs += __expf(gl[i] - gm);
        const float gp = 1.f / gs;
        float el[8]; float m0 = -3.0e38f, m1 = -3.0e38f; int i0 = 0, i1 = 0;
#pragma unroll
        for (int i = 0; i < 8; ++i) { el[i] = l[8 + gi * 8 + i] + be[gi * 8 + i];
            if (el[i] > m0) { m1 = m0; i1 = i0; m0 = el[i]; i0 = i; } else if (el[i] > m1) { m1 = el[i]; i1 = i; } }
        const float e1 = __expf(m1 - m0); const float p0 = 1.f / (1.f + e1), p1 = e1 / (1.f + e1);
        const int ex0 = gi * 8 + i0, ex1 = gi * 8 + i1;
        const unsigned s0 = atomicAdd(&cnt[ex0], 1u), s1 = atomicAdd(&cnt[64 + ex1], 1u);
        LISTS[(size_t)ex0 * T + s0] = t; ROWW[(size_t)ex0 * T + s0] = gp * p0;
        LISTS[(size_t)(64 + ex1) * T + s1] = t; ROWW[(size_t)(64 + ex1) * T + s1] = gp * p1;
    }
}
__device__ void build_tile_base(const P& p, int* tb) {
    const unsigned* cnt = (const unsigned*)(p.ws + WS_CTL) + CW_CNT;
    if (threadIdx.x == 0) { int s = 0; for (int i = 0; i < 128; ++i) { tb[i] = s; s += ((int)cnt[i] + 255) >> 8; } tb[128] = s; }
    __syncthreads();
}
#define LAS __attribute__((address_space(3)))
#define XB_TMO      128
#define XB_XCNT(j)  (256  + 64 * (j))
#define XB_XSUB(j)  (1280 + 64 * (j))
#define XB_XGEN(j)  (2304 + 64 * (j))
#define XB_TOP      3328
#define XB_TOPGEN   3392
#define XCD_BAR_WORDS 3456
#define XB_SPIN_CAP (1u << 18)
constexpr int CW_BAR = 4096;
__device__ __forceinline__ unsigned xb_ld(unsigned* p)              { return __hip_atomic_load(p, __ATOMIC_RELAXED, __HIP_MEMORY_SCOPE_AGENT); }
__device__ __forceinline__ unsigned xb_add(unsigned* p, unsigned v) { return __hip_atomic_fetch_add(p, v, __ATOMIC_RELAXED, __HIP_MEMORY_SCOPE_AGENT); }
__device__ __forceinline__ unsigned xb_xcc_id() { return (unsigned)__builtin_amdgcn_s_getreg((3 << 11) | 20) & 0xFu; }
#define XB_SPIN(cond, bar) do { unsigned _sp = 0; while (cond) { __builtin_amdgcn_s_sleep(1); \
    if ((++_sp & 255u) == 0u) { if (xb_ld(&(bar)[XB_TMO])) break; if (_sp > XB_SPIN_CAP) { atomicAdd(&(bar)[XB_TMO], 1u); break; } } } } while (0)
struct XcdBarrier { unsigned* bar; unsigned x; volatile LAS unsigned* st; };
__device__ __forceinline__ XcdBarrier xcd_barrier_post(unsigned* bar, volatile LAS unsigned* st) {
    XcdBarrier b; b.bar = bar; b.x = xb_xcc_id(); b.st = st;
    if (threadIdx.x == 0) (void)xb_add(&bar[XB_XCNT(b.x)], 1u);
    return b;
}
__device__ __forceinline__ void xcd_barrier_complete(unsigned* bar, unsigned x, unsigned& nloc, unsigned& nx) {
    const unsigned G = gridDim.x * gridDim.y * gridDim.z;
    unsigned sum, cnt, mine, sp = 0u;
    for (;;) {
        sum = 0u; cnt = 0u; mine = 0u;
#pragma unroll
        for (unsigned j = 0; j < 16; ++j) { const unsigned c = xb_ld(&bar[XB_XCNT(j)]); sum += c; cnt += (c > 0u) ? 1u : 0u; mine = (j == x) ? c : mine; }
        if (sum == G) break;
        __builtin_amdgcn_s_sleep(1);
        if ((++sp & 255u) == 0u) { if (xb_ld(&bar[XB_TMO])) break; if (sp > XB_SPIN_CAP) { atomicAdd(&bar[XB_TMO], 1u); break; } }
    }
    nloc = mine > 0u ? mine : 1u; nx = cnt > 0u ? cnt : 1u;
}
__device__ __forceinline__ void xcd_barrier(const XcdBarrier& b) {
    asm volatile("s_waitcnt vmcnt(0)" ::: "memory");
    __syncthreads();
    if (threadIdx.x == 0) {
        unsigned* bar = b.bar;
        __builtin_amdgcn_s_waitcnt(0);
        unsigned nloc = b.st[0], nx = b.st[1];
        if (nloc == 0u) { xcd_barrier_complete(bar, b.x, nloc, nx); b.st[0] = nloc; b.st[1] = nx; }
        const unsigned old = xb_add(&bar[XB_XSUB(b.x)], 1u);
        const unsigned gen = old / nloc;
        if (old + 1u == (gen + 1u) * nloc) {
            __builtin_amdgcn_fence(__ATOMIC_RELEASE, "agent");
            asm volatile("s_waitcnt vmcnt(0)" ::: "memory");
            const unsigned og = xb_add(&bar[XB_TOP], 1u);
            const unsigned tg = og / nx;
            if (og + 1u == (tg + 1u) * nx) xb_add(&bar[XB_TOPGEN], 1u);
            else XB_SPIN(xb_ld(&bar[XB_TOPGEN]) == tg, bar);
            __builtin_amdgcn_fence(__ATOMIC_ACQUIRE, "agent");
            xb_add(&bar[XB_XGEN(b.x)], 1u);
            asm volatile("s_waitcnt vmcnt(0)" ::: "memory");
        } else {
            XB_SPIN(xb_ld(&bar[XB_XGEN(b.x)]) == gen, bar);
            __builtin_amdgcn_fence(__ATOMIC_ACQUIRE, "agent");
            asm volatile("s_waitcnt vmcnt(0)" ::: "memory");
        }
    }
    __syncthreads();
}

constexpr int NT = 512;
constexpr int LDS_SCR = 0, LDS_SHB = 131072, LDS_MISC = LDS_SHB + 8192, LDS_BYTES = 147456;
__global__ void __launch_bounds__(NT) mega(P p) {
    extern __shared__ __attribute__((aligned(16))) unsigned char ldsb[];
    float* lds = (float*)ldsb;
    const int ngw = gridDim.x * (NT / 64);
#define TIDV opq_tid()
#define GW (blockIdx.x * (NT / 64) + (TIDV >> 6))
#define SCR (lds + (TIDV >> 6) * (8448 / 4))
    float* shb = lds + LDS_SHB / 4;
    volatile LAS unsigned* misc = (volatile LAS unsigned*)((LAS unsigned char*)ldsb + LDS_MISC);
    if (threadIdx.x < 16) misc[threadIdx.x] = 0u;
    __syncthreads();
    XcdBarrier bar = xcd_barrier_post((unsigned*)(p.ws + WS_CTL) + CW_BAR, misc);
#define GB() xcd_barrier(bar)
    PG8_LAS unsigned char* ring = (PG8_LAS unsigned char*)ldsb;
    const int G = gridDim.x, cb = blockIdx.x;
    ph_mod(p, blockIdx.x, gridDim.x, shb); ph_wprep_a(p, GW, ngw, SCR); GB();
    ph_rownorm(p, GW, ngw, p.in[0], 0); GB();
    { pg8::StaticOrder S; S.init(p.ws + WS_XN, p.ws + WS_WIN_T, DM, DM, T, NINP, G, cb); pg8::EpiRaw E{(bf16*)(p.ws + WS_R1), NINP};
      pg8::gemm_phase<pg8::EpiRaw, pg8::StaticOrder, false>(ring, DM, DM, S, E); } GB();
    ph_post(p, GW, ngw); GB();
    if (cb < 32) { pg8::CmpOrder S{(const char*)(p.ws + WS_KV), (const char*)(p.ws + WS_CW1_T), cb}; pg8::EpiCmp E{(float*)(p.ws + WS_HID), (const float*)(p.ws + WS_POSB)};
      pg8::gemm_phase<pg8::EpiCmp, pg8::CmpOrder, false>(ring, 2048, 1024, S, E); }
    else ph_wprep_moe(p, GW - 32 * (NT / 64), ngw - 32 * (NT / 64), SCR);
    GB();
    ph_cmp_fin(p, GW, ngw); GB();
    ph_attn(p, ldsb, shb); GB();
    { pg8::StaticOrder S; S.init(p.ws + WS_MIX, p.ws + WS_WOUT_T, DM, DM, T, DM, G, cb); pg8::EpiOutRes E{p.in[0], p.out, (const float*)(p.ws + WS_MOD)};
      pg8::gemm_phase<pg8::EpiOutRes, pg8::StaticOrder, false>(ring, DM, DM, S, E); } GB();
    ph_rownorm(p, GW, ngw, p.out, 1); GB();
    { pg8::StaticOrder S; S.init(p.ws + WS_XN, p.ws + WS_WR_T, DM, DM, T, 256, G, cb); pg8::EpiRouter E{(float*)(p.ws + WS_LOGITS)};
      pg8::gemm_phase<pg8::EpiRouter, pg8::StaticOrder, false>(ring, DM, DM, S, E); } GB();
    ph_route(p, blockIdx.x * NT + TIDV, gridDim.x * NT); GB();
    build_tile_base(p, (int*)shb);
    const unsigned* cnt = (const unsigned*)(p.ws + WS_CTL) + CW_CNT;
    { pg8::MoeOrder1 S{(const char*)(p.ws + WS_XN), (const char*)(p.ws + WS_W13_T), (const int*)(p.ws + WS_LISTS), cnt, (const int*)shb, G, cb}; pg8::EpiMoe1 E{(bf16*)(p.ws + WS_H)};
      pg8::gemm_phase<pg8::EpiMoe1, pg8::MoeOrder1, true>(ring, DM, DM, S, E); } GB();
    { pg8::MoeOrder2 S{(const char*)(p.ws + WS_H), (const char*)(p.ws + WS_W2_T), (const int*)(p.ws + WS_LISTS), cnt, (const int*)shb, G, cb, 0}; pg8::EpiMoe2 E{p.out, (const float*)(p.ws + WS_MOD)};
      pg8::gemm_phase<pg8::EpiMoe2, pg8::MoeOrder2, false>(ring, 512, 512, S, E); } GB();
    { pg8::MoeOrder2 S{(const char*)(p.ws + WS_H), (const char*)(p.ws + WS_W2_T), (const int*)(p.ws + WS_LISTS), cnt, (const int*)shb, G, cb, 1}; pg8::EpiMoe2 E{p.out, (const float*)(p.ws + WS_MOD)};
      pg8::gemm_phase<pg8::EpiMoe2, pg8::MoeOrder2, false>(ring, 512, 512, S, E); }
}

extern "C" void kernel_launch(void* const* d_in, const int* in_sizes, int n_in, void* d_out, int out_size, void* d_ws, size_t ws_size, hipStream_t stream) {
    static int ready = 0;
    if (ready == 0) {
        if (n_in != 26 || ws_size < WS_END) { fprintf(stderr, "kernel_launch: bad args n_in=%d ws=%zu\n", n_in, ws_size); ready = -1; return; }
        if (hipFuncSetAttribute((const void*)mega, hipFuncAttributeMaxDynamicSharedMemorySize, LDS_BYTES) != hipSuccess) { fprintf(stderr, "kernel_launch: hipFuncSetAttribute failed\n"); ready = -1; return; }
        ready = 1;
    }
    if (ready < 0) return;
    P p{};
    for (int i = 0; i < 26; ++i) p.in[i] = (const float*)d_in[i];
    p.out = (float*)d_out; p.ws = (unsigned char*)d_ws;
    (void)hipMemsetAsync((char*)d_ws + WS_CTL, 0, 1 * MiB, stream);
    hipLaunchKernelGGL(mega, dim3(256), dim3(NT), LDS_BYTES, stream, p);
}
```

```cpp
#include <hip/hip_runtime.h>
#include <stdint.h>
#include <stdio.h>

#ifndef PROBE_ATT
#define PROBE_ATT 0
#endif
#ifndef NAIVE_GEMM
#define NAIVE_GEMM 0
#endif

typedef unsigned short bf16;
typedef short bf16x8 __attribute__((ext_vector_type(8)));
typedef float f32x4 __attribute__((ext_vector_type(4)));
typedef unsigned u32x4 __attribute__((ext_vector_type(4)));
typedef unsigned u32x2 __attribute__((ext_vector_type(2)));

constexpr int BATCH = 2, SEQ = 16384, DM = 1024, T = BATCH * SEQ;
constexpr int NIN = 2840, NINP = 3072;
constexpr int NC = 1023, NCP = 1024, NS = 256;
constexpr int NEXP = 64;
constexpr float EPS = 1e-6f;

constexpr size_t MiB = 1u << 20;
constexpr size_t WS_CTL = 0;
constexpr size_t WS_MOD = 1 * MiB;
constexpr size_t WS_POSB = 1 * MiB + 65536;
constexpr size_t WS_WIN_T = 2 * MiB;
constexpr size_t WS_WOUT_T = 8 * MiB;
constexpr size_t WS_CW1_T = 10 * MiB;
constexpr size_t WS_WR_T = 12 * MiB;
constexpr size_t WS_HID = 13 * MiB;
constexpr size_t WS_KCVC = 21 * MiB;
constexpr size_t WS_GATES = 22 * MiB;
constexpr size_t WS_LOGITS = 25 * MiB;
constexpr size_t WS_LISTS = 41 * MiB;
constexpr size_t WS_ROWW = 57 * MiB;
constexpr size_t WS_XN = 73 * MiB;
constexpr size_t WS_R1 = 137 * MiB;
constexpr size_t WS_W13_T = WS_R1;
constexpr size_t WS_W2_T = WS_R1 + 128 * MiB;
constexpr size_t WS_Q = 329 * MiB;
constexpr size_t WS_KV = 361 * MiB;
constexpr size_t WS_H = 329 * MiB;
constexpr size_t WS_MIX = 418 * MiB;
constexpr size_t WS_END = 482 * MiB;

constexpr int CW_CNT = 0;

struct P {
    const float* in[26];
    float* out;
    unsigned char* ws;
};

__device__ __forceinline__ unsigned f2bf(float f) { unsigned u = __builtin_bit_cast(unsigned, f); return (u + 0x7fffu + ((u >> 16) & 1u)) >> 16; }
__device__ __forceinline__ unsigned pk2(float lo, float hi) { return f2bf(lo) | (f2bf(hi) << 16); }
__device__ __forceinline__ float bf2f(unsigned short h) { return __builtin_bit_cast(float, (unsigned)h << 16); }
__device__ __forceinline__ float bflo(unsigned u) { return __builtin_bit_cast(float, u << 16); }
__device__ __forceinline__ float bfhi(unsigned u) { return __builtin_bit_cast(float, u & 0xffff0000u); }
__device__ __forceinline__ float wave_sum(float v) {
#pragma unroll
    for (int o = 1; o < 64; o <<= 1) v += __shfl_xor(v, o);
    return v;
}
__device__ __forceinline__ float silu_f(float v) { return v / (1.f + __expf(-v)); }
#define LDS_FENCE() asm volatile("s_waitcnt lgkmcnt(0)" ::: "memory")
__device__ __forceinline__ int opq_tid() { int t = threadIdx.x; asm volatile("" : "+v"(t)); return t; }

template <class AR, class BR, class EPI>
__device__ __forceinline__ void wave_gemm_64x64(AR arow, BR brow, int K, EPI epi) {
    const int lane = threadIdx.x & 63, fr = lane & 15, fq = lane >> 4;
#if !NAIVE_GEMM
    const bf16* ap[4]; const bf16* bp[4];
#pragma unroll
    for (int i = 0; i < 4; ++i) { ap[i] = arow(16 * i + fr) + fq * 8; bp[i] = brow(16 * i + fr) + fq * 8; }
    f32x4 acc[4][4];
#pragma unroll
    for (int i = 0; i < 4; ++i)
#pragma unroll
        for (int j = 0; j < 4; ++j) acc[i][j] = (f32x4){0.f, 0.f, 0.f, 0.f};
#pragma unroll 1
    for (int k = 0; k < K; k += 64) {
        bf16x8 a[4][2], b[4][2];
#pragma unroll
        for (int i = 0; i < 4; ++i) {
            a[i][0] = *(const bf16x8*)(ap[i] + k); a[i][1] = *(const bf16x8*)(ap[i] + k + 32);
            b[i][0] = *(const bf16x8*)(bp[i] + k); b[i][1] = *(const bf16x8*)(bp[i] + k + 32);
        }
#pragma unroll
        for (int kk = 0; kk < 2; ++kk)
#pragma unroll
            for (int i = 0; i < 4; ++i)
#pragma unroll
                for (int j = 0; j < 4; ++j) acc[i][j] = __builtin_amdgcn_mfma_f32_16x16x32_bf16(b[j][kk], a[i][kk], acc[i][j], 0, 0, 0);
    }
#pragma unroll
    for (int i = 0; i < 4; ++i)
#pragma unroll
        for (int j = 0; j < 4; ++j) { epi(16 * i + fr, 16 * j + 4 * fq, acc[i][j]); asm volatile("" ::: "memory"); }
#else
    for (int i = 0; i < 4; ++i) {
        const bf16* ar = arow(16 * i + fr);
        for (int j = 0; j < 4; ++j) {
            f32x4 acc = (f32x4){0.f, 0.f, 0.f, 0.f};
#pragma unroll
            for (int r = 0; r < 4; ++r) {
                const bf16* br = brow(16 * j + 4 * fq + r);
                float s = 0.f;
                for (int k = 0; k < K; k += 8) {
                    u32x4 av = *(const u32x4*)(ar + k), bv = *(const u32x4*)(br + k);
#pragma unroll
                    for (int q = 0; q < 4; ++q) { s += bflo(av[q]) * bflo(bv[q]); s += bfhi(av[q]) * bfhi(bv[q]); }
                }
                acc[r] = s;
            }
            epi(16 * i + fr, 16 * j + 4 * fq, acc);
        }
    }
#endif
}

__device__ __forceinline__ void transpose_item(const float* W, int K, int N, bf16* WT, int rmul, int radd, float* scr, int item, int lane) {
    const int nblk = (N + 31) / 32, kb = item / nblk, nb = item % nblk, k0 = 64 * kb, n0 = 32 * nb;
    const int ncol = n0 + (lane & 31);
#pragma unroll 8
    for (int i = 0; i < 32; ++i) { const int kk = 2 * i + (lane >> 5); scr[kk * 33 + (lane & 31)] = ncol < N ? W[(size_t)(k0 + kk) * N + ncol] : 0.f; }
    LDS_FENCE();
    const int c = lane & 7;
#pragma unroll
    for (int j = 0; j < 4; ++j) { const int n = (lane >> 3) + 8 * j; const float* s = scr + (8 * c) * 33 + n;
        u32x4 o; o.x = pk2(s[0 * 33], s[1 * 33]); o.y = pk2(s[2 * 33], s[3 * 33]); o.z = pk2(s[4 * 33], s[5 * 33]); o.w = pk2(s[6 * 33], s[7 * 33]);
        *(u32x4*)(WT + (size_t)(radd + rmul * (n0 + n)) * K + k0 + 8 * c) = o; }
    LDS_FENCE();
}

namespace pg8 {
#define PG8_LAS __attribute__((address_space(3)))
constexpr int BM = 256, BK = 64, HALF = 128, HTB = HALF * BK * 2, STAGE_BYTES = 8 * HTB, NXCD = 8, WGM = 8;
__host__ __device__ __forceinline__ int lds_byte(int r, int c) { const int st = (r >> 4) * 2 + (c >> 5), rr = r & 15, cc = c & 31, ob = rr * 64 + cc * 2; return st * 1024 + (ob ^ (((ob >> 9) & 1) << 5)); }
__host__ __device__ __forceinline__ void stage_rc(int b, int& R, int& C) { const int st = b / 1024, sb = b % 1024, swz = sb ^ (((sb >> 9) & 1) << 5); R = (st >> 1) * 16 + swz / 64; C = (st & 1) * 32 + (swz % 64) / 2; }
__host__ __device__ __forceinline__ int perm32(int rho) { const int n = rho >> 4, i = rho & 15; return 8 * (i >> 2) + 4 * n + (i & 3); }

struct Unit { const char* A; const char* B; const int* list; int r0, nrows; int pm, pn, aux; };

struct StaticOrder {
    const char* A; const char* B; int lda, K; int nM, nN, nwg, G, c;
    __device__ void init(const void* A_, const void* B_, int lda_, int K_, int M, int N, int G_, int c_) { A = (const char*)A_; B = (const char*)B_; lda = lda_; K = K_; nM = M / BM; nN = N / BM; nwg = nM * nN; G = G_; c = c_; }
    __device__ bool next(int i, Unit& u) const {
        const long L = (long)i * G + c; if (L >= nwg) return false;
        int wgid = (int)L; { const int q = nwg / NXCD, r = nwg % NXCD, xcd = wgid % NXCD, off = wgid / NXCD; wgid = (xcd < r ? xcd * (q + 1) : r * (q + 1) + (xcd - r) * q) + off; }
        const int nig = WGM * nN, gid = wgid / nig, fm = gid * WGM, gsz = (nM - fm) < WGM ? (nM - fm) : WGM;
        u.pm = fm + ((wgid % nig) % gsz); u.pn = (wgid % nig) / gsz;
        u.A = A + (size_t)u.pm * BM * lda * 2; u.B = B + (size_t)u.pn * BM * K * 2; u.list = nullptr; u.r0 = 0; u.nrows = BM; u.aux = 0; return true;
    }
};

__device__ __forceinline__ unsigned cvt_pk_bf16(float lo, float hi) { unsigned r; asm volatile("v_cvt_pk_bf16_f32 %0, %1, %2" : "=v"(r) : "v"(lo), "v"(hi)); return r; }

template <class Epi, class Sched, bool GATHER, bool ALIGN_EPI = true>
__device__ __forceinline__ void gemm_phase(PG8_LAS unsigned char* lds, const int K, const int lda, const Sched& S, const Epi& E) {
    const int tid = opq_tid(), wid = __builtin_amdgcn_readfirstlane(tid >> 6), lane = tid & 63, wr = wid >> 2, wc = wid & 3, fr = lane & 15, fq = lane >> 4;
    const int nt = K / BK;
    int RA[2], CA[2]; unsigned voffA[2], voffB[2];
#pragma unroll
    for (int i = 0; i < 2; ++i) { int R, C; stage_rc(tid * 16 + i * 8192, R, C); const int Rb = Epi::PERM ? ((R & ~31) + perm32(R & 31)) : R;
        RA[i] = R; CA[i] = C; voffA[i] = (unsigned)(R * lda + C) * 2u; voffB[i] = (unsigned)(Rb * K + C) * 2u; }
    const size_t kstep = (size_t)(BK * 2);
    const size_t hstepA = (size_t)HALF * lda * 2, hstepB = (size_t)HALF * K * 2;
    const unsigned ldsw = (unsigned)wid * 1024u;
    const int aoff = lds_byte(wr * 64 + fr, fq * 8), boff = lds_byte(wc * 32 + fr, fq * 8);
    unsigned offC[2][2], offN[2][2];
#define PG8_SA(b, h) (((b) * 2 + (h)) * HTB)
#define PG8_SB(b, h) ((4 + (b) * 2 + (h)) * HTB)
#define PG8_GL(ptr, bufoff, i_) __builtin_amdgcn_global_load_lds((const unsigned*)(ptr), (PG8_LAS unsigned*)(lds + (bufoff) + ldsw + (i_) * 8192), 16, 0, 0)
#define PG8_STAGE_B(bufoff, gbase) do { _Pragma("unroll") for (int _i = 0; _i < 2; ++_i) PG8_GL((const char*)(gbase) + voffB[_i], bufoff, _i); } while (0)
#define PG8_STAGE_A(bufoff, h, kb, NX) do { const char* _b = (NX) ? nA : cA; _Pragma("unroll") for (int _i = 0; _i < 2; ++_i) { \
        if constexpr (GATHER) { if (NX) PG8_GL(_b + (kb) + offN[h][_i], bufoff, _i); else PG8_GL(_b + (kb) + offC[h][_i], bufoff, _i); } \
        else PG8_GL(_b + (kb) + (h) * hstepA + voffA[_i], bufoff, _i); } } while (0)
#define PG8_LDA(dst, b, h) do { _Pragma("unroll") for (int m = 0; m < 4; ++m) _Pragma("unroll") for (int k = 0; k < 2; ++k) dst[m][k] = *(const PG8_LAS bf16x8*)(lds + PG8_SA(b, h) + aoff + m * 2048 + k * 1024); } while (0)
#define PG8_LDB(dst, b, h) do { _Pragma("unroll") for (int n = 0; n < 2; ++n) _Pragma("unroll") for (int k = 0; k < 2; ++k) dst[n][k] = *(const PG8_LAS bf16x8*)(lds + PG8_SB(b, h) + boff + n * 2048 + k * 1024); } while (0)
#define PG8_MMA(ai, bj, At, Bt) do { __builtin_amdgcn_s_setprio(1); _Pragma("unroll") for (int m = 0; m < 4; ++m) _Pragma("unroll") for (int n = 0; n < 2; ++n) _Pragma("unroll") for (int k = 0; k < 2; ++k) \
        acc[ai][bj][m][n] = __builtin_amdgcn_mfma_f32_16x16x32_bf16(Bt[n][k], At[m][k], acc[ai][bj][m][n], 0, 0, 0); __builtin_amdgcn_s_setprio(0); } while (0)
#define PG8_WAIT_V(n) asm volatile("s_waitcnt vmcnt(" #n ")" ::: "memory")
#define PG8_WAIT_L(n) asm volatile("s_waitcnt lgkmcnt(" #n ")" ::: "memory")
#define PG8_BAR __builtin_amdgcn_s_barrier()
#define PG8_SCHED __builtin_amdgcn_sched_barrier(0)
#define PG8_GOFF(dst, u) do { if constexpr (GATHER) { _Pragma("unroll") for (int _h = 0; _h < 2; ++_h) _Pragma("unroll") for (int _i = 0; _i < 2; ++_i) { \
        int _r = (u).r0 + _h * HALF + RA[_i]; _r = _r < (u).nrows ? _r : (u).nrows - 1; dst[_h][_i] = (unsigned)((u).list[_r] * lda + CA[_i]) * 2u; } } } while (0)
    Unit cur, nxt; int ui = 0;
    if (!S.next(0, cur)) return;
    f32x4 acc[2][2][4][2];
#pragma unroll
    for (int a = 0; a < 2; ++a)
#pragma unroll
        for (int b = 0; b < 2; ++b)
#pragma unroll
            for (int m = 0; m < 4; ++m)
#pragma unroll
                for (int n = 0; n < 2; ++n) acc[a][b][m][n] = (f32x4){0.f, 0.f, 0.f, 0.f};
    bf16x8 At[4][2], B0[2][2], B1[2][2];
    const char* cA = cur.A; const char* cB = cur.B; const char* nA = cA; const char* nB = cB;
    PG8_GOFF(offC, cur); PG8_GOFF(offN, cur);
    PG8_STAGE_B(PG8_SB(0, 0), cB); PG8_STAGE_B(PG8_SB(0, 1), cB + hstepB); PG8_STAGE_A(PG8_SA(0, 0), 0, 0, false); PG8_STAGE_A(PG8_SA(0, 1), 1, 0, false);
    if (wr == 1) PG8_BAR;
    PG8_WAIT_V(2); PG8_BAR;
    PG8_STAGE_B(PG8_SB(1, 0), cB + kstep); PG8_STAGE_A(PG8_SA(1, 0), 0, kstep, false); PG8_STAGE_B(PG8_SB(1, 1), cB + hstepB + kstep);
    PG8_WAIT_V(6); PG8_BAR;
    for (;;) {
        const bool has_next = S.next(ui + 1, nxt);
        nA = has_next ? nxt.A : cA; nB = has_next ? nxt.B : cB;
        if (has_next) PG8_GOFF(offN, nxt); else { if constexpr (GATHER) { _Pragma("unroll") for (int _h = 0; _h < 2; ++_h) _Pragma("unroll") for (int _i = 0; _i < 2; ++_i) offN[_h][_i] = offC[_h][_i]; } }
        for (int t = 0; t < nt; t += 2) {
            const bool last = (t == nt - 2);
            const size_t k1 = (size_t)(t + 1) * kstep;
            const size_t k2 = last ? 0 : (size_t)(t + 2) * kstep, k3 = k2 + kstep;
            const char* b2 = last ? nB : cB + (size_t)(t + 2) * kstep; const char* b3 = b2 + kstep;
            PG8_LDB(B0, 0, 0); PG8_LDB(B1, 0, 1); PG8_SCHED; PG8_LDA(At, 0, 0); PG8_STAGE_A(PG8_SA(1, 1), 1, k1, false);
            PG8_WAIT_V(8); PG8_WAIT_L(0); PG8_BAR; PG8_MMA(0, 0, At, B0); PG8_MMA(0, 1, At, B1); PG8_BAR; PG8_SCHED;
            PG8_LDA(At, 0, 1); PG8_STAGE_B(PG8_SB(0, 0), b2); PG8_STAGE_B(PG8_SB(0, 1), b2 + hstepB); PG8_STAGE_A(PG8_SA(0, 0), 0, k2, last);
            PG8_WAIT_V(8); PG8_WAIT_L(0); PG8_BAR; PG8_MMA(1, 0, At, B0); PG8_MMA(1, 1, At, B1); PG8_BAR; PG8_SCHED;
            PG8_LDB(B0, 1, 0); PG8_LDB(B1, 1, 1); PG8_SCHED; PG8_LDA(At, 1, 0); PG8_STAGE_A(PG8_SA(0, 1), 1, k2, last);
            PG8_WAIT_V(8); PG8_WAIT_L(0); PG8_BAR; PG8_MMA(0, 0, At, B0); PG8_MMA(0, 1, At, B1); PG8_BAR; PG8_SCHED;
            PG8_LDA(At, 1, 1); PG8_STAGE_B(PG8_SB(1, 0), b3); PG8_STAGE_B(PG8_SB(1, 1), b3 + hstepB); PG8_STAGE_A(PG8_SA(1, 0), 0, k3, last);
            PG8_WAIT_V(8); PG8_WAIT_L(0); PG8_BAR; PG8_MMA(1, 0, At, B0); PG8_MMA(1, 1, At, B1); PG8_BAR; PG8_SCHED;
        }
        if constexpr (ALIGN_EPI) { if (wr == 0) PG8_BAR; }
        E(acc, cur, wr, wc, fr, fq);
        if (!has_next) break;
#pragma unroll
        for (int a = 0; a < 2; ++a)
#pragma unroll
            for (int b = 0; b < 2; ++b)
#pragma unroll
                for (int m = 0; m < 4; ++m)
#pragma unroll
                    for (int n = 0; n < 2; ++n) acc[a][b][m][n] = (f32x4){0.f, 0.f, 0.f, 0.f};
        cur = nxt; cA = nA; cB = nB; ++ui;
        if constexpr (GATHER) { _Pragma("unroll") for (int _h = 0; _h < 2; ++_h) _Pragma("unroll") for (int _i = 0; _i < 2; ++_i) offC[_h][_i] = offN[_h][_i]; }
        if constexpr (ALIGN_EPI) { if (wr == 1) PG8_BAR; }
    }
    PG8_WAIT_V(0);
    if constexpr (!ALIGN_EPI) { if (wr == 0) PG8_BAR; }
    PG8_BAR;
#undef PG8_SA
#undef PG8_SB
#undef PG8_GL
#undef PG8_STAGE_A
#undef PG8_STAGE_B
#undef PG8_LDA
#undef PG8_LDB
#undef PG8_MMA
#undef PG8_WAIT_V
#undef PG8_WAIT_L
#undef PG8_BAR
#undef PG8_SCHED
#undef PG8_GOFF
}
struct EpiRaw {
    static constexpr bool PERM = true; bf16* O; int ldc;
    __device__ __forceinline__ void operator()(const f32x4 (&acc)[2][2][4][2], const Unit& u, int wr, int wc, int fr, int fq) const {
#pragma unroll
        for (int ai = 0; ai < 2; ++ai)
#pragma unroll
            for (int m = 0; m < 4; ++m) { bf16* rowp = O + (size_t)(u.pm * BM + ai * HALF + wr * 64 + m * 16 + fr) * ldc + u.pn * BM + wc * 32 + 8 * fq;
#pragma unroll
                for (int bj = 0; bj < 2; ++bj) { const f32x4 v0 = acc[ai][bj][m][0], v1 = acc[ai][bj][m][1];
                    u32x4 w; w.x = cvt_pk_bf16(v0[0], v0[1]); w.y = cvt_pk_bf16(v0[2], v0[3]); w.z = cvt_pk_bf16(v1[0], v1[1]); w.w = cvt_pk_bf16(v1[2], v1[3]);
                    *(u32x4*)(rowp + bj * HALF) = w; } }
    }
};
struct EpiOutRes {
    static constexpr bool PERM = false; const float* x; float* out; const float* mod;
    __device__ __forceinline__ void operator()(const f32x4 (&acc)[2][2][4][2], const Unit& u, int wr, int wc, int fr, int fq) const {
        const int b = (u.pm * BM) / SEQ; const int col0 = u.pn * BM + wc * 32 + 4 * fq;
        f32x4 g[2][2];
#pragma unroll
        for (int bj = 0; bj < 2; ++bj)
#pragma unroll
            for (int n = 0; n < 2; ++n) g[bj][n] = *(const f32x4*)(mod + b * 6144 + 2048 + col0 + bj * HALF + n * 16);
#pragma unroll
        for (int ai = 0; ai < 2; ++ai)
#pragma unroll
            for (int m = 0; m < 4; ++m) { const size_t off = (size_t)(u.pm * BM + ai * HALF + wr * 64 + m * 16 + fr) * DM + col0;
#pragma unroll
                for (int bj = 0; bj < 2; ++bj)
#pragma unroll
                    for (int n = 0; n < 2; ++n) { const f32x4 xv = *(const f32x4*)(x + off + bj * HALF + n * 16); *(f32x4*)(out + off + bj * HALF + n * 16) = xv + g[bj][n] * acc[ai][bj][m][n]; }
                asm volatile("" ::: "memory"); }
    }
};
struct EpiRouter {
    static constexpr bool PERM = false; float* LG;
    __device__ __forceinline__ void operator()(const f32x4 (&acc)[2][2][4][2], const Unit& u, int wr, int wc, int fr, int fq) const {
#pragma unroll
        for (int ai = 0; ai < 2; ++ai)
#pragma unroll
            for (int m = 0; m < 4; ++m)
#pragma unroll
                for (int n = 0; n < 2; ++n) *(f32x4*)(LG + (size_t)(u.pm * BM + ai * HALF + wr * 64 + m * 16 + fr) * 128 + wc * 32 + n * 16 + 4 * fq) = acc[ai][0][m][n];
    }
};
struct EpiCmp {
    static constexpr bool PERM = false; float* HID; const float* posb;
    __device__ __forceinline__ void operator()(const f32x4 (&acc)[2][2][4][2], const Unit& u, int wr, int wc, int fr, int fq) const {
        const int kv = u.pm >= 16 ? 1 : 0; const int col0 = wc * 32 + 4 * fq;
#pragma unroll
        for (int bj = 0; bj < 2; ++bj)
#pragma unroll
            for (int n = 0; n < 2; ++n) { const f32x4 pb = *(const f32x4*)(posb + kv * 256 + col0 + bj * HALF + n * 16);
#pragma unroll
                for (int ai = 0; ai < 2; ++ai)
#pragma unroll
                    for (int m = 0; m < 4; ++m) { const f32x4 v = acc[ai][bj][m][n] + pb; f32x4 o; o.x = silu_f(v.x); o.y = silu_f(v.y); o.z = silu_f(v.z); o.w = silu_f(v.w);
                        *(f32x4*)(HID + (size_t)(u.pm * BM + ai * HALF + wr * 64 + m * 16 + fr) * 256 + col0 + bj * HALF + n * 16) = o; } }
    }
};
struct EpiMoe1 {
    static constexpr bool PERM = true; bf16* H;
    __device__ __forceinline__ void operator()(const f32x4 (&acc)[2][2][4][2], const Unit& u, int wr, int wc, int fr, int fq) const {
#pragma unroll
        for (int ai = 0; ai < 2; ++ai)
#pragma unroll
            for (int m = 0; m < 4; ++m) { bf16* rowp = H + (size_t)(u.aux + ai * HALF + wr * 64 + m * 16 + fr) * 512 + ((u.pn * BM + wc * 32 + 8 * fq) >> 1);
#pragma unroll
                for (int bj = 0; bj < 2; ++bj) { const f32x4 v0 = acc[ai][bj][m][0], v1 = acc[ai][bj][m][1];
                    u32x2 w; w.x = cvt_pk_bf16(silu_f(v0[0]) * v0[1], silu_f(v0[2]) * v0[3]); w.y = cvt_pk_bf16(silu_f(v1[0]) * v1[1], silu_f(v1[2]) * v1[3]);
                    *(u32x2*)(rowp + bj * (HALF / 2)) = w; } }
    }
};
struct EpiMoe2 {
    static constexpr bool PERM = false; float* out; const float* mod;
    __device__ __forceinline__ void operator()(const f32x4 (&acc)[2][2][4][2], const Unit& u, int wr, int wc, int fr, int fq) const {
        const int col0 = u.pn * BM + wc * 32 + 4 * fq; const float* roww = (const float*)((const char*)u.list + (WS_ROWW - WS_LISTS));
#pragma unroll
        for (int ai = 0; ai < 2; ++ai)
#pragma unroll
            for (int m = 0; m < 4; ++m) { const int r = u.r0 + ai * HALF + wr * 64 + m * 16 + fr;
                if (r < u.nrows) { const int tok = u.list[r]; const float w = roww[r]; const int b = tok / SEQ; float* o = out + (size_t)tok * DM + col0; const float* g2 = mod + b * 6144 + 5120 + col0;
#pragma unroll
                    for (int bj = 0; bj < 2; ++bj)
#pragma unroll
                        for (int n = 0; n < 2; ++n) { const f32x4 gv = *(const f32x4*)(g2 + bj * HALF + n * 16); f32x4* op = (f32x4*)(o + bj * HALF + n * 16); *op = *op + gv * (acc[ai][bj][m][n] * w); } }
                asm volatile("" ::: "memory"); }
    }
};
__device__ __forceinline__ int xcd_remap(int L, int total) { const int q = total / NXCD, r = total % NXCD, xcd = L % NXCD, off = L / NXCD; return (xcd < r ? xcd * (q + 1) : r * (q + 1) + (xcd - r) * q) + off; }
__device__ __forceinline__ int find_list(const int* tb, int R, int lo, int hi) { while (hi - lo > 1) { const int mid = (lo + hi) >> 1; if (tb[mid] <= R) lo = mid; else hi = mid; } return lo; }
struct CmpOrder {
    const char* A; const char* B; int c;
    __device__ bool next(int i, Unit& u) const { if (i > 0 || c >= 32) return false; u.pm = c; u.pn = 0; u.A = A + (size_t)c * BM * 1024 * 2; u.B = B + (size_t)(c >= 16 ? 1 : 0) * 256 * 2048 * 2; u.list = nullptr; u.r0 = 0; u.nrows = BM; u.aux = 0; return true; }
};
struct MoeOrder1 {
    const char* XNb; const char* W13; const int* LISTS; const unsigned* cnt; const int* tb; int G, c;
    __device__ bool next(int i, Unit& u) const {
        const int total = tb[128] * 4; const long L0 = (long)i * G + c; if (L0 >= total) return false;
        const int L = xcd_remap((int)L0, total); const int R = L >> 2, pn = L & 3, idx = find_list(tb, R, 0, 128), e = idx & 63;
        u.pm = R; u.pn = pn; u.A = XNb; u.B = W13 + ((size_t)e * 1024 + pn * BM) * 1024 * 2; u.list = LISTS + (size_t)idx * T; u.r0 = (R - tb[idx]) * BM; u.nrows = (int)cnt[idx]; u.aux = R * BM; return true;
    }
};
struct MoeOrder2 {
    const char* Hb; const char* W2T; const int* LISTS; const unsigned* cnt; const int* tb; int G, c, k;
    __device__ bool next(int i, Unit& u) const {
        const int R0 = tb[64 * k], total = (tb[64 * k + 64] - R0) * 4; const long L0 = (long)i * G + c; if (L0 >= total) return false;
        const int L = xcd_remap((int)L0, total); const int R = R0 + (L >> 2), pn = L & 3, idx = find_list(tb, R, 64 * k, 64 * k + 64), e = idx & 63;
        u.pm = R; u.pn = pn; u.A = Hb + (size_t)R * BM * 512 * 2; u.B = W2T + ((size_t)e * 1024 + pn * BM) * 512 * 2; u.list = LISTS + (size_t)idx * T; u.r0 = (R - tb[idx]) * BM; u.nrows = (int)cnt[idx]; u.aux = 0; return true;
    }
};
}


__device__ void ph_mod(const P& p, int blk, int nblk, float* shb) {
    const float* c = p.in[1]; const float* w_ada = p.in[2]; const float* b_ada = p.in[3];
    float* mod = (float*)(p.ws + WS_MOD);
    const int tid = opq_tid(), wave = tid >> 6, lane = tid & 63, nw = blockDim.x >> 6;
    for (int task = blk; task < 96; task += nblk) {
        const int col = task * 64 + lane;
        float a0 = 0.f, a1 = 0.f;
        const int kper = 1024 / nw;
        for (int k = wave * kper; k < (wave + 1) * kper; ++k) {
            const float w = w_ada[(size_t)k * 6144 + col];
            a0 += silu_f(c[k]) * w; a1 += silu_f(c[1024 + k]) * w;
        }
        shb[(wave * 2 + 0) * 64 + lane] = a0; shb[(wave * 2 + 1) * 64 + lane] = a1;
        __syncthreads();
        if (wave < 2) { float s = 0.f; for (int w = 0; w < nw; ++w) s += shb[(w * 2 + wave) * 64 + lane]; mod[wave * 6144 + col] = s + b_ada[col]; }
        __syncthreads();
    }
    float* posb = (float*)(p.ws + WS_POSB);
    for (int task = blk; task < 8; task += nblk) {
        const int kv = task >> 2, col = (task & 3) * 64 + lane;
        const float* pos = p.in[8 + kv]; const float* w1 = p.in[kv == 0 ? 10 : 12];
        float a = 0.f; const int kper = 2048 / nw;
        for (int k = wave * kper; k < (wave + 1) * kper; ++k) a += pos[k] * w1[(size_t)k * 256 + col];
        shb[wave * 64 + lane] = a;
        __syncthreads();
        if (wave == 0) { float s = 0.f; for (int w = 0; w < nw; ++w) s += shb[w * 64 + lane]; posb[kv * 256 + col] = s; }
        __syncthreads();
    }
}

__device__ void ph_wprep_a(const P& p, int gw, int ngw, float* scr) {
    const int lane = opq_tid() & 63;
    bf16* WIN_T = (bf16*)(p.ws + WS_WIN_T); bf16* WOUT_T = (bf16*)(p.ws + WS_WOUT_T); bf16* CW1_T = (bf16*)(p.ws + WS_CW1_T); bf16* WR_T = (bf16*)(p.ws + WS_WR_T);
    constexpr int I_IN = (1024 / 64) * 89, I_OUT = 16 * 32, I_C = (2048 / 64) * 8;
    for (int it = gw; it < I_IN + I_OUT + 2 * I_C; it += ngw) {
        int r = it;
        if (r < I_IN) { transpose_item(p.in[5], 1024, NIN, WIN_T, 1, 0, scr, r, lane); continue; } r -= I_IN;
        if (r < I_OUT) { transpose_item(p.in[16], 1024, 1024, WOUT_T, 1, 0, scr, r, lane); continue; } r -= I_OUT;
        if (r < I_C) { transpose_item(p.in[10], 2048, 256, CW1_T, 1, 0, scr, r, lane); continue; } r -= I_C;
        transpose_item(p.in[12], 2048, 256, CW1_T + 256 * 2048, 1, 0, scr, r, lane);
    }
    for (int i = gw * 64 + lane; i < 224 * 1024 / 8; i += ngw * 64) *(u32x4*)(WIN_T + (size_t)2848 * 1024 + (size_t)i * 8) = (u32x4){0u, 0u, 0u, 0u};
    for (int i = gw * 64 + lane; i < 256 * 1024; i += ngw * 64) {
        const int n = i >> 10, k = i & 1023; float v = 0.f;
        if (n < 8) v = p.in[19][k * 8 + n]; else if (n < 72) v = p.in[21][k * 64 + (n - 8)];
        WR_T[i] = (bf16)f2bf(v);
    }
}
__device__ void ph_wprep_moe(const P& p, int gw, int ngw, float* scr) {
    const int lane = opq_tid() & 63;
    bf16* W13 = (bf16*)(p.ws + WS_W13_T); bf16* W2T = (bf16*)(p.ws + WS_W2_T);
    constexpr int I_13 = (1024 / 64) * (512 / 32), I_2 = (512 / 64) * (1024 / 32);
    for (int it = gw; it < NEXP * (2 * I_13 + I_2); it += ngw) {
        const int e = it / (2 * I_13 + I_2); int r = it % (2 * I_13 + I_2);
        if (r < I_13) { transpose_item(p.in[23] + (size_t)e * 1024 * 512, 1024, 512, W13 + (size_t)e * 1024 * 1024, 2, 0, scr, r, lane); continue; } r -= I_13;
        if (r < I_13) { transpose_item(p.in[24] + (size_t)e * 1024 * 512, 1024, 512, W13 + (size_t)e * 1024 * 1024, 2, 1, scr, r, lane); continue; } r -= I_13;
        transpose_item(p.in[25] + (size_t)e * 512 * 1024, 512, 1024, W2T + (size_t)e * 1024 * 512, 1, 0, scr, r, lane);
    }
}

__device__ void ph_rownorm(const P& p, int gw, int ngw, const float* src, int which) {
    const int lane = opq_tid() & 63;
    const float* nw = p.in[which == 0 ? 4 : 18];
    const float* mod = (const float*)(p.ws + WS_MOD);
    bf16* XN = (bf16*)(p.ws + WS_XN);
    f32x4 wv[4];
#pragma unroll
    for (int j = 0; j < 4; ++j) wv[j] = *(const f32x4*)(nw + 4 * lane + 256 * j);
    for (int row = gw; row < T; row += ngw) {
        const int b = row / SEQ;
        const float* sh = mod + b * 6144 + (which == 0 ? 0 : 3072); const float* sc = sh + 1024;
        const f32x4* xr = (const f32x4*)(src + (size_t)row * DM) + lane;
        f32x4 v[4]; float s = 0.f;
#pragma unroll
        for (int j = 0; j < 4; ++j) { v[j] = xr[64 * j]; s += v[j].x * v[j].x + v[j].y * v[j].y + v[j].z * v[j].z + v[j].w * v[j].w; }
        const float rstd = rsqrtf(wave_sum(s) * (1.f / DM) + EPS);
        unsigned long long* o8 = (unsigned long long*)(XN + (size_t)row * DM) + lane;
#pragma unroll
        for (int j = 0; j < 4; ++j) {
            const f32x4 scv = *(const f32x4*)(sc + 4 * lane + 256 * j), shv = *(const f32x4*)(sh + 4 * lane + 256 * j);
            const f32x4 h = v[j] * rstd * wv[j] * (scv + 1.f) + shv;
            o8[64 * j] = (unsigned long long)pk2(h.x, h.y) | ((unsigned long long)pk2(h.z, h.w) << 32);
        }
    }
}

constexpr float QSCALE = 0.125f * 1.4426950408889634f;
__device__ __forceinline__ int vt32_slot(int kk) { const int s = kk >> 4, rem = kk & 15, h = (rem >> 2) & 1, j = ((rem >> 3) << 2) | (rem & 3); return 16 * s + 8 * h + j; }
__device__ __forceinline__ int vt16_slot(int kk) { const int ks = kk >> 5, rem = kk & 31, hi = rem >> 4, r2 = rem & 15, qr = r2 >> 2, j = (r2 & 3) + 4 * hi; return 32 * ks + 8 * qr + j; }
__device__ void ph_post(const P& p, int gw, int ngw) {
    const int lane = opq_tid() & 63;
    const bf16* RAW = (const bf16*)(p.ws + WS_R1);
    bf16* Q = (bf16*)(p.ws + WS_Q); bf16* KV = (bf16*)(p.ws + WS_KV); float* GATES = (float*)(p.ws + WS_GATES); bf16* MIX = (bf16*)(p.ws + WS_MIX);
    const float qw = p.in[6][lane], kw1 = p.in[7][64 + lane], kw2 = p.in[7][128 + lane];
    const float* conv_w = p.in[14]; const float* onw = p.in[15];
    for (int t = gw; t < T; t += ngw) {
        const int b = t / SEQ, s = t % SEQ;
        const bf16* r = RAW + (size_t)t * NINP;
#pragma unroll
        for (int h = 0; h < 8; ++h) {
            const float v = bf2f(r[h * 64 + lane]);
            const float rs = rsqrtf(wave_sum(v * v) * (1.f / 64.f) + EPS);
            Q[((size_t)t * 8 + h) * 64 + lane] = (bf16)f2bf(v * rs * qw * QSCALE);
        }
#pragma unroll
        for (int i = 0; i < 6; ++i)
#pragma unroll
            for (int g = 0; g < 2; ++g) {
                float v = bf2f(r[512 + i * 128 + g * 64 + lane]);
                if (i == 2 || i == 4) { const float rs = rsqrtf(wave_sum(v * v) * (1.f / 64.f) + EPS); v = v * rs * (i == 2 ? kw1 : kw2); }
                bf16* base = KV + (((size_t)i * 2 + b) * 2 + g) * SEQ * 64;
                if (i == 3 || i == 5) {
                    base[(size_t)(s >> 5) * 2048 + lane * 32 + vt32_slot(s & 31)] = (bf16)f2bf(v);
                    if (i == 3) (KV + (((size_t)6 * 2 + b) * 2 + g) * SEQ * 64)[(size_t)(s >> 6) * 4096 + lane * 64 + vt16_slot(s & 63)] = (bf16)f2bf(v);
                } else base[(size_t)s * 64 + lane] = (bf16)f2bf(v);
            }
        if (lane < 24) GATES[(size_t)t * 24 + lane] = 1.f / (1.f + __expf(-bf2f(r[1280 + lane])));
#pragma unroll
        for (int j = 0; j < 8; ++j) {
            const int c = j * 64 + lane;
            float acc = 0.f;
#pragma unroll
            for (int d = 0; d < 3; ++d) {
                const int sd = s - 2 + d;
                if (sd >= 0) { const bf16* rr = RAW + (size_t)(t - 2 + d) * NINP; acc += conv_w[d * 512 + c] * bf2f(rr[1816 + c]) * bf2f(rr[2328 + c]); }
            }
            const float y = bf2f(r[1304 + c]) * acc;
            const float rs = rsqrtf(wave_sum(y * y) * (1.f / 64.f) + EPS);
            MIX[(size_t)t * DM + 512 + c] = (bf16)f2bf(y * rs * onw[512 + c]);
        }
    }
}

__device__ void ph_cmp_fin(const P& p, int gw, int ngw) {
    const int lane = opq_tid() & 63;
    const float* HID = (const float*)(p.ws + WS_HID); bf16* KCVC = (bf16*)(p.ws + WS_KCVC);
    const float kw0 = p.in[7][lane];
    for (int r = gw; r < 2 * 4096; r += ngw) {
        const int kv = r / 4096, row = r % 4096, n = row & 1023;
        float o = 0.f;
        if (n < NC) {
            const float* w2 = p.in[kv == 0 ? 11 : 13]; const float* h = HID + (size_t)r * 256;
            for (int j = 0; j < 256; ++j) o += h[j] * w2[j * 64 + lane];
            if (kv == 0) { const float rs = rsqrtf(wave_sum(o * o) * (1.f / 64.f) + EPS); o = o * rs * kw0; }
        }
        if (kv == 0) KCVC[(size_t)r * 64 + lane] = (bf16)f2bf(o);
        else KCVC[(size_t)(r - n) * 64 + (size_t)(n >> 5) * 2048 + lane * 32 + vt32_slot(n & 31)] = (bf16)f2bf(o);
    }
}

typedef float f32x16 __attribute__((ext_vector_type(16)));
typedef float f32x2_t __attribute__((ext_vector_type(2))); typedef __bf16 bf16x2_t __attribute__((ext_vector_type(2)));
#define MFMA32(a, b, c) __builtin_amdgcn_mfma_f32_32x32x16_bf16((a), (b), (c), 0, 0, 0)
#define MFMA16(a, b, c) __builtin_amdgcn_mfma_f32_16x16x32_bf16((a), (b), (c), 0, 0, 0)
__device__ __forceinline__ unsigned cvtpk(float lo, float hi) { f32x2_t v = {lo, hi}; bf16x2_t b = __builtin_convertvector(v, bf16x2_t); return __builtin_bit_cast(unsigned, b); }
__device__ __forceinline__ int crow(int i, int h) { return (i & 3) + 8 * (i >> 2) + 4 * h; }
#define PACK8(x, s) __builtin_bit_cast(bf16x8, (u32x4){cvtpk(x[8 * (s)], x[8 * (s) + 1]), cvtpk(x[8 * (s) + 2], x[8 * (s) + 3]), cvtpk(x[8 * (s) + 4], x[8 * (s) + 5]), cvtpk(x[8 * (s) + 6], x[8 * (s) + 7])})
constexpr int AL_Q = 0, AL_ACC = 32768, AL_MASK = 99328, AL_LACC = 101376, AL_ROWS = 102400, AL_RANK = 110592;
constexpr int SLOT_B = 528, CU_SCR_B = 458752;
constexpr int IMP_LD = 260, OACC_LD = 65;
typedef __attribute__((address_space(3))) const float* lds_cfp;

__device__ void build_bias_table(const P& p, float* biasL) {
    for (int i = threadIdx.x; i < 129 * 8; i += blockDim.x) {
        const int d = i >> 3, h = i & 7; int bk;
        if (d < 16) bk = d; else { bk = 16 + (int)(logf((float)d / 16.f) / logf(8.f) * 16.f); bk = min(bk, 31); }
        if (d >= 128) bk = 31;
        biasL[i] = (p.in[17][bk * 8 + h] - p.in[17][31 * 8 + h]) * 1.4426950408889634f;
    }
    __syncthreads();
}
template <int KIND> __device__ __forceinline__ float apply_p(f32x16& S, int key0, int h, int pos, int head, bool near, lds_cfp biasL) {
    float sum = 0.f;
    if (!near) {
#pragma unroll
        for (int i = 0; i < 16; ++i) { S[i] = __builtin_amdgcn_exp2f(S[i]); sum += S[i]; }
    } else {
#pragma unroll
        for (int i = 0; i < 16; ++i) { const int key = key0 + crow(i, h); const int dist = KIND == 0 ? pos - 16 * key - 31 : pos - key;
            const bool vis = dist >= 0 && (KIND != 1 || dist < 512); const int bi = min(max(dist, 0), 128);
            const float v = __builtin_amdgcn_exp2f(S[i] + biasL[bi * 8 + head]); S[i] = vis ? v : 0.f; sum += S[i]; }
    }
    return sum;
}
struct DCtx { int c, h, pos, pos_lo, pos_hi, head; lds_cfp biasL; };
template <int KIND, int MODE>
__device__ __forceinline__ void dense_range(const bf16* K, const bf16* Vt, int kt_lo, int kt_hi, const bf16x8 (&qf)[4], const DCtx& X, f32x16 (&O)[2], float& lsum, float rl, float& carry, float* imp_row) {
    if (kt_lo > kt_hi) return;
    const bf16* kp = K + (size_t)X.c * 64 + 8 * X.h; const bf16* vp = Vt + X.c * 32 + 8 * X.h;
    bf16x8 kA[4], kB[4], vA[4];
#define DR_LOAD(kf, kt) do { _Pragma("unroll") for (int k_ = 0; k_ < 4; ++k_) kf[k_] = *(const bf16x8*)(kp + (size_t)(kt) * 2048 + 16 * k_); } while (0)
#define DR_LOADV(vf, kt) do { \
        if (MODE & 1) { vf[0] = *(const bf16x8*)(vp + (size_t)(kt) * 2048); vf[1] = *(const bf16x8*)(vp + (size_t)(kt) * 2048 + 16); vf[2] = *(const bf16x8*)(vp + (size_t)(kt) * 2048 + 1024); vf[3] = *(const bf16x8*)(vp + (size_t)(kt) * 2048 + 1040); } } while (0)
#define DR_COMP(kf, vf, kt) do { DR_LOADV(vf, kt); f32x16 S; _Pragma("unroll") for (int i_ = 0; i_ < 16; ++i_) S[i_] = 0.f; \
        _Pragma("unroll") for (int k_ = 0; k_ < 4; ++k_) S = MFMA32(kf[k_], qf[k_], S); \
        bool near_; if (KIND == 0) near_ = !(X.pos_lo - 16 * (32 * (kt) + 31) - 31 >= 128); else if (KIND == 1) near_ = !((32 * (kt) + 31 <= X.pos_lo - 128) && (32 * (kt) >= X.pos_hi - 511)); else near_ = !(32 * (kt) + 31 <= X.pos_lo - 128); \
        lsum += apply_p<KIND>(S, 32 * (kt), X.h, X.pos, X.head, near_, X.biasL); \
        if (MODE & 1) { const bf16x8 pa0 = PACK8(S, 0), pa1 = PACK8(S, 1); O[0] = MFMA32(pa0, vf[0], O[0]); O[0] = MFMA32(pa1, vf[1], O[0]); O[1] = MFMA32(pa0, vf[2], O[1]); O[1] = MFMA32(pa1, vf[3], O[1]); } \
        if (MODE & 2) { float G[4], E[4], Eo[4]; \
            _Pragma("unroll") for (int m = 0; m < 4; ++m) { G[m] = (S[4 * m] + S[4 * m + 1] + S[4 * m + 2] + S[4 * m + 3]) * rl; E[m] = S[4 * m + 3] * rl; \
                G[m] += __shfl_xor(G[m], 1); G[m] += __shfl_xor(G[m], 2); E[m] += __shfl_xor(E[m], 1); E[m] += __shfl_xor(E[m], 2); Eo[m] = __shfl_xor(E[m], 32); } \
            if (X.h == 1) { _Pragma("unroll") for (int m = 0; m < 4; ++m) G[m] += Eo[m]; } \
            else { G[0] += carry; G[1] += Eo[0]; G[2] += Eo[1]; G[3] += Eo[2]; carry = Eo[3]; } \
            if ((X.c & 3) == 0) { _Pragma("unroll") for (int m = 0; m < 4; ++m) imp_row[(kt) * 8 + 2 * m + X.h] = G[m]; } } } while (0)
    DR_LOAD(kA, kt_lo);
    for (int kt = kt_lo; kt <= kt_hi; kt += 2) {
        if (kt + 1 <= kt_hi) DR_LOAD(kB, kt + 1);
        DR_COMP(kA, vA, kt);
        if (kt + 1 > kt_hi) break;
        if (kt + 2 <= kt_hi) DR_LOAD(kA, kt + 2);
        DR_COMP(kB, vA, kt + 1);
    }
#undef DR_LOAD
#undef DR_LOADV
#undef DR_COMP
}
__device__ __forceinline__ unsigned wave_max_u32(unsigned v) {
    v = max(v, (unsigned)__builtin_amdgcn_update_dpp(0, (int)v, 0xB1, 0xF, 0xF, false));
    v = max(v, (unsigned)__builtin_amdgcn_update_dpp(0, (int)v, 0x4E, 0xF, 0xF, false));
    v = max(v, (unsigned)__builtin_amdgcn_update_dpp(0, (int)v, 0x141, 0xF, 0xF, false));
    v = max(v, (unsigned)__builtin_amdgcn_update_dpp(0, (int)v, 0x140, 0xF, 0xF, false));
    const unsigned s0 = __builtin_amdgcn_readlane(v, 0), s1 = __builtin_amdgcn_readlane(v, 16), s2 = __builtin_amdgcn_readlane(v, 32), s3 = __builtin_amdgcn_readlane(v, 48);
    return max(max(s0, s1), max(s2, s3));
}
__device__ void attn_unit(const P& p, const int b, const int g, const int cur, unsigned char* ring, const float* biasLg) {
    const int tid = opq_tid(), lane = tid & 63, w = tid >> 6, c = lane & 31, h = lane >> 5;
    const int t0 = cur * 64; const size_t tbase = (size_t)b * SEQ;
    bf16* Qs = (bf16*)(ring + AL_Q); float* OACC = (float*)(ring + AL_ACC); float* ACC = OACC + w * (32 * OACC_LD);
    unsigned long long* MASK = (unsigned long long*)(ring + AL_MASK); float* LACC = (float*)(ring + AL_LACC);
    float* RS = (float*)(ring + AL_ROWS) + w * 256; unsigned char* RANK = ring + AL_RANK;
    unsigned char* CUS = p.ws + WS_LOGITS + (size_t)blockIdx.x * CU_SCR_B;
    const bf16* Qg = (const bf16*)(p.ws + WS_Q) + ((tbase + t0) * 8 + 4 * g) * 64;
    const bf16* KVall = (const bf16*)(p.ws + WS_KV);
    auto kvb = [&](int i) { return KVall + (((size_t)i * 2 + b) * 2 + g) * SEQ * 64; };
    const bf16* KC = (const bf16*)(p.ws + WS_KCVC) + (size_t)(b * 2 + g) * NCP * 64; const bf16* VCt = (const bf16*)(p.ws + WS_KCVC) + (size_t)(4 + b * 2 + g) * NCP * 64;
    const float* GATES = (const float*)(p.ws + WS_GATES);
#pragma unroll
    for (int k = 0; k < 4; ++k) { const int ci = tid + 512 * k, ql_ = ci >> 5, rem = ci & 31;
        *(u32x4*)(Qs + (size_t)ci * 8) = *(const u32x4*)(Qg + (size_t)(ql_ * 8 + (rem >> 3)) * 64 + (rem & 7) * 8); }
    if (tid < 256) MASK[tid] = 0ull;
    const int row = 32 * w + c, ql = row >> 2, hl = row & 3;
    DCtx X; X.c = c; X.h = h; X.pos = t0 + ql; X.pos_lo = t0 + 8 * w; X.pos_hi = X.pos_lo + 7; X.head = 4 * g + hl; X.biasL = (lds_cfp)biasLg;
    bf16x8 qf[4];
#pragma unroll
    for (int k = 0; k < 4; ++k) qf[k] = *(const bf16x8*)(Qg + (size_t)(ql * 8 + hl) * 64 + 16 * k + 8 * h);
    const float* gt = GATES + (tbase + X.pos) * 24 + X.head * 3;
    __syncthreads();
    const int NTc = (4 * cur + 3 + 31) >> 5;
    f32x16 Ob[2];
    float lsum = 0.f, carry = 0.f, dummy = 0.f;
    dense_range<0, 0>(KC, VCt, 0, NTc - 1, qf, X, Ob, lsum, 0.f, carry, nullptr);
#if PROBE_ATT == 1
    { float l2 = 0.f; dense_range<0, 0>(KC, VCt, 0, NTc - 1, qf, X, Ob, l2, 0.f, carry, nullptr); asm volatile("" :: "v"(l2)); }
#endif
    lsum += __shfl_xor(lsum, 32);
    const float rlc = lsum > 0.f ? 1.f / lsum : 0.f;
    dense_range<0, 2>(KC, VCt, 0, NTc - 1, qf, X, Ob, dummy, rlc, carry, OACC + (size_t)(8 * w + (c >> 2)) * IMP_LD);
    LDS_FENCE();
    if (cur >= 16) {
#if PROBE_ATT == 3
        for (int rep = 0; rep < 2; ++rep)
#endif
        for (int qi = 0; qi < 8; ++qi) {
            unsigned key[4];
#pragma unroll
            for (int j = 0; j < 4; ++j) { const int s = lane + 64 * j; const float v = OACC[(size_t)(8 * w + qi) * IMP_LD + s];
                key[j] = (s >= 1 && s <= cur - 2) ? ((__float_as_uint(v) & 0xFFFFFE00u) | 0x100u | (unsigned)(255 - s)) : 0u; }
            for (int r = 0; r < 13; ++r) {
                const unsigned m = wave_max_u32(max(max(key[0], key[1]), max(key[2], key[3])));
                if (m == 0u) break;
                if (lane == 0) { const unsigned sb = 255u - (m & 0xFFu); atomicOr(&MASK[sb], 1ull << (8 * w + qi)); RANK[(8 * w + qi) * 256 + sb] = (unsigned char)r; }
#pragma unroll
                for (int j = 0; j < 4; ++j) key[j] = key[j] == m ? 0u : key[j];
            }
        }
    }
    LDS_FENCE();
    if (cur >= 16) {
        __syncthreads();
        const int kr = lane & 15, qr = lane >> 4, qi = kr >> 2, hh = kr & 3, lim = cur - 2;
        const bf16* KS = kvb(2) + (size_t)kr * 64 + 8 * qr; const bf16* VS16 = kvb(6) + (size_t)kr * 64 + 8 * qr;
        lds_cfp biasL = X.biasL;
        bf16x8 kA[8], kB[8], vf[8];
#define GA_NEXT(s_) do { while ((s_) <= lim && MASK[(s_)] == 0ull) (s_) += 8; (s_) = __builtin_amdgcn_readfirstlane((s_)); } while (0)
#define GA_LOAD(kf, s_) do { _Pragma("unroll") for (int a_ = 0; a_ < 4; ++a_) _Pragma("unroll") for (int ks_ = 0; ks_ < 2; ++ks_) \
            kf[2 * a_ + ks_] = *(const bf16x8*)(KS + (size_t)((s_) * 64 + 16 * a_) * 64 + 32 * ks_); } while (0)
#define GA_LOADV(s_) do { _Pragma("unroll") for (int a_ = 0; a_ < 4; ++a_) _Pragma("unroll") for (int ks_ = 0; ks_ < 2; ++ks_) \
            vf[2 * a_ + ks_] = *(const bf16x8*)(VS16 + (size_t)((s_) * 64 + 16 * a_) * 64 + 32 * ks_); } while (0)
#define GA_PROC(kf, s_) do { GA_LOADV(s_); const unsigned long long mm_ = MASK[(s_)]; unsigned long long m = ((unsigned long long)__builtin_amdgcn_readfirstlane((unsigned)(mm_ >> 32)) << 32) | (unsigned)__builtin_amdgcn_readfirstlane((unsigned)mm_); \
            const bool near = ((s_) == lim); \
            while (m) { int q0 = __builtin_ctzll(m); m &= m - 1; int nv = 1, q1 = q0, q2 = q0, q3 = q0; \
                if (m) { q1 = __builtin_ctzll(m); m &= m - 1; nv = 2; if (m) { q2 = __builtin_ctzll(m); m &= m - 1; nv = 3; if (m) { q3 = __builtin_ctzll(m); m &= m - 1; nv = 4; } } } \
                const int myq = qi == 0 ? q0 : qi == 1 ? q1 : qi == 2 ? q2 : q3; \
                const bf16* qp = Qs + (size_t)(myq * 4 + hh) * 64 + 8 * qr; const bf16x8 qb0 = *(const bf16x8*)qp, qb1 = *(const bf16x8*)(qp + 32); \
                f32x4 St[4]; _Pragma("unroll") for (int kg = 0; kg < 4; ++kg) { St[kg] = (f32x4){0.f, 0.f, 0.f, 0.f}; St[kg] = MFMA16(kf[2 * kg], qb0, St[kg]); St[kg] = MFMA16(kf[2 * kg + 1], qb1, St[kg]); } \
                float lg = 0.f; const int qpos = t0 + myq; \
                _Pragma("unroll") for (int kg = 0; kg < 4; ++kg) _Pragma("unroll") for (int e = 0; e < 4; ++e) { float x = St[kg][e]; \
                    if (near) { const int dist = qpos - ((s_) * 64 + 16 * kg + 4 * qr + e); x += biasL[min(max(dist, 0), 128) * 8 + 4 * g + hh]; } \
                    x = __builtin_amdgcn_exp2f(x); St[kg][e] = x; lg += x; } \
                const bf16x8 pb0 = __builtin_bit_cast(bf16x8, (u32x4){cvtpk(St[0][0], St[0][1]), cvtpk(St[0][2], St[0][3]), cvtpk(St[1][0], St[1][1]), cvtpk(St[1][2], St[1][3])}); \
                const bf16x8 pb1 = __builtin_bit_cast(bf16x8, (u32x4){cvtpk(St[2][0], St[2][1]), cvtpk(St[2][2], St[2][3]), cvtpk(St[3][0], St[3][1]), cvtpk(St[3][2], St[3][3])}); \
                f32x4 OT[4]; _Pragma("unroll") for (int dg = 0; dg < 4; ++dg) { OT[dg] = (f32x4){0.f, 0.f, 0.f, 0.f}; OT[dg] = MFMA16(vf[2 * dg], pb0, OT[dg]); OT[dg] = MFMA16(vf[2 * dg + 1], pb1, OT[dg]); } \
                lg += __shfl_xor(lg, 16); lg += __shfl_xor(lg, 32); \
                if (qi < nv && !noacc) { unsigned char* sp = CUS + (size_t)(myq * 13 + RANK[myq * 256 + (s_)]) * SLOT_B; \
                    _Pragma("unroll") for (int dg = 0; dg < 4; ++dg) *(u32x2*)(sp + hh * 128 + (16 * dg + 4 * qr) * 2) = (u32x2){cvtpk(OT[dg][0], OT[dg][1]), cvtpk(OT[dg][2], OT[dg][3])}; \
                    if (qr == 0) *(float*)(sp + 512 + hh * 4) = lg; } } } while (0)
#if PROBE_ATT == 4
        for (int rep = 0; rep < 2; ++rep) { const bool noacc = (rep == 0);
#else
        { const bool noacc = false;
#endif
        int s = (w == 0) ? 8 : w; GA_NEXT(s);
        if (s <= lim) GA_LOAD(kA, s);
        while (s <= lim) {
            int s2 = s + 8; GA_NEXT(s2);
            if (s2 <= lim) GA_LOAD(kB, s2);
            GA_PROC(kA, s);
            if (s2 > lim) break;
            s = s2 + 8; GA_NEXT(s);
            if (s <= lim) GA_LOAD(kA, s);
            GA_PROC(kB, s2);
        }
        }
#undef GA_NEXT
#undef GA_LOAD
#undef GA_LOADV
#undef GA_PROC
        asm volatile("s_waitcnt vmcnt(0) lgkmcnt(0)" ::: "memory");
        __syncthreads();
        for (int qi2 = 0; qi2 < 8; ++qi2) {
            const unsigned char* qb = CUS + (size_t)((8 * w + qi2) * 13) * SLOT_B;
            float a0 = 0.f, a1 = 0.f, a2 = 0.f, a3 = 0.f, ll = 0.f;
#pragma unroll
            for (int r = 0; r < 13; ++r) {
                const unsigned long long v = __hip_atomic_load((const unsigned long long*)(qb + r * SLOT_B + lane * 8), __ATOMIC_RELAXED, __HIP_MEMORY_SCOPE_AGENT);
                a0 += bflo((unsigned)v); a1 += bfhi((unsigned)v); a2 += bflo((unsigned)(v >> 32)); a3 += bfhi((unsigned)(v >> 32));
                if (lane < 4) ll += __builtin_bit_cast(float, __hip_atomic_load((const unsigned*)(qb + r * SLOT_B + 512 + lane * 4), __ATOMIC_RELAXED, __HIP_MEMORY_SCOPE_AGENT));
            }
            float* ap = ACC + (size_t)(qi2 * 4 + (lane >> 4)) * OACC_LD + 4 * (lane & 15);
            ap[0] = a0; ap[1] = a1; ap[2] = a2; ap[3] = a3;
            if (lane < 4) LACC[32 * w + qi2 * 4 + lane] = ll;
        }
    } else {
        for (int i = lane; i < 32 * OACC_LD; i += 64) ACC[i] = 0.f;
        if (lane < 32) LACC[32 * w + lane] = 0.f;
    }
    LDS_FENCE();
#pragma unroll
    for (int k = 0; k < 4; ++k) qf[k] = *(const bf16x8*)(Qg + (size_t)(ql * 8 + hl) * 64 + 16 * k + 8 * h);
#pragma unroll
    for (int i = 0; i < 16; ++i) { Ob[0][i] = 0.f; Ob[1][i] = 0.f; }
    lsum = 0.f;
    if (cur <= 15) dense_range<2, 1>(kvb(2), kvb(3), 0, 2 * cur + 1, qf, X, Ob, lsum, 0.f, carry, nullptr);
    else { dense_range<2, 1>(kvb(2), kvb(3), 0, 1, qf, X, Ob, lsum, 0.f, carry, nullptr); dense_range<2, 1>(kvb(2), kvb(3), 2 * cur - 2, 2 * cur + 1, qf, X, Ob, lsum, 0.f, carry, nullptr); }
    lsum += __shfl_xor(lsum, 32);
    if (h == 0) { const float ls = lsum + LACC[32 * w + c]; RS[c] = gt[1] * (ls > 0.f ? 1.f / ls : 0.f); }
    LDS_FENCE();
#pragma unroll
    for (int i = 0; i < 16; ++i) { const int r = crow(i, h); const float a = RS[r];
#pragma unroll
        for (int d0 = 0; d0 < 2; ++d0) { float* ap = ACC + r * OACC_LD + 32 * d0 + c; *ap = a * (Ob[d0][i] + *ap); } }
#if PROBE_ATT == 5
    { float l2 = 0.f;
#pragma unroll
      for (int i = 0; i < 16; ++i) { Ob[0][i] = 0.f; Ob[1][i] = 0.f; }
      dense_range<0, 1>(KC, VCt, 0, NTc - 1, qf, X, Ob, l2, 0.f, carry, nullptr); asm volatile("" :: "v"(l2), "v"(Ob[0]), "v"(Ob[1])); }
#endif
#pragma unroll
    for (int i = 0; i < 16; ++i) { Ob[0][i] = 0.f; Ob[1][i] = 0.f; }
    dense_range<0, 1>(KC, VCt, 0, NTc - 1, qf, X, Ob, dummy, 0.f, carry, nullptr);
    if (h == 0) RS[32 + c] = gt[0] * rlc;
    LDS_FENCE();
#pragma unroll
    for (int i = 0; i < 16; ++i) { const int r = crow(i, h); const float a = RS[32 + r];
#pragma unroll
        for (int d0 = 0; d0 < 2; ++d0) { float* ap = ACC + r * OACC_LD + 32 * d0 + c; *ap += a * Ob[d0][i]; } }
#if PROBE_ATT == 2
    { float l2 = 0.f;
#pragma unroll
      for (int i = 0; i < 16; ++i) { Ob[0][i] = 0.f; Ob[1][i] = 0.f; }
      dense_range<1, 1>(kvb(4), kvb(5), max(0, X.pos_lo - 511) >> 5, X.pos_hi >> 5, qf, X, Ob, l2, 0.f, carry, nullptr); asm volatile("" :: "v"(l2), "v"(Ob[0]), "v"(Ob[1])); }
#endif
#pragma unroll
    for (int i = 0; i < 16; ++i) { Ob[0][i] = 0.f; Ob[1][i] = 0.f; }
    lsum = 0.f;
    dense_range<1, 1>(kvb(4), kvb(5), max(0, X.pos_lo - 511) >> 5, X.pos_hi >> 5, qf, X, Ob, lsum, 0.f, carry, nullptr);
    lsum += __shfl_xor(lsum, 32);
    if (h == 0) RS[64 + c] = gt[2] * (lsum > 0.f ? 1.f / lsum : 0.f);
    LDS_FENCE();
#pragma unroll
    for (int i = 0; i < 16; ++i) { const int r = crow(i, h); const float a = RS[64 + r];
#pragma unroll
        for (int d0 = 0; d0 < 2; ++d0) { float* ap = ACC + r * OACC_LD + 32 * d0 + c; *ap += a * Ob[d0][i]; } }
    LDS_FENCE();
    {
        const int r = lane >> 1, hf = lane & 1; const float* src = ACC + r * OACC_LD + 32 * hf;
        float v[32]; float ss = 0.f;
#pragma unroll
        for (int k = 0; k < 32; ++k) { v[k] = src[k]; ss += v[k] * v[k]; }
        ss += __shfl_xor(ss, 1);
        const float rstd = rsqrtf(ss * (1.f / 64.f) + EPS);
        const int rq = (32 * w + r) >> 2, rh = (32 * w + r) & 3; const int col = (4 * g + rh) * 64 + 32 * hf;
        const float* onw = p.in[15] + col; bf16* dst = (bf16*)(p.ws + WS_MIX) + (tbase + t0 + rq) * DM + col;
#pragma unroll
        for (int k = 0; k < 4; ++k) { const f32x4 w0 = *(const f32x4*)(onw + 8 * k), w1 = *(const f32x4*)(onw + 8 * k + 4);
            *(u32x4*)(dst + 8 * k) = (u32x4){cvtpk(v[8 * k] * rstd * w0.x, v[8 * k + 1] * rstd * w0.y), cvtpk(v[8 * k + 2] * rstd * w0.z, v[8 * k + 3] * rstd * w0.w),
                                            cvtpk(v[8 * k + 4] * rstd * w1.x, v[8 * k + 5] * rstd * w1.y), cvtpk(v[8 * k + 6] * rstd * w1.z, v[8 * k + 7] * rstd * w1.w)}; }
    }
    __syncthreads();
}
__device__ void ph_attn(const P& p, unsigned char* ring, float* biasL) {
    build_bias_table(p, biasL);
    const int bx = blockIdx.x, vcu = (bx & 7) * 32 + (bx >> 3), bg = vcu >> 6, si = vcu & 63;
    for (int ui = 0; ui < 4; ++ui) {
        const int cur = ui == 0 ? si : ui == 1 ? 127 - si : ui == 2 ? 128 + si : 255 - si;
        attn_unit(p, bg >> 1, bg & 1, cur, ring, biasL);
    }
}

__device__ void ph_route(const P& p, int gtid, int nthreads) {
    const float* LG = (const float*)(p.ws + WS_LOGITS); unsigned* cnt = (unsigned*)(p.ws + WS_CTL) + CW_CNT;
    int* LISTS = (int*)(p.ws + WS_LISTS); float* ROWW = (float*)(p.ws + WS_ROWW);
    const float* bg = p.in[20]; const float* be = p.in[22];
    for (int t = gtid; t < T; t += nthreads) {
        const float* l = LG + (size_t)t * 128;
        float gl[8]; float gm = -3.0e38f; int gi = 0;
#pragma unroll
        for (int i = 0; i < 8; ++i) { gl[i] = l[i] + bg[i]; if (gl[i] > gm) { gm = gl[i]; gi = i; } }
        float gs = 0.f;
#pragma unroll
        for (int i = 0; i < 8; ++i) gs += __expf(gl[i] - gm);
        const float gp = 1.f / gs;
        float el[8]; float m0 = -3.0e38f, m1 = -3.0e38f; int i0 = 0, i1 = 0;
#pragma unroll
        for (int i = 0; i < 8; ++i) { el[i] = l[8 + gi * 8 + i] + be[gi * 8 + i];
            if (el[i] > m0) { m1 = m0; i1 = i0; m0 = el[i]; i0 = i; } else if (el[i] > m1) { m1 = el[i]; i1 = i; } }
        const float e1 = __expf(m1 - m0); const float p0 = 1.f / (1.f + e1), p1 = e1 / (1.f + e1);
        const int ex0 = gi * 8 + i0, ex1 = gi * 8 + i1;
        const unsigned s0 = atomicAdd(&cnt[ex0], 1u), s1 = atomicAdd(&cnt[64 + ex1], 1u);
        LISTS[(size_t)ex0 * T + s0] = t; ROWW[(size_t)ex0 * T + s0] = gp * p0;
        LISTS[(size_t)(64 + ex1) * T + s1] = t; ROWW[(size_t)(64 + ex1) * T + s1] = gp * p1;
    }
}
__device__ void build_tile_base(const P& p, int* tb) {
    const unsigned* cnt = (const unsigned*)(p.ws + WS_CTL) + CW_CNT;
    if (threadIdx.x == 0) { int s = 0; for (int i = 0; i < 128; ++i) { tb[i] = s; s += ((int)cnt[i] + 255) >> 8; } tb[128] = s; }
    __syncthreads();
}
#define LAS __attribute__((address_space(3)))
#define XB_TMO      128
#define XB_XCNT(j)  (256  + 64 * (j))
#define XB_XSUB(j)  (1280 + 64 * (j))
#define XB_XGEN(j)  (2304 + 64 * (j))
#define XB_TOP      3328
#define XB_TOPGEN   3392
#define XCD_BAR_WORDS 3456
#define XB_SPIN_CAP (1u << 18)
constexpr int CW_BAR = 4096;
__device__ __forceinline__ unsigned xb_ld(unsigned* p)              { return __hip_atomic_load(p, __ATOMIC_RELAXED, __HIP_MEMORY_SCOPE_AGENT); }
__device__ __forceinline__ unsigned xb_add(unsigned* p, unsigned v) { return __hip_atomic_fetch_add(p, v, __ATOMIC_RELAXED, __HIP_MEMORY_SCOPE_AGENT); }
__device__ __forceinline__ unsigned xb_xcc_id() { return (unsigned)__builtin_amdgcn_s_getreg((3 << 11) | 20) & 0xFu; }
#define XB_SPIN(cond, bar) do { unsigned _sp = 0; while (cond) { __builtin_amdgcn_s_sleep(1); \
    if ((++_sp & 255u) == 0u) { if (xb_ld(&(bar)[XB_TMO])) break; if (_sp > XB_SPIN_CAP) { atomicAdd(&(bar)[XB_TMO], 1u); break; } } } } while (0)
struct XcdBarrier { unsigned* bar; unsigned x; volatile LAS unsigned* st; };
__device__ __forceinline__ XcdBarrier xcd_barrier_post(unsigned* bar, volatile LAS unsigned* st) {
    XcdBarrier b; b.bar = bar; b.x = xb_xcc_id(); b.st = st;
    if (threadIdx.x == 0) (void)xb_add(&bar[XB_XCNT(b.x)], 1u);
    return b;
}
__device__ __forceinline__ void xcd_barrier_complete(unsigned* bar, unsigned x, unsigned& nloc, unsigned& nx) {
    const unsigned G = gridDim.x * gridDim.y * gridDim.z;
    unsigned sum, cnt, mine, sp = 0u;
    for (;;) {
        sum = 0u; cnt = 0u; mine = 0u;
#pragma unroll
        for (unsigned j = 0; j < 16; ++j) { const unsigned c = xb_ld(&bar[XB_XCNT(j)]); sum += c; cnt += (c > 0u) ? 1u : 0u; mine = (j == x) ? c : mine; }
        if (sum == G) break;
        __builtin_amdgcn_s_sleep(1);
        if ((++sp & 255u) == 0u) { if (xb_ld(&bar[XB_TMO])) break; if (sp > XB_SPIN_CAP) { atomicAdd(&bar[XB_TMO], 1u); break; } }
    }
    nloc = mine > 0u ? mine : 1u; nx = cnt > 0u ? cnt : 1u;
}
__device__ __forceinline__ void xcd_barrier(const XcdBarrier& b) {
    asm volatile("s_waitcnt vmcnt(0)" ::: "memory");
    __syncthreads();
    if (threadIdx.x == 0) {
        unsigned* bar = b.bar;
        __builtin_amdgcn_s_waitcnt(0);
        unsigned nloc = b.st[0], nx = b.st[1];
        if (nloc == 0u) { xcd_barrier_complete(bar, b.x, nloc, nx); b.st[0] = nloc; b.st[1] = nx; }
        const unsigned old = xb_add(&bar[XB_XSUB(b.x)], 1u);
        const unsigned gen = old / nloc;
        if (old + 1u == (gen + 1u) * nloc) {
            __builtin_amdgcn_fence(__ATOMIC_RELEASE, "agent");
            asm volatile("s_waitcnt vmcnt(0)" ::: "memory");
            const unsigned og = xb_add(&bar[XB_TOP], 1u);
            const unsigned tg = og / nx;
            if (og + 1u == (tg + 1u) * nx) xb_add(&bar[XB_TOPGEN], 1u);
            else XB_SPIN(xb_ld(&bar[XB_TOPGEN]) == tg, bar);
            __builtin_amdgcn_fence(__ATOMIC_ACQUIRE, "agent");
            xb_add(&bar[XB_XGEN(b.x)], 1u);
            asm volatile("s_waitcnt vmcnt(0)" ::: "memory");
        } else {
            XB_SPIN(xb_ld(&bar[XB_XGEN(b.x)]) == gen, bar);
            __builtin_amdgcn_fence(__ATOMIC_ACQUIRE, "agent");
            asm volatile("s_waitcnt vmcnt(0)" ::: "memory");
        }
    }
    __syncthreads();
}

constexpr int NT = 512;
constexpr int LDS_SCR = 0, LDS_SHB = 131072, LDS_MISC = LDS_SHB + 8192, LDS_BYTES = 147456;
__global__ void __launch_bounds__(NT) mega(P p) {
    extern __shared__ __attribute__((aligned(16))) unsigned char ldsb[];
    float* lds = (float*)ldsb;
    const int ngw = gridDim.x * (NT / 64);
#define TIDV opq_tid()
#define GW (blockIdx.x * (NT / 64) + (TIDV >> 6))
#define SCR (lds + (TIDV >> 6) * (8448 / 4))
    float* shb = lds + LDS_SHB / 4;
    volatile LAS unsigned* misc = (volatile LAS unsigned*)((LAS unsigned char*)ldsb + LDS_MISC);
    if (threadIdx.x < 16) misc[threadIdx.x] = 0u;
    __syncthreads();
    XcdBarrier bar = xcd_barrier_post((unsigned*)(p.ws + WS_CTL) + CW_BAR, misc);
#define GB() xcd_barrier(bar)
    PG8_LAS unsigned char* ring = (PG8_LAS unsigned char*)ldsb;
    const int G = gridDim.x, cb = blockIdx.x;
    const unsigned* cnt = (const unsigned*)(p.ws + WS_CTL) + CW_CNT;
#define PHASE_0 { ph_mod(p, blockIdx.x, gridDim.x, shb); ph_wprep_a(p, GW, ngw, SCR); }
#define PHASE_1 { ph_rownorm(p, GW, ngw, p.in[0], 0); }
#define PHASE_2 { pg8::StaticOrder S; S.init(p.ws + WS_XN, p.ws + WS_WIN_T, DM, DM, T, NINP, G, cb); pg8::EpiRaw E{(bf16*)(p.ws + WS_R1), NINP}; \
      pg8::gemm_phase<pg8::EpiRaw, pg8::StaticOrder, false>(ring, DM, DM, S, E); }
#define PHASE_3 { ph_post(p, GW, ngw); }
#define PHASE_4 { if (cb < 32) { pg8::CmpOrder S{(const char*)(p.ws + WS_KV), (const char*)(p.ws + WS_CW1_T), cb}; pg8::EpiCmp E{(float*)(p.ws + WS_HID), (const float*)(p.ws + WS_POSB)}; \
      pg8::gemm_phase<pg8::EpiCmp, pg8::CmpOrder, false>(ring, 2048, 1024, S, E); } \
    else ph_wprep_moe(p, GW - 32 * (NT / 64), ngw - 32 * (NT / 64), SCR); }
#define PHASE_5 { ph_cmp_fin(p, GW, ngw); }
#define PHASE_6 { ph_attn(p, ldsb, shb); }
#define PHASE_7 { pg8::StaticOrder S; S.init(p.ws + WS_MIX, p.ws + WS_WOUT_T, DM, DM, T, DM, G, cb); pg8::EpiOutRes E{p.in[0], p.out, (const float*)(p.ws + WS_MOD)}; \
      pg8::gemm_phase<pg8::EpiOutRes, pg8::StaticOrder, false>(ring, DM, DM, S, E); }
#define PHASE_8 { ph_rownorm(p, GW, ngw, p.out, 1); }
#define PHASE_9 { pg8::StaticOrder S; S.init(p.ws + WS_XN, p.ws + WS_WR_T, DM, DM, T, 256, G, cb); pg8::EpiRouter E{(float*)(p.ws + WS_LOGITS)}; \
      pg8::gemm_phase<pg8::EpiRouter, pg8::StaticOrder, false>(ring, DM, DM, S, E); }
#define PHASE_10 { ph_route(p, blockIdx.x * NT + TIDV, gridDim.x * NT); }
#define PHASE_11 { build_tile_base(p, (int*)shb); pg8::MoeOrder1 S{(const char*)(p.ws + WS_XN), (const char*)(p.ws + WS_W13_T), (const int*)(p.ws + WS_LISTS), cnt, (const int*)shb, G, cb}; pg8::EpiMoe1 E{(bf16*)(p.ws + WS_H)}; \
      pg8::gemm_phase<pg8::EpiMoe1, pg8::MoeOrder1, true>(ring, DM, DM, S, E); }
#define PHASE_12 { pg8::MoeOrder2 S{(const char*)(p.ws + WS_H), (const char*)(p.ws + WS_W2_T), (const int*)(p.ws + WS_LISTS), cnt, (const int*)shb, G, cb, 0}; pg8::EpiMoe2 E{p.out, (const float*)(p.ws + WS_MOD)}; \
      pg8::gemm_phase<pg8::EpiMoe2, pg8::MoeOrder2, false>(ring, 512, 512, S, E); }
#define PHASE_13 { pg8::MoeOrder2 S{(const char*)(p.ws + WS_H), (const char*)(p.ws + WS_W2_T), (const int*)(p.ws + WS_LISTS), cnt, (const int*)shb, G, cb, 1}; pg8::EpiMoe2 E{p.out, (const float*)(p.ws + WS_MOD)}; \
      pg8::gemm_phase<pg8::EpiMoe2, pg8::MoeOrder2, false>(ring, 512, 512, S, E); }
#ifndef PROBE_DUP
#define PROBE_DUP -1
#endif
#define RUN(k) { PHASE_##k GB(); if (PROBE_DUP == k) { PHASE_##k GB(); } }
    RUN(0) RUN(1) RUN(2) RUN(3) RUN(4) RUN(5) RUN(6) RUN(7) RUN(8) RUN(9)
    PHASE_10 GB();
    RUN(11)
    PHASE_12 GB();
    PHASE_13
}

extern "C" void kernel_launch(void* const* d_in, const int* in_sizes, int n_in, void* d_out, int out_size, void* d_ws, size_t ws_size, hipStream_t stream) {
    static int ready = 0;
    if (ready == 0) {
        if (n_in != 26 || ws_size < WS_END) { fprintf(stderr, "kernel_launch: bad args n_in=%d ws=%zu\n", n_in, ws_size); ready = -1; return; }
        if (hipFuncSetAttribute((const void*)mega, hipFuncAttributeMaxDynamicSharedMemorySize, LDS_BYTES) != hipSuccess) { fprintf(stderr, "kernel_launch: hipFuncSetAttribute failed\n"); ready = -1; return; }
        ready = 1;
    }
    if (ready < 0) return;
    P p{};
    for (int i = 0; i < 26; ++i) p.in[i] = (const float*)d_in[i];
    p.out = (float*)d_out; p.ws = (unsigned char*)d_ws;
    (void)hipMemsetAsync((char*)d_ws + WS_CTL, 0, 1 * MiB, stream);
    hipLaunchKernelGGL(mega, dim3(256), dim3(NT), LDS_BYTES, stream, p);
}
```

```cpp
#include <hip/hip_runtime.h>
#include <stdint.h>
#include <stdio.h>

#ifndef PROBE_ATT
#define PROBE_ATT 0
#endif
#ifndef SW_REGION
#define SW_REGION 0
#endif
#define SW_BEGIN(r) do { if (SW_REGION == (r)) sw_t0 = __builtin_amdgcn_s_memrealtime(); } while (0)
#define SW_END(r) do { if (SW_REGION == (r)) { asm volatile("s_waitcnt vmcnt(0) lgkmcnt(0)" ::: "memory"); sw_acc += __builtin_amdgcn_s_memrealtime() - sw_t0; } } while (0)
#ifndef NAIVE_GEMM
#define NAIVE_GEMM 0
#endif

typedef unsigned short bf16;
typedef short bf16x8 __attribute__((ext_vector_type(8)));
typedef float f32x4 __attribute__((ext_vector_type(4)));
typedef unsigned u32x4 __attribute__((ext_vector_type(4)));
typedef unsigned u32x2 __attribute__((ext_vector_type(2)));

constexpr int BATCH = 2, SEQ = 16384, DM = 1024, T = BATCH * SEQ;
constexpr int NIN = 2840, NINP = 3072;
constexpr int NC = 1023, NCP = 1024, NS = 256;
constexpr int NEXP = 64;
constexpr float EPS = 1e-6f;

constexpr size_t MiB = 1u << 20;
constexpr size_t WS_CTL = 0;
constexpr size_t WS_MOD = 1 * MiB;
constexpr size_t WS_POSB = 1 * MiB + 65536;
constexpr size_t WS_WIN_T = 2 * MiB;
constexpr size_t WS_WOUT_T = 8 * MiB;
constexpr size_t WS_CW1_T = 10 * MiB;
constexpr size_t WS_WR_T = 12 * MiB;
constexpr size_t WS_CW2_T = 12 * MiB + 524288;
constexpr size_t WS_HID = 13 * MiB;
constexpr size_t WS_KCVC = 21 * MiB;
constexpr size_t WS_GATES = 22 * MiB;
constexpr size_t WS_LOGITS = 25 * MiB;
constexpr size_t WS_LISTS = 41 * MiB;
constexpr size_t WS_ROWW = 57 * MiB;
constexpr size_t WS_XN = 73 * MiB;
constexpr size_t WS_R1 = 137 * MiB;
constexpr size_t WS_W13_T = WS_R1;
constexpr size_t WS_W2_T = WS_R1 + 128 * MiB;
constexpr size_t WS_Q = 329 * MiB;
constexpr size_t WS_KV = 361 * MiB;
constexpr size_t WS_H = 329 * MiB;
constexpr size_t WS_MIX = 418 * MiB;
constexpr size_t WS_Y1 = 425 * MiB;
constexpr size_t WS_X1 = 489 * MiB;
constexpr size_t WS_END = 553 * MiB;

constexpr int CW_CNT = 0;

struct P {
    const float* in[26];
    float* out;
    unsigned char* ws;
};

__device__ __forceinline__ unsigned f2bf(float f) { unsigned u = __builtin_bit_cast(unsigned, f); return (u + 0x7fffu + ((u >> 16) & 1u)) >> 16; }
__device__ __forceinline__ unsigned pk2(float lo, float hi) { return f2bf(lo) | (f2bf(hi) << 16); }
__device__ __forceinline__ float bf2f(unsigned short h) { return __builtin_bit_cast(float, (unsigned)h << 16); }
__device__ __forceinline__ float bflo(unsigned u) { return __builtin_bit_cast(float, u << 16); }
__device__ __forceinline__ float bfhi(unsigned u) { return __builtin_bit_cast(float, u & 0xffff0000u); }
#define DPPF(x, ctrl) __builtin_bit_cast(float, __builtin_amdgcn_update_dpp(0, __builtin_bit_cast(int, (x)), (ctrl), 0xF, 0xF, false))
__device__ __forceinline__ float add_xor1(float x) { return x + DPPF(x, 0xB1); }
__device__ __forceinline__ float add_xor2(float x) { return x + DPPF(x, 0x4E); }
__device__ __forceinline__ void swap32(float& a, float& b) { asm volatile("s_nop 1\n\tv_permlane32_swap_b32 %0, %1" : "+v"(a), "+v"(b)); }
__device__ __forceinline__ void swap16(float& a, float& b) { asm volatile("s_nop 1\n\tv_permlane16_swap_b32 %0, %1" : "+v"(a), "+v"(b)); }
__device__ __forceinline__ float sum_halves(float x) { float a = x, b = x; swap32(a, b); return a + b; }
__device__ __forceinline__ float other_half(float x, int h) { float a = x, b = x; swap32(a, b); return h ? a : b; }
__device__ __forceinline__ float sum_rows(float x) { float a = x, b = x; swap16(a, b); return sum_halves(a + b); }
__device__ __forceinline__ float max_rows(float x) { float a = x, b = x; swap16(a, b); x = fmaxf(a, b); a = x; b = x; swap32(a, b); return fmaxf(a, b); }
__device__ __forceinline__ float wave_sum(float v) {
    v = add_xor1(v); v = add_xor2(v); v += DPPF(v, 0x141); v += DPPF(v, 0x140);
    return sum_rows(v);
}
__device__ __forceinline__ float silu_f(float v) { return v / (1.f + __expf(-v)); }
#define LDS_FENCE() asm volatile("s_waitcnt lgkmcnt(0)" ::: "memory")
__device__ __forceinline__ int opq_tid() { int t = threadIdx.x; asm volatile("" : "+v"(t)); return t; }

template <class AR, class BR, class EPI>
__device__ __forceinline__ void wave_gemm_64x64(AR arow, BR brow, int K, EPI epi) {
    const int lane = threadIdx.x & 63, fr = lane & 15, fq = lane >> 4;
#if !NAIVE_GEMM
    const bf16* ap[4]; const bf16* bp[4];
#pragma unroll
    for (int i = 0; i < 4; ++i) { ap[i] = arow(16 * i + fr) + fq * 8; bp[i] = brow(16 * i + fr) + fq * 8; }
    f32x4 acc[4][4];
#pragma unroll
    for (int i = 0; i < 4; ++i)
#pragma unroll
        for (int j = 0; j < 4; ++j) acc[i][j] = (f32x4){0.f, 0.f, 0.f, 0.f};
#pragma unroll 1
    for (int k = 0; k < K; k += 64) {
        bf16x8 a[4][2], b[4][2];
#pragma unroll
        for (int i = 0; i < 4; ++i) {
            a[i][0] = *(const bf16x8*)(ap[i] + k); a[i][1] = *(const bf16x8*)(ap[i] + k + 32);
            b[i][0] = *(const bf16x8*)(bp[i] + k); b[i][1] = *(const bf16x8*)(bp[i] + k + 32);
        }
#pragma unroll
        for (int kk = 0; kk < 2; ++kk)
#pragma unroll
            for (int i = 0; i < 4; ++i)
#pragma unroll
                for (int j = 0; j < 4; ++j) acc[i][j] = __builtin_amdgcn_mfma_f32_16x16x32_bf16(b[j][kk], a[i][kk], acc[i][j], 0, 0, 0);
    }
#pragma unroll
    for (int i = 0; i < 4; ++i)
#pragma unroll
        for (int j = 0; j < 4; ++j) { epi(16 * i + fr, 16 * j + 4 * fq, acc[i][j]); asm volatile("" ::: "memory"); }
#else
    for (int i = 0; i < 4; ++i) {
        const bf16* ar = arow(16 * i + fr);
        for (int j = 0; j < 4; ++j) {
            f32x4 acc = (f32x4){0.f, 0.f, 0.f, 0.f};
#pragma unroll
            for (int r = 0; r < 4; ++r) {
                const bf16* br = brow(16 * j + 4 * fq + r);
                float s = 0.f;
                for (int k = 0; k < K; k += 8) {
                    u32x4 av = *(const u32x4*)(ar + k), bv = *(const u32x4*)(br + k);
#pragma unroll
                    for (int q = 0; q < 4; ++q) { s += bflo(av[q]) * bflo(bv[q]); s += bfhi(av[q]) * bfhi(bv[q]); }
                }
                acc[r] = s;
            }
            epi(16 * i + fr, 16 * j + 4 * fq, acc);
        }
    }
#endif
}

__device__ __forceinline__ void transpose_item(const float* W, int K, int N, bf16* WT, int rmul, int radd, float* scr, int item, int lane) {
    const int nblk = (N + 31) / 32, kb = item / nblk, nb = item % nblk, k0 = 64 * kb, n0 = 32 * nb;
    {
        const int n4 = (lane & 7) * 4; f32x4 v[8];
#pragma unroll
        for (int i = 0; i < 8; ++i) { const int kk = 8 * i + (lane >> 3); v[i] = (n0 + n4 < N) ? *(const f32x4*)(W + (size_t)(k0 + kk) * N + n0 + n4) : (f32x4){0.f, 0.f, 0.f, 0.f}; }
#pragma unroll
        for (int i = 0; i < 8; ++i) { const int kk = 8 * i + (lane >> 3); float* d = scr + kk * 33 + n4; d[0] = v[i].x; d[1] = v[i].y; d[2] = v[i].z; d[3] = v[i].w; }
    }
    LDS_FENCE();
    const int c = lane & 7;
#pragma unroll
    for (int j = 0; j < 4; ++j) { const int n = (lane >> 3) + 8 * j; const float* s = scr + (8 * c) * 33 + n;
        u32x4 o; o.x = pk2(s[0 * 33], s[1 * 33]); o.y = pk2(s[2 * 33], s[3 * 33]); o.z = pk2(s[4 * 33], s[5 * 33]); o.w = pk2(s[6 * 33], s[7 * 33]);
        if (n0 + n < N) *(u32x4*)(WT + (size_t)(radd + rmul * (n0 + n)) * K + k0 + 8 * c) = o; }
    LDS_FENCE();
}

namespace pg8 {
#define PG8_LAS __attribute__((address_space(3)))
constexpr int BM = 256, BK = 64, HALF = 128, HTB = HALF * BK * 2, STAGE_BYTES = 8 * HTB, NXCD = 8, WGM = 8;
__host__ __device__ __forceinline__ int lds_byte(int r, int c) { const int st = (r >> 4) * 2 + (c >> 5), rr = r & 15, cc = c & 31, ob = rr * 64 + cc * 2; return st * 1024 + (ob ^ (((ob >> 9) & 1) << 5)); }
__host__ __device__ __forceinline__ void stage_rc(int b, int& R, int& C) { const int st = b / 1024, sb = b % 1024, swz = sb ^ (((sb >> 9) & 1) << 5); R = (st >> 1) * 16 + swz / 64; C = (st & 1) * 32 + (swz % 64) / 2; }
__host__ __device__ __forceinline__ int perm32(int rho) { const int n = rho >> 4, i = rho & 15; return 8 * (i >> 2) + 4 * n + (i & 3); }

struct Unit { const char* A; const char* B; const int* list; int r0, nrows; int pm, pn, aux; };

struct StaticOrder {
    const char* A; const char* B; int lda, K; int nM, nN, nwg, G, c;
    __device__ __forceinline__ void init(const void* A_, const void* B_, int lda_, int K_, int M, int N, int G_, int c_) { A = (const char*)A_; B = (const char*)B_; lda = lda_; K = K_; nM = M / BM; nN = N / BM; nwg = nM * nN; G = G_; c = c_; }
    __device__ __forceinline__ bool next(int i, Unit& u) const {
        const long L = (long)i * G + c; if (L >= nwg) return false;
        int wgid = (int)L; { const int q = nwg / NXCD, r = nwg % NXCD, xcd = wgid % NXCD, off = wgid / NXCD; wgid = (xcd < r ? xcd * (q + 1) : r * (q + 1) + (xcd - r) * q) + off; }
        const int nig = WGM * nN, gid = wgid / nig, fm = gid * WGM, gsz = (nM - fm) < WGM ? (nM - fm) : WGM;
        u.pm = fm + ((wgid % nig) % gsz); u.pn = (wgid % nig) / gsz;
        u.A = A + (size_t)u.pm * BM * lda * 2; u.B = B + (size_t)u.pn * BM * K * 2; u.list = nullptr; u.r0 = 0; u.nrows = BM; u.aux = 0; return true;
    }
};

__device__ __forceinline__ unsigned cvt_pk_bf16(float lo, float hi) { unsigned r; asm volatile("v_cvt_pk_bf16_f32 %0, %1, %2" : "=v"(r) : "v"(lo), "v"(hi)); return r; }

template <class Epi, class Sched, bool GATHER, bool ALIGN_EPI = true>
__device__ __forceinline__ void gemm_phase(PG8_LAS unsigned char* lds, const int K, const int lda, const Sched& S, const Epi& E) {
    const int tid = opq_tid(), wid = __builtin_amdgcn_readfirstlane(tid >> 6), lane = tid & 63, wr = wid >> 2, wc = wid & 3, fr = lane & 15, fq = lane >> 4;
    const int nt = K / BK;
    int RA[2], CA[2]; unsigned voffA[2], voffB[2];
#pragma unroll
    for (int i = 0; i < 2; ++i) { int R, C; stage_rc(tid * 16 + i * 8192, R, C); const int Rb = Epi::PERM ? ((R & ~31) + perm32(R & 31)) : R;
        RA[i] = R; CA[i] = C; voffA[i] = (unsigned)(R * lda + C) * 2u; voffB[i] = (unsigned)(Rb * K + C) * 2u; }
    const size_t kstep = (size_t)(BK * 2);
    const size_t hstepA = (size_t)HALF * lda * 2, hstepB = (size_t)HALF * K * 2;
    const unsigned ldsw = (unsigned)wid * 1024u;
    const int aoff = lds_byte(wr * 64 + fr, fq * 8), boff = lds_byte(wc * 32 + fr, fq * 8);
    unsigned offC[2][2], offN[2][2];
#define PG8_SA(b, h) (((b) * 2 + (h)) * HTB)
#define PG8_SB(b, h) ((4 + (b) * 2 + (h)) * HTB)
#define PG8_GL(ptr, bufoff, i_) __builtin_amdgcn_global_load_lds((const unsigned*)(ptr), (PG8_LAS unsigned*)(lds + (bufoff) + ldsw + (i_) * 8192), 16, 0, 0)
#define PG8_STAGE_B(bufoff, gbase) do { _Pragma("unroll") for (int _i = 0; _i < 2; ++_i) PG8_GL((const char*)(gbase) + voffB[_i], bufoff, _i); } while (0)
#define PG8_STAGE_A(bufoff, h, kb, NX) do { const char* _b = (NX) ? nA : cA; _Pragma("unroll") for (int _i = 0; _i < 2; ++_i) { \
        if constexpr (GATHER) { if (NX) PG8_GL(_b + (kb) + offN[h][_i], bufoff, _i); else PG8_GL(_b + (kb) + offC[h][_i], bufoff, _i); } \
        else PG8_GL(_b + (kb) + (h) * hstepA + voffA[_i], bufoff, _i); } } while (0)
#define PG8_LDA(dst, b, h) do { _Pragma("unroll") for (int m = 0; m < 4; ++m) _Pragma("unroll") for (int k = 0; k < 2; ++k) dst[m][k] = *(const PG8_LAS bf16x8*)(lds + PG8_SA(b, h) + aoff + m * 2048 + k * 1024); } while (0)
#define PG8_LDB(dst, b, h) do { _Pragma("unroll") for (int n = 0; n < 2; ++n) _Pragma("unroll") for (int k = 0; k < 2; ++k) dst[n][k] = *(const PG8_LAS bf16x8*)(lds + PG8_SB(b, h) + boff + n * 2048 + k * 1024); } while (0)
#define PG8_MMA(ai, bj, At, Bt) do { __builtin_amdgcn_s_setprio(1); _Pragma("unroll") for (int m = 0; m < 4; ++m) _Pragma("unroll") for (int n = 0; n < 2; ++n) _Pragma("unroll") for (int k = 0; k < 2; ++k) \
        acc[ai][bj][m][n] = __builtin_amdgcn_mfma_f32_16x16x32_bf16(Bt[n][k], At[m][k], acc[ai][bj][m][n], 0, 0, 0); __builtin_amdgcn_s_setprio(0); } while (0)
#define PG8_WAIT_V(n) asm volatile("s_waitcnt vmcnt(" #n ")" ::: "memory")
#define PG8_WAIT_L(n) asm volatile("s_waitcnt lgkmcnt(" #n ")" ::: "memory")
#define PG8_BAR __builtin_amdgcn_s_barrier()
#define PG8_SCHED __builtin_amdgcn_sched_barrier(0)
#define PG8_GOFF(dst, u) do { if constexpr (GATHER) { _Pragma("unroll") for (int _h = 0; _h < 2; ++_h) _Pragma("unroll") for (int _i = 0; _i < 2; ++_i) { \
        int _r = (u).r0 + _h * HALF + RA[_i]; _r = _r < (u).nrows ? _r : (u).nrows - 1; dst[_h][_i] = (unsigned)(((u).list[_r] & 0x7fffffff) * lda + CA[_i]) * 2u; } } } while (0)
    Unit cur, nxt; int ui = 0;
    if (!S.next(0, cur)) return;
    f32x4 acc[2][2][4][2];
#pragma unroll
    for (int a = 0; a < 2; ++a)
#pragma unroll
        for (int b = 0; b < 2; ++b)
#pragma unroll
            for (int m = 0; m < 4; ++m)
#pragma unroll
                for (int n = 0; n < 2; ++n) acc[a][b][m][n] = (f32x4){0.f, 0.f, 0.f, 0.f};
    bf16x8 At[4][2], B0[2][2], B1[2][2];
    const char* cA = cur.A; const char* cB = cur.B; const char* nA = cA; const char* nB = cB;
    PG8_GOFF(offC, cur); PG8_GOFF(offN, cur);
    PG8_STAGE_B(PG8_SB(0, 0), cB); PG8_STAGE_B(PG8_SB(0, 1), cB + hstepB); PG8_STAGE_A(PG8_SA(0, 0), 0, 0, false); PG8_STAGE_A(PG8_SA(0, 1), 1, 0, false);
    if (wr == 1) PG8_BAR;
    PG8_WAIT_V(2); PG8_BAR;
    PG8_STAGE_B(PG8_SB(1, 0), cB + kstep); PG8_STAGE_A(PG8_SA(1, 0), 0, kstep, false); PG8_STAGE_B(PG8_SB(1, 1), cB + hstepB + kstep);
    PG8_WAIT_V(6); PG8_BAR;
    for (;;) {
        const bool has_next = S.next(ui + 1, nxt);
        nA = has_next ? nxt.A : cA; nB = has_next ? nxt.B : cB;
        if (has_next) PG8_GOFF(offN, nxt); else { if constexpr (GATHER) { _Pragma("unroll") for (int _h = 0; _h < 2; ++_h) _Pragma("unroll") for (int _i = 0; _i < 2; ++_i) offN[_h][_i] = offC[_h][_i]; } }
        for (int t = 0; t < nt; t += 2) {
            const bool last = (t == nt - 2);
            const size_t k1 = (size_t)(t + 1) * kstep;
            const size_t k2 = last ? 0 : (size_t)(t + 2) * kstep, k3 = k2 + kstep;
            const char* b2 = last ? nB : cB + (size_t)(t + 2) * kstep; const char* b3 = b2 + kstep;
            PG8_LDB(B0, 0, 0); PG8_LDB(B1, 0, 1); PG8_SCHED; PG8_LDA(At, 0, 0); PG8_STAGE_A(PG8_SA(1, 1), 1, k1, false);
            PG8_WAIT_V(8); PG8_WAIT_L(0); PG8_BAR; PG8_MMA(0, 0, At, B0); PG8_MMA(0, 1, At, B1); PG8_BAR; PG8_SCHED;
            PG8_LDA(At, 0, 1); PG8_STAGE_B(PG8_SB(0, 0), b2); PG8_STAGE_B(PG8_SB(0, 1), b2 + hstepB); PG8_STAGE_A(PG8_SA(0, 0), 0, k2, last);
            PG8_WAIT_V(8); PG8_WAIT_L(0); PG8_BAR; PG8_MMA(1, 0, At, B0); PG8_MMA(1, 1, At, B1); PG8_BAR; PG8_SCHED;
            PG8_LDB(B0, 1, 0); PG8_LDB(B1, 1, 1); PG8_SCHED; PG8_LDA(At, 1, 0); PG8_STAGE_A(PG8_SA(0, 1), 1, k2, last);
            PG8_WAIT_V(8); PG8_WAIT_L(0); PG8_BAR; PG8_MMA(0, 0, At, B0); PG8_MMA(0, 1, At, B1); PG8_BAR; PG8_SCHED;
            PG8_LDA(At, 1, 1); PG8_STAGE_B(PG8_SB(1, 0), b3); PG8_STAGE_B(PG8_SB(1, 1), b3 + hstepB); PG8_STAGE_A(PG8_SA(1, 0), 0, k3, last);
            PG8_WAIT_V(8); PG8_WAIT_L(0); PG8_BAR; PG8_MMA(1, 0, At, B0); PG8_MMA(1, 1, At, B1); PG8_BAR; PG8_SCHED;
        }
        if constexpr (ALIGN_EPI) { if (wr == 0) PG8_BAR; }
        E(acc, cur, wr, wc, fr, fq);
        if (!has_next) break;
#pragma unroll
        for (int a = 0; a < 2; ++a)
#pragma unroll
            for (int b = 0; b < 2; ++b)
#pragma unroll
                for (int m = 0; m < 4; ++m)
#pragma unroll
                    for (int n = 0; n < 2; ++n) acc[a][b][m][n] = (f32x4){0.f, 0.f, 0.f, 0.f};
        cur = nxt; cA = nA; cB = nB; ++ui;
        if constexpr (GATHER) { _Pragma("unroll") for (int _h = 0; _h < 2; ++_h) _Pragma("unroll") for (int _i = 0; _i < 2; ++_i) offC[_h][_i] = offN[_h][_i]; }
        if constexpr (ALIGN_EPI) { if (wr == 1) PG8_BAR; }
    }
    PG8_WAIT_V(0);
    if constexpr (!ALIGN_EPI) { if (wr == 0) PG8_BAR; }
    PG8_BAR;
#undef PG8_SA
#undef PG8_SB
#undef PG8_GL
#undef PG8_STAGE_A
#undef PG8_STAGE_B
#undef PG8_LDA
#undef PG8_LDB
#undef PG8_MMA
#undef PG8_WAIT_V
#undef PG8_WAIT_L
#undef PG8_BAR
#undef PG8_SCHED
#undef PG8_GOFF
}
struct EpiRaw {
    static constexpr bool PERM = true; bf16* O; int ldc;
    __device__ __forceinline__ void operator()(const f32x4 (&acc)[2][2][4][2], const Unit& u, int wr, int wc, int fr, int fq) const {
#pragma unroll
        for (int ai = 0; ai < 2; ++ai)
#pragma unroll
            for (int m = 0; m < 4; ++m) { bf16* rowp = O + (size_t)(u.pm * BM + ai * HALF + wr * 64 + m * 16 + fr) * ldc + u.pn * BM + wc * 32 + 8 * fq;
#pragma unroll
                for (int bj = 0; bj < 2; ++bj) { const f32x4 v0 = acc[ai][bj][m][0], v1 = acc[ai][bj][m][1];
                    u32x4 w; w.x = cvt_pk_bf16(v0[0], v0[1]); w.y = cvt_pk_bf16(v0[2], v0[3]); w.z = cvt_pk_bf16(v1[0], v1[1]); w.w = cvt_pk_bf16(v1[2], v1[3]);
                    *(u32x4*)(rowp + bj * HALF) = w; } }
    }
};
struct EpiOutRes {
    static constexpr bool PERM = true; const float* x; bf16* x1; const float* mod;
    __device__ __forceinline__ void operator()(const f32x4 (&acc)[2][2][4][2], const Unit& u, int wr, int wc, int fr, int fq) const {
        const int b = (u.pm * BM) / SEQ; const int col0 = u.pn * BM + wc * 32 + 8 * fq;
        f32x4 g[2][2];
#pragma unroll
        for (int bj = 0; bj < 2; ++bj)
#pragma unroll
            for (int n = 0; n < 2; ++n) g[bj][n] = *(const f32x4*)(mod + b * 6144 + 2048 + col0 + bj * HALF + n * 4);
#pragma unroll
        for (int ai = 0; ai < 2; ++ai)
#pragma unroll
            for (int m = 0; m < 4; ++m) { const size_t off = (size_t)(u.pm * BM + ai * HALF + wr * 64 + m * 16 + fr) * DM + col0;
#pragma unroll
                for (int bj = 0; bj < 2; ++bj) { const f32x4 x0 = *(const f32x4*)(x + off + bj * HALF), x1v = *(const f32x4*)(x + off + bj * HALF + 4);
                    const f32x4 v0 = x0 + g[bj][0] * acc[ai][bj][m][0], v1 = x1v + g[bj][1] * acc[ai][bj][m][1];
                    *(u32x4*)(x1 + off + bj * HALF) = (u32x4){cvt_pk_bf16(v0[0], v0[1]), cvt_pk_bf16(v0[2], v0[3]), cvt_pk_bf16(v1[0], v1[1]), cvt_pk_bf16(v1[2], v1[3])}; }
                asm volatile("" ::: "memory"); }
    }
};
struct EpiRouter {
    static constexpr bool PERM = false; float* LG;
    __device__ __forceinline__ void operator()(const f32x4 (&acc)[2][2][4][2], const Unit& u, int wr, int wc, int fr, int fq) const {
#pragma unroll
        for (int ai = 0; ai < 2; ++ai)
#pragma unroll
            for (int m = 0; m < 4; ++m)
#pragma unroll
                for (int n = 0; n < 2; ++n) *(f32x4*)(LG + (size_t)(u.pm * BM + ai * HALF + wr * 64 + m * 16 + fr) * 128 + wc * 32 + n * 16 + 4 * fq) = acc[ai][0][m][n];
    }
};
struct EpiCmp {
    static constexpr bool PERM = true; bf16* HID; const float* posb;
    __device__ __forceinline__ void operator()(const f32x4 (&acc)[2][2][4][2], const Unit& u, int wr, int wc, int fr, int fq) const {
        const int kv = u.pm >= 16 ? 1 : 0; const int col0 = wc * 32 + 8 * fq;
#pragma unroll
        for (int bj = 0; bj < 2; ++bj) { const f32x4 pb0 = *(const f32x4*)(posb + kv * 256 + col0 + bj * HALF), pb1 = *(const f32x4*)(posb + kv * 256 + col0 + bj * HALF + 4);
#pragma unroll
            for (int ai = 0; ai < 2; ++ai)
#pragma unroll
                for (int m = 0; m < 4; ++m) { const f32x4 v0 = acc[ai][bj][m][0] + pb0, v1 = acc[ai][bj][m][1] + pb1;
                    *(u32x4*)(HID + (size_t)(u.pm * BM + ai * HALF + wr * 64 + m * 16 + fr) * 256 + col0 + bj * HALF) =
                        (u32x4){cvt_pk_bf16(silu_f(v0[0]), silu_f(v0[1])), cvt_pk_bf16(silu_f(v0[2]), silu_f(v0[3])), cvt_pk_bf16(silu_f(v1[0]), silu_f(v1[1])), cvt_pk_bf16(silu_f(v1[2]), silu_f(v1[3]))}; } }
    }
};
struct EpiMoe1 {
    static constexpr bool PERM = true; bf16* H;
    __device__ __forceinline__ void operator()(const f32x4 (&acc)[2][2][4][2], const Unit& u, int wr, int wc, int fr, int fq) const {
#pragma unroll
        for (int ai = 0; ai < 2; ++ai)
#pragma unroll
            for (int m = 0; m < 4; ++m) { bf16* rowp = H + (size_t)(u.aux + ai * HALF + wr * 64 + m * 16 + fr) * 512 + ((u.pn * BM + wc * 32 + 8 * fq) >> 1);
#pragma unroll
                for (int bj = 0; bj < 2; ++bj) { const f32x4 v0 = acc[ai][bj][m][0], v1 = acc[ai][bj][m][1];
                    u32x2 w; w.x = cvt_pk_bf16(silu_f(v0[0]) * v0[1], silu_f(v0[2]) * v0[3]); w.y = cvt_pk_bf16(silu_f(v1[0]) * v1[1], silu_f(v1[2]) * v1[3]);
                    *(u32x2*)(rowp + bj * (HALF / 2)) = w; } }
    }
};
struct EpiMoe2 {
    static constexpr bool PERM = true; bf16* Y0; bf16* Y1; const float* mod;
    __device__ __forceinline__ void operator()(const f32x4 (&acc)[2][2][4][2], const Unit& u, int wr, int wc, int fr, int fq) const {
        const int col0 = u.pn * BM + wc * 32 + 8 * fq; const float* roww = (const float*)((const char*)u.list + (WS_ROWW - WS_LISTS));
        int tok[2][4]; float wgt[2][4];
#pragma unroll
        for (int ai = 0; ai < 2; ++ai)
#pragma unroll
            for (int m = 0; m < 4; ++m) { const int r = u.r0 + ai * HALF + wr * 64 + m * 16 + fr; const bool ok = r < u.nrows; tok[ai][m] = ok ? u.list[r] : -1; wgt[ai][m] = ok ? roww[r] : 0.f; }
#pragma unroll
        for (int ai = 0; ai < 2; ++ai)
#pragma unroll
            for (int m = 0; m < 4; ++m) { if (tok[ai][m] != -1) { const int tk = tok[ai][m] & 0x7fffffff; bf16* o = (tok[ai][m] < 0 ? Y1 : Y0) + (size_t)tk * DM + col0; const float w = wgt[ai][m];
#pragma unroll
                    for (int bj = 0; bj < 2; ++bj) { const f32x4 v0 = acc[ai][bj][m][0] * w, v1 = acc[ai][bj][m][1] * w;
                        *(u32x4*)(o + bj * HALF) = (u32x4){cvt_pk_bf16(v0[0], v0[1]), cvt_pk_bf16(v0[2], v0[3]), cvt_pk_bf16(v1[0], v1[1]), cvt_pk_bf16(v1[2], v1[3])}; } } }
    }
};
__device__ __forceinline__ int xcd_remap(int L, int total) { const int q = total / NXCD, r = total % NXCD, xcd = L % NXCD, off = L / NXCD; return (xcd < r ? xcd * (q + 1) : r * (q + 1) + (xcd - r) * q) + off; }
__device__ __forceinline__ int find_list(const int* tb, int R, int lo, int hi) { while (hi - lo > 1) { const int mid = (lo + hi) >> 1; if (tb[mid] <= R) lo = mid; else hi = mid; } return lo; }
struct CmpOrder {
    const char* A; const char* B; int c;
    __device__ __forceinline__ bool next(int i, Unit& u) const { if (i > 0 || c >= 32) return false; u.pm = c; u.pn = 0; u.A = A + (size_t)c * BM * 1024 * 2; u.B = B + (size_t)(c >= 16 ? 1 : 0) * 256 * 2048 * 2; u.list = nullptr; u.r0 = 0; u.nrows = BM; u.aux = 0; return true; }
};
struct MoeOrder1 {
    const char* XNb; const char* W13; const int* LISTS; const unsigned* cnt; const int* tb; int G, c;
    __device__ __forceinline__ bool next(int i, Unit& u) const {
        const int total = tb[64] * 4; const long L0 = (long)i * G + c; if (L0 >= total) return false;
        const int L = xcd_remap((int)L0, total); const int R = L >> 2, pn = L & 3, idx = find_list(tb, R, 0, 64), e = idx;
        u.pm = R; u.pn = pn; u.A = XNb; u.B = W13 + ((size_t)e * 1024 + pn * BM) * 1024 * 2; u.list = LISTS + (size_t)idx * T; u.r0 = (R - tb[idx]) * BM; u.nrows = (int)cnt[idx * 16]; u.aux = R * BM; return true;
    }
};
struct MoeOrder2 {
    const char* Hb; const char* W2T; const int* LISTS; const unsigned* cnt; const int* tb; int G, c;
    __device__ __forceinline__ bool next(int i, Unit& u) const {
        const int total = tb[64] * 4; const long L0 = (long)i * G + c; if (L0 >= total) return false;
        const int L = xcd_remap((int)L0, total); const int R = L >> 2, pn = L & 3, idx = find_list(tb, R, 0, 64), e = idx;
        u.pm = R; u.pn = pn; u.A = Hb + (size_t)R * BM * 512 * 2; u.B = W2T + ((size_t)e * 1024 + pn * BM) * 512 * 2; u.list = LISTS + (size_t)idx * T; u.r0 = (R - tb[idx]) * BM; u.nrows = (int)cnt[idx * 16]; u.aux = 0; return true;
    }
};
}


__device__ __forceinline__ void ph_mod(const P& p, int blk, int nblk, float* shb) {
    const float* c = p.in[1]; const float* w_ada = p.in[2]; const float* b_ada = p.in[3];
    float* mod = (float*)(p.ws + WS_MOD);
    const int tid = opq_tid(), wave = tid >> 6, lane = tid & 63, nw = blockDim.x >> 6;
    for (int task = blk; task < 192; task += nblk) {
        const int cg = task % 96, kh = task / 96, col = cg * 64 + lane;
        float a0 = 0.f, a1 = 0.f;
        const int kper = 512 / nw, kb = kh * 512 + wave * kper;
#pragma unroll 8
        for (int k = kb; k < kb + kper; ++k) {
            const float w = w_ada[(size_t)k * 6144 + col];
            a0 += silu_f(c[k]) * w; a1 += silu_f(c[1024 + k]) * w;
        }
        shb[(wave * 2 + 0) * 64 + lane] = a0; shb[(wave * 2 + 1) * 64 + lane] = a1;
        __syncthreads();
        if (wave < 2) { float s = 0.f; for (int w = 0; w < nw; ++w) s += shb[(w * 2 + wave) * 64 + lane]; atomicAdd(&mod[wave * 6144 + col], s + (kh == 0 ? b_ada[col] : 0.f)); }
        __syncthreads();
    }
}
__device__ __forceinline__ void ph_posb(const P& p, int task, float* shb) {
    const int tid = opq_tid(), wave = tid >> 6, lane = tid & 63;
    float* posb = (float*)(p.ws + WS_POSB);
    const int kv = task >> 5, cg = (task >> 3) & 3, kc = task & 7, col = cg * 64 + lane;
    const float* pos = kv == 0 ? p.in[8] : p.in[9]; const float* w1 = kv == 0 ? p.in[10] : p.in[12];
    float a = 0.f; const int kb = kc * 256 + wave * 32;
#pragma unroll 8
    for (int k = kb; k < kb + 32; ++k) a += pos[k] * w1[(size_t)k * 256 + col];
    shb[wave * 64 + lane] = a;
    __syncthreads();
    if (wave == 0) { float s2 = 0.f; for (int w = 0; w < 8; ++w) s2 += shb[w * 64 + lane]; atomicAdd(&posb[kv * 256 + col], s2); }
    __syncthreads();
}

__device__ __forceinline__ void ph_wprep_a(const P& p, int gw, int ngw, float* scr) {
    const int lane = opq_tid() & 63;
    bf16* WIN_T = (bf16*)(p.ws + WS_WIN_T); bf16* WOUT_T = (bf16*)(p.ws + WS_WOUT_T); bf16* CW1_T = (bf16*)(p.ws + WS_CW1_T); bf16* WR_T = (bf16*)(p.ws + WS_WR_T);
    constexpr int I_IN = (1024 / 64) * 89, I_OUT = 16 * 32, I_C = (2048 / 64) * 8;
    for (int it = gw; it < I_IN + I_OUT + 2 * I_C; it += ngw) {
        int r = it;
        if (r < I_IN) { transpose_item(p.in[5], 1024, NIN, WIN_T, 1, 0, scr, r, lane); continue; } r -= I_IN;
        if (r < I_OUT) { transpose_item(p.in[16], 1024, 1024, WOUT_T, 1, 0, scr, r, lane); continue; } r -= I_OUT;
        if (r < I_C) { transpose_item(p.in[10], 2048, 256, CW1_T, 1, 0, scr, r, lane); continue; } r -= I_C;
        transpose_item(p.in[12], 2048, 256, CW1_T + 256 * 2048, 1, 0, scr, r, lane);
    }
    for (int i = gw * 64 + lane; i < 232 * 1024 / 8; i += ngw * 64) *(u32x4*)(WIN_T + (size_t)2840 * 1024 + (size_t)i * 8) = (u32x4){0u, 0u, 0u, 0u};
    for (int i = gw * 64 + lane; i < 184 * 1024 / 8; i += ngw * 64) *(u32x4*)(WR_T + (size_t)72 * 1024 + (size_t)i * 8) = (u32x4){0u, 0u, 0u, 0u};
    for (int it = gw; it < 48; it += ngw) { if (it < 16) transpose_item(p.in[19], 1024, 8, WR_T, 1, 0, scr, it, lane); else transpose_item(p.in[21], 1024, 64, WR_T, 1, 8, scr, it - 16, lane); }
    { bf16* CW2T = (bf16*)(p.ws + WS_CW2_T);
      for (int i = gw * 64 + lane; i < 2 * 64 * 256; i += ngw * 64) { const int kv = i >> 14, d = (i >> 8) & 63, j = i & 255; const float* w2_ = kv == 0 ? p.in[11] : p.in[13]; CW2T[i] = (bf16)f2bf(w2_[j * 64 + d]); } }
}
__device__ __forceinline__ void ph_wprep_moe(const P& p, int gw, int ngw, float* scr) {
    const int lane = opq_tid() & 63;
    bf16* W13 = (bf16*)(p.ws + WS_W13_T); bf16* W2T = (bf16*)(p.ws + WS_W2_T);
    constexpr int I_13 = (1024 / 64) * (512 / 32), I_2 = (512 / 64) * (1024 / 32);
    for (int it = gw; it < NEXP * (2 * I_13 + I_2); it += ngw) {
        const int e = it / (2 * I_13 + I_2); int r = it % (2 * I_13 + I_2);
        if (r < I_13) { transpose_item(p.in[23] + (size_t)e * 1024 * 512, 1024, 512, W13 + (size_t)e * 1024 * 1024, 2, 0, scr, r, lane); continue; } r -= I_13;
        if (r < I_13) { transpose_item(p.in[24] + (size_t)e * 1024 * 512, 1024, 512, W13 + (size_t)e * 1024 * 1024, 2, 1, scr, r, lane); continue; } r -= I_13;
        transpose_item(p.in[25] + (size_t)e * 512 * 1024, 512, 1024, W2T + (size_t)e * 1024 * 512, 1, 0, scr, r, lane);
    }
}

template <bool SRC_BF16>
__device__ __forceinline__ void ph_rownorm(const P& p, int gw, int ngw, const void* src_, int which) {
    const int lane = opq_tid() & 63;
    const float* nw = which == 0 ? p.in[4] : p.in[18];
    const float* mod = (const float*)(p.ws + WS_MOD);
    bf16* XN = (bf16*)(p.ws + WS_XN);
    for (int b = 0; b < BATCH; ++b) {
        const float* sh = mod + b * 6144 + (which == 0 ? 0 : 3072); const float* sc = sh + 1024;
        f32x4 A[4], Bv[4];
#pragma unroll
        for (int j = 0; j < 4; ++j) { const int co = SRC_BF16 ? 16 * lane + 4 * j : 4 * lane + 256 * j; A[j] = *(const f32x4*)(nw + co) * (*(const f32x4*)(sc + co) + 1.f); Bv[j] = *(const f32x4*)(sh + co); }
        constexpr int RU = 4;
        for (int r0 = gw; r0 < SEQ; r0 += RU * ngw) {
            f32x4 v[RU][4];
#pragma unroll
            for (int u = 0; u < RU; ++u) { const int row = b * SEQ + r0 + u * ngw;
                if (SRC_BF16) { const bf16* xr = (const bf16*)src_ + (size_t)row * DM + 16 * lane; const u32x4 a = *(const u32x4*)xr, b2 = *(const u32x4*)(xr + 8);
                    v[u][0] = (f32x4){bflo(a.x), bfhi(a.x), bflo(a.y), bfhi(a.y)}; v[u][1] = (f32x4){bflo(a.z), bfhi(a.z), bflo(a.w), bfhi(a.w)};
                    v[u][2] = (f32x4){bflo(b2.x), bfhi(b2.x), bflo(b2.y), bfhi(b2.y)}; v[u][3] = (f32x4){bflo(b2.z), bfhi(b2.z), bflo(b2.w), bfhi(b2.w)}; }
                else { const f32x4* xr = (const f32x4*)((const float*)src_ + (size_t)row * DM) + lane;
#pragma unroll
                    for (int j = 0; j < 4; ++j) v[u][j] = xr[64 * j]; } }
#pragma unroll
            for (int u = 0; u < RU; ++u) {
                const int row = b * SEQ + r0 + u * ngw; float ss = 0.f;
#pragma unroll
                for (int j = 0; j < 4; ++j) ss += v[u][j].x * v[u][j].x + v[u][j].y * v[u][j].y + v[u][j].z * v[u][j].z + v[u][j].w * v[u][j].w;
                const float rstd = rsqrtf(wave_sum(ss) * (1.f / DM) + EPS);
                f32x4 h[4];
#pragma unroll
                for (int j = 0; j < 4; ++j) h[j] = v[u][j] * rstd * A[j] + Bv[j];
                if (SRC_BF16) { bf16* o = XN + (size_t)row * DM + 16 * lane;
                    *(u32x4*)o = (u32x4){pk2(h[0].x, h[0].y), pk2(h[0].z, h[0].w), pk2(h[1].x, h[1].y), pk2(h[1].z, h[1].w)}; *(u32x4*)(o + 8) = (u32x4){pk2(h[2].x, h[2].y), pk2(h[2].z, h[2].w), pk2(h[3].x, h[3].y), pk2(h[3].z, h[3].w)}; }
                else { unsigned long long* o8 = (unsigned long long*)(XN + (size_t)row * DM) + lane;
#pragma unroll
                    for (int j = 0; j < 4; ++j) o8[64 * j] = (unsigned long long)pk2(h[j].x, h[j].y) | ((unsigned long long)pk2(h[j].z, h[j].w) << 32); }
            }
        }
    }
}

__device__ __forceinline__ u32x2 pack8_fp8(float a0, float a1, float a2, float a3, float a4, float a5, float a6, float a7) {
    int w0 = __builtin_amdgcn_cvt_pk_fp8_f32(a0, a1, 0, false); w0 = __builtin_amdgcn_cvt_pk_fp8_f32(a2, a3, w0, true);
    int w1 = __builtin_amdgcn_cvt_pk_fp8_f32(a4, a5, 0, false); w1 = __builtin_amdgcn_cvt_pk_fp8_f32(a6, a7, w1, true);
    return (u32x2){(unsigned)w0, (unsigned)w1};
}
constexpr float QSCALE = 0.125f * 1.4426950408889634f;
__device__ __forceinline__ int vt32_slot(int kk) { const int s = kk >> 4, rem = kk & 15, h = (rem >> 2) & 1, j = ((rem >> 3) << 2) | (rem & 3); return 16 * s + 8 * h + j; }
__device__ __forceinline__ int vt16_slot(int kk) { const int ks = kk >> 5, rem = kk & 31, hi = rem >> 4, r2 = rem & 15, qr = r2 >> 2, j = (r2 & 3) + 4 * hi; return 32 * ks + 8 * qr + j; }
__device__ __forceinline__ void unpack16(const u32x4 a, const u32x4 b, float (&v)[16]) {
    v[0] = bflo(a.x); v[1] = bfhi(a.x); v[2] = bflo(a.y); v[3] = bfhi(a.y); v[4] = bflo(a.z); v[5] = bfhi(a.z); v[6] = bflo(a.w); v[7] = bfhi(a.w);
    v[8] = bflo(b.x); v[9] = bfhi(b.x); v[10] = bflo(b.y); v[11] = bfhi(b.y); v[12] = bflo(b.z); v[13] = bfhi(b.z); v[14] = bflo(b.w); v[15] = bfhi(b.w);
}
__device__ __forceinline__ void ph_post(const P& p, unsigned char* ldsb) {
    const int tid = opq_tid(), l4 = tid & 3;
    const bf16* RAW = (const bf16*)(p.ws + WS_R1);
    bf16* Q = (bf16*)(p.ws + WS_Q); bf16* KV = (bf16*)(p.ws + WS_KV); float* GATES = (float*)(p.ws + WS_GATES); bf16* MIX = (bf16*)(p.ws + WS_MIX);
    const float* conv_w = p.in[14]; const float* onw = p.in[15];
    bf16* TL = (bf16*)ldsb;
    constexpr int TLD = 34;
    for (int tile = blockIdx.x; tile < T / 32; tile += gridDim.x) {
        const int tk0 = tile * 32, b = tk0 / SEQ, s0 = tk0 % SEQ;
#pragma unroll
        for (int it = 0; it < 4; ++it) {
            const int unit = (tid >> 2) + 128 * it, tok = unit >> 4, grp = unit & 15;
            const int i = grp < 8 ? -1 : (grp < 10 ? 0 : grp < 12 ? 1 : grp < 14 ? 2 : 4), g = grp & 1;
            const int col = grp < 8 ? grp * 64 : 512 + i * 128 + g * 64;
            const bf16* src = RAW + (size_t)(tk0 + tok) * NINP + col + l4 * 16;
            float v[16]; unpack16(*(const u32x4*)src, *(const u32x4*)(src + 8), v);
            float ss = 0.f;
#pragma unroll
            for (int e = 0; e < 16; ++e) ss += v[e] * v[e];
            ss = add_xor2(add_xor1(ss));
            const bool normed = grp < 8 || grp >= 12;
            const float rs = normed ? rsqrtf(ss * (1.f / 64.f) + EPS) * (grp < 8 ? QSCALE : 1.f) : 1.f;
            const float* wv = grp < 8 ? p.in[6] : (p.in[7] + (grp < 14 ? 64 : 128));
            if (normed) {
#pragma unroll
                for (int e = 0; e < 16; ++e) v[e] = v[e] * rs * wv[l4 * 16 + e];
            }
            bf16* dst = grp < 8 ? Q + ((size_t)(tk0 + tok) * 8 + grp) * 64 + l4 * 16 : KV + ((((size_t)i * 2 + b) * 2 + g) * SEQ + s0 + tok) * 64 + l4 * 16;
            bf16* dst2 = dst + 8;
            if (i == 2) {
                const int sq = s0 + tok, kk = sq & 63; bf16* bb = KV + (((size_t)2 * 2 + b) * 2 + g) * SEQ * 64 + (size_t)(sq >> 6) * 4096 + (((kk >> 4) * 2 + (l4 >> 1)) * 16 + (kk & 15)) * 32;
                dst = bb + ((l4 & 1) * 2) * 8; dst2 = dst + 8; }
            *(u32x4*)dst = (u32x4){pk2(v[0], v[1]), pk2(v[2], v[3]), pk2(v[4], v[5]), pk2(v[6], v[7])};
            *(u32x4*)dst2 = (u32x4){pk2(v[8], v[9]), pk2(v[10], v[11]), pk2(v[12], v[13]), pk2(v[14], v[15])};
            if (i == 2) {
                const int sq = s0 + tok, kk = sq & 63;
                unsigned char* k8 = (unsigned char*)(KV + (((size_t)6 * 2 + b) * 2 + g) * SEQ * 64) + 1048576 + (size_t)(sq >> 6) * 4096 + (((kk >> 4) * 16 + (kk & 15)) * 4 + (l4 & 1) * 2) * 16 + (l4 >> 1) * 8;
                *(u32x2*)k8 = pack8_fp8(v[0], v[1], v[2], v[3], v[4], v[5], v[6], v[7]); *(u32x2*)(k8 + 16) = pack8_fp8(v[8], v[9], v[10], v[11], v[12], v[13], v[14], v[15]); }
        }
        {
            const int tl = tid >> 7, tok = (tid >> 2) & 31, i = tl < 2 ? 3 : 5, g = tl & 1;
            const bf16* src = RAW + (size_t)(tk0 + tok) * NINP + 512 + i * 128 + g * 64 + l4 * 16;
            const u32x4 a = *(const u32x4*)src, c2 = *(const u32x4*)(src + 8);
            unsigned short e16[16];
            e16[0] = a.x & 0xffff; e16[1] = a.x >> 16; e16[2] = a.y & 0xffff; e16[3] = a.y >> 16; e16[4] = a.z & 0xffff; e16[5] = a.z >> 16; e16[6] = a.w & 0xffff; e16[7] = a.w >> 16;
            e16[8] = c2.x & 0xffff; e16[9] = c2.x >> 16; e16[10] = c2.y & 0xffff; e16[11] = c2.y >> 16; e16[12] = c2.z & 0xffff; e16[13] = c2.z >> 16; e16[14] = c2.w & 0xffff; e16[15] = c2.w >> 16;
            const int sl32 = vt32_slot(tok), sl16 = vt16_slot(tok) & 31;
#pragma unroll
            for (int e = 0; e < 16; ++e) { TL[(tl * 64 + l4 * 16 + e) * TLD + sl32] = e16[e]; if (tl < 2) TL[((4 + tl) * 64 + l4 * 16 + e) * TLD + sl16] = e16[e]; }
        }
        __syncthreads();
#pragma unroll
        for (int k = 0; k < 3; ++k) {
            const int ch = tid + 512 * k, tl = ch >> 8, d = (ch >> 2) & 63, part = ch & 3;
            const bf16* sp = TL + (tl * 64 + d) * TLD + part * 8;
            const u32x4 o = (u32x4){*(const unsigned*)(sp), *(const unsigned*)(sp + 2), *(const unsigned*)(sp + 4), *(const unsigned*)(sp + 6)};
            bf16* dst;
            if (tl < 4) { const int i = tl < 2 ? 3 : 5, g = tl & 1; dst = KV + (((size_t)i * 2 + b) * 2 + g) * SEQ * 64 + (size_t)(s0 >> 5) * 2048 + d * 32 + part * 8; }
            else { const int g = tl & 1;
                unsigned char* v8 = (unsigned char*)(KV + (((size_t)6 * 2 + b) * 2 + g) * SEQ * 64) + (size_t)(s0 >> 6) * 4096 + (((d >> 4) * 16 + (d & 15)) * 4 + part) * 16 + ((s0 >> 5) & 1) * 8;
                *(u32x2*)v8 = pack8_fp8(bflo(o.x), bfhi(o.x), bflo(o.y), bfhi(o.y), bflo(o.z), bfhi(o.z), bflo(o.w), bfhi(o.w)); continue; }
            *(u32x4*)dst = o;
        }
        for (int k = tid; k < 32 * 24; k += 512) { const int tok = k / 24, jj = k % 24; GATES[(size_t)(tk0 + tok) * 24 + jj] = 1.f / (1.f + __expf(-bf2f(RAW[(size_t)(tk0 + tok) * NINP + 1280 + jj]))); }
#pragma unroll
        for (int it = 0; it < 2; ++it) {
            const int unit = (tid >> 2) + 128 * it, tok = unit >> 3, grp = unit & 7, ch0 = grp * 64 + l4 * 16;
            float acc[16];
#pragma unroll
            for (int e = 0; e < 16; ++e) acc[e] = 0.f;
#pragma unroll
            for (int d = 0; d < 3; ++d) {
                if (s0 + tok - 2 + d >= 0) {
                    const bf16* rr = RAW + (size_t)(tk0 + tok - 2 + d) * NINP;
                    float cg[16], uu[16]; unpack16(*(const u32x4*)(rr + 1816 + ch0), *(const u32x4*)(rr + 1816 + ch0 + 8), cg); unpack16(*(const u32x4*)(rr + 2328 + ch0), *(const u32x4*)(rr + 2328 + ch0 + 8), uu);
#pragma unroll
                    for (int e = 0; e < 16; ++e) acc[e] += conv_w[d * 512 + ch0 + e] * cg[e] * uu[e];
                }
            }
            const bf16* r0 = RAW + (size_t)(tk0 + tok) * NINP + 1304 + ch0;
            float bg[16]; unpack16(*(const u32x4*)r0, *(const u32x4*)(r0 + 8), bg);
            float ss = 0.f;
#pragma unroll
            for (int e = 0; e < 16; ++e) { acc[e] *= bg[e]; ss += acc[e] * acc[e]; }
            ss = add_xor2(add_xor1(ss));
            const float rs = rsqrtf(ss * (1.f / 64.f) + EPS);
#pragma unroll
            for (int e = 0; e < 16; ++e) acc[e] = acc[e] * rs * onw[512 + ch0 + e];
            bf16* dst = MIX + (size_t)(tk0 + tok) * DM + 512 + ch0;
            *(u32x4*)dst = (u32x4){pk2(acc[0], acc[1]), pk2(acc[2], acc[3]), pk2(acc[4], acc[5]), pk2(acc[6], acc[7])};
            *(u32x4*)(dst + 8) = (u32x4){pk2(acc[8], acc[9]), pk2(acc[10], acc[11]), pk2(acc[12], acc[13]), pk2(acc[14], acc[15])};
        }
        __syncthreads();
    }
}

__device__ __forceinline__ void ph_cmp_fin2(const P& p, int pm) {
    const int tid = opq_tid(), lane = tid & 63, wv = tid >> 6, fr = lane & 15, fq = lane >> 4;
    if (wv >= 4) return;
    const int kv = pm >= 16 ? 1 : 0;
    const bf16* A = (const bf16*)(p.ws + WS_HID) + (size_t)(pm * 256 + 64 * wv + fr) * 256 + fq * 8;
    const bf16* B = (const bf16*)(p.ws + WS_CW2_T) + (size_t)(kv * 64 + fr) * 256 + fq * 8;
    bf16* KCVC = (bf16*)(p.ws + WS_KCVC);
    f32x4 acc[4][4];
#pragma unroll
    for (int i = 0; i < 4; ++i)
#pragma unroll
        for (int j = 0; j < 4; ++j) acc[i][j] = (f32x4){0.f, 0.f, 0.f, 0.f};
#pragma unroll 2
    for (int ks = 0; ks < 8; ++ks) {
        bf16x8 a[4], b[4];
#pragma unroll
        for (int i = 0; i < 4; ++i) { a[i] = *(const bf16x8*)(A + (size_t)(16 * i) * 256 + 32 * ks); b[i] = *(const bf16x8*)(B + (size_t)(16 * i) * 256 + 32 * ks); }
#pragma unroll
        for (int i = 0; i < 4; ++i)
#pragma unroll
            for (int j = 0; j < 4; ++j) acc[i][j] = __builtin_amdgcn_mfma_f32_16x16x32_bf16(b[j], a[i], acc[i][j], 0, 0, 0);
    }
#pragma unroll
    for (int i = 0; i < 4; ++i) {
        const int r = pm * 256 + 64 * wv + 16 * i + fr, n = r & 1023; const bool valid = n < NC;
        float ss = 0.f;
#pragma unroll
        for (int j = 0; j < 4; ++j) ss += acc[i][j].x * acc[i][j].x + acc[i][j].y * acc[i][j].y + acc[i][j].z * acc[i][j].z + acc[i][j].w * acc[i][j].w;
        ss = sum_rows(ss);
        const float rs = kv == 0 ? rsqrtf(ss * (1.f / 64.f) + EPS) : 1.f;
#pragma unroll
        for (int j = 0; j < 4; ++j) { const int col = 16 * j + 4 * fq; f32x4 v = acc[i][j] * rs;
            if (kv == 0) v = v * *(const f32x4*)(p.in[7] + col);
            if (!valid) v = (f32x4){0.f, 0.f, 0.f, 0.f};
            if (kv == 0) *(u32x2*)(KCVC + (size_t)r * 64 + col) = (u32x2){pk2(v.x, v.y), pk2(v.z, v.w)};
            else { bf16* vb = KCVC + (size_t)(r - n) * 64 + (size_t)(n >> 5) * 2048 + vt32_slot(n & 31);
                vb[(col + 0) * 32] = (bf16)f2bf(v.x); vb[(col + 1) * 32] = (bf16)f2bf(v.y); vb[(col + 2) * 32] = (bf16)f2bf(v.z); vb[(col + 3) * 32] = (bf16)f2bf(v.w); } }
    }
}

typedef float f32x16 __attribute__((ext_vector_type(16)));
typedef float f32x2_t __attribute__((ext_vector_type(2))); typedef __bf16 bf16x2_t __attribute__((ext_vector_type(2)));
#define MFMA32(a, b, c) __builtin_amdgcn_mfma_f32_32x32x16_bf16((a), (b), (c), 0, 0, 0)
#define MFMA16(a, b, c) __builtin_amdgcn_mfma_f32_16x16x32_bf16((a), (b), (c), 0, 0, 0)
__device__ __forceinline__ unsigned cvtpk(float lo, float hi) { f32x2_t v = {lo, hi}; bf16x2_t b = __builtin_convertvector(v, bf16x2_t); return __builtin_bit_cast(unsigned, b); }
__device__ __forceinline__ int crow(int i, int h) { return (i & 3) + 8 * (i >> 2) + 4 * h; }
#define PACK8(x, s) __builtin_bit_cast(bf16x8, (u32x4){cvtpk(x[8 * (s)], x[8 * (s) + 1]), cvtpk(x[8 * (s) + 2], x[8 * (s) + 3]), cvtpk(x[8 * (s) + 4], x[8 * (s) + 5]), cvtpk(x[8 * (s) + 6], x[8 * (s) + 7])})
constexpr int AL_Q = 0, AL_ACC = 32768, AL_LACC = 99328, AL_ROWS = 100352, AL_RANK = 104448, AL_PARK01 = 120832, AL_PARK27 = 139264;
constexpr int SLOT_B = 544, CU_SCR_B = 458752;
constexpr int IMP_LD = 260, OACC_LD = 65;
typedef __attribute__((address_space(3))) const float* lds_cfp;

constexpr int BN_LO = 70, BN_N = 269;
__device__ __forceinline__ void build_bias_table(const P& p, float* biasL, int g) {
    float* biasN = biasL + 130 * 4;
    for (int i = threadIdx.x; i < (130 + BN_N) * 4; i += blockDim.x) {
        const bool n = i >= 130 * 4; const int k = (n ? i - 130 * 4 : i) >> 2, hl = i & 3, d = n ? k - BN_LO : k - 1; int bk;
        if (d < 16) bk = max(d, 0); else { bk = 16 + (int)(logf((float)d / 16.f) / logf(8.f) * 16.f); bk = min(bk, 31); }
        if (d >= 128) bk = 31;
        biasL[i] = d < 0 ? -1.0e30f : (p.in[17][bk * 8 + 4 * g + hl] - p.in[17][31 * 8 + 4 * g + hl]) * 1.4426950408889634f;
    }
    __syncthreads();
}
template <int KIND, int NM> __device__ __forceinline__ float apply_p(f32x16& S, int key0, int h, int pos, int hl, lds_cfp biasL) {
    float sum = 0.f;
    if (NM == 0) {
#pragma unroll
        for (int i = 0; i < 16; ++i) { S[i] = __builtin_amdgcn_exp2f(S[i]); sum += S[i]; }
    } else if (NM == 2) {
        const int B1 = pos - key0 - 4 * h;
#pragma unroll
        for (int i = 0; i < 16; ++i) { const int d = B1 - ((i & 3) + 8 * (i >> 2)); const float v = __builtin_amdgcn_exp2f(S[i]); S[i] = d < 512 ? v : 0.f; sum += S[i]; }
    } else if (KIND == 0) {
        const int B1 = pos - 16 * (key0 + 4 * h) - 30;
#pragma unroll
        for (int i = 0; i < 16; ++i) { const int bi = min(max(B1 - 16 * ((i & 3) + 8 * (i >> 2)), 0), 129);
            S[i] = __builtin_amdgcn_exp2f(S[i] + biasL[bi * 4 + hl]); sum += S[i]; }
    } else {
        lds_cfp tb = biasL + 130 * 4 + (pos - key0 - 4 * h + BN_LO - 27) * 4 + hl;
#pragma unroll
        for (int i = 0; i < 16; ++i) { S[i] = __builtin_amdgcn_exp2f(S[i] + tb[(27 - ((i & 3) + 8 * (i >> 2))) * 4]); sum += S[i]; }
    }
    return sum;
}
struct DCtx { int c, h, pos, pos_lo, pos_hi, head, hl; lds_cfp biasL; };
typedef __attribute__((address_space(3))) const unsigned char* lds_cbp;
template <int KIND, int MODE>
__device__ __forceinline__ void stage_compute(lds_cbp sb, int step, const bf16x8 (&qf)[4], const DCtx& X, f32x16 (&O)[2], float& lsum, float rl, float& carry, float* imp_row) {
#pragma unroll
    for (int t2 = 0; t2 < 2; ++t2) {
        const int kt = 2 * step + t2;
        bool skip; if (KIND == 0) skip = 16 * (32 * kt) + 31 > X.pos_hi; else if (KIND == 1) skip = (32 * kt > X.pos_hi) || (32 * kt + 31 < X.pos_lo - 511); else skip = 32 * kt > X.pos_hi;
        if (skip) continue;
        const int row = 32 * t2 + X.c, sw = (row ^ (row >> 3)) & 7;
        f32x16 S;
#pragma unroll
        for (int i_ = 0; i_ < 16; ++i_) S[i_] = 0.f;
#pragma unroll
        for (int k_ = 0; k_ < 4; ++k_) { const bf16x8 kf = *(const __attribute__((address_space(3))) bf16x8*)(sb + row * 128 + (((2 * k_ + X.h) ^ sw) << 4)); S = MFMA32(kf, qf[k_], S); }
        int nm;
        if (KIND == 0) nm = (X.pos_lo - 16 * (32 * kt + 31) - 31 >= 128) ? 0 : 1;
        else if (KIND == 1) nm = (32 * kt < X.pos_hi - 511) ? 2 : ((32 * kt + 31 <= X.pos_lo - 128) ? 0 : 1);
        else nm = (32 * kt + 31 <= X.pos_lo - 128) ? 0 : 1;
        nm = __builtin_amdgcn_readfirstlane(nm);
        if (nm == 0) lsum += apply_p<KIND, 0>(S, 32 * kt, X.h, X.pos, X.hl, X.biasL);
        else if (KIND == 1 && nm == 2) lsum += apply_p<KIND, 2>(S, 32 * kt, X.h, X.pos, X.hl, X.biasL);
        else lsum += apply_p<KIND, 1>(S, 32 * kt, X.h, X.pos, X.hl, X.biasL);
        if (MODE & 1) { const bf16x8 pa0 = PACK8(S, 0), pa1 = PACK8(S, 1);
#pragma unroll
            for (int d0 = 0; d0 < 2; ++d0) { const int d = 32 * d0 + X.c, sv = (d >> 2) & 3; lds_cbp vb = sb + 8192 + t2 * 4096 + d * 64;
                const bf16x8 v0 = *(const __attribute__((address_space(3))) bf16x8*)(vb + ((X.h ^ sv) << 4)), v1 = *(const __attribute__((address_space(3))) bf16x8*)(vb + (((2 + X.h) ^ sv) << 4));
                O[d0] = MFMA32(pa0, v0, O[d0]); O[d0] = MFMA32(pa1, v1, O[d0]); } }
        if (MODE & 2) { float G[4], E[4], Eo[4];
#pragma unroll
            for (int m = 0; m < 4; ++m) { G[m] = (S[4 * m] + S[4 * m + 1] + S[4 * m + 2] + S[4 * m + 3]) * rl; E[m] = S[4 * m + 3] * rl;
                G[m] = add_xor2(add_xor1(G[m])); E[m] = add_xor2(add_xor1(E[m])); Eo[m] = other_half(E[m], X.h); }
            if (X.h == 1) {
#pragma unroll
                for (int m = 0; m < 4; ++m) G[m] += Eo[m];
            } else { G[0] += carry; G[1] += Eo[0]; G[2] += Eo[1]; G[3] += Eo[2]; carry = Eo[3]; }
            if ((X.c & 3) == 0) {
#pragma unroll
                for (int m = 0; m < 4; ++m) imp_row[kt * 8 + 2 * m + X.h] = G[m];
            } }
    }
}
__device__ __forceinline__ unsigned wave_max_u32(unsigned v) {
    v = max(v, (unsigned)__builtin_amdgcn_update_dpp(0, (int)v, 0xB1, 0xF, 0xF, false));
    v = max(v, (unsigned)__builtin_amdgcn_update_dpp(0, (int)v, 0x4E, 0xF, 0xF, false));
    v = max(v, (unsigned)__builtin_amdgcn_update_dpp(0, (int)v, 0x141, 0xF, 0xF, false));
    v = max(v, (unsigned)__builtin_amdgcn_update_dpp(0, (int)v, 0x140, 0xF, 0xF, false));
    const unsigned s0 = __builtin_amdgcn_readlane(v, 0), s1 = __builtin_amdgcn_readlane(v, 16), s2 = __builtin_amdgcn_readlane(v, 32), s3 = __builtin_amdgcn_readlane(v, 48);
    return max(max(s0, s1), max(s2, s3));
}
__device__ __forceinline__ void attn_unit(const P& p, const int b, const int g, const int cur, unsigned char* ring, const float* biasLg, unsigned long long& sw_acc) {
    unsigned long long sw_t0 = 0;
    int tid = opq_tid(), lane = tid & 63, c = lane & 31, h = lane >> 5; const int w = __builtin_amdgcn_readfirstlane(tid >> 6);
    const int t0 = cur * 64; const size_t tbase = (size_t)b * SEQ;
    bf16* Qs = (bf16*)(ring + AL_Q); float* OACC = (float*)(ring + AL_ACC); float* ACC = OACC + w * (32 * OACC_LD);
    float* LACC = (float*)(ring + AL_LACC);
    float* RS = (float*)(ring + AL_ROWS) + w * 128; unsigned char* RANK = ring + AL_RANK;
    bf16* PARK = (bf16*)(ring + (w < 2 ? AL_PARK01 + w * 4096 : AL_PARK27 + (w - 2) * 4096));
    unsigned char* CUS = p.ws + WS_LOGITS + (size_t)blockIdx.x * CU_SCR_B;
    const bf16* Qg = (const bf16*)(p.ws + WS_Q) + ((tbase + t0) * 8 + 4 * g) * 64;
    const bf16* KVall = (const bf16*)(p.ws + WS_KV);
    auto kvb = [&](int i) { return KVall + (((size_t)i * 2 + b) * 2 + g) * SEQ * 64; };
    const bf16* KC = (const bf16*)(p.ws + WS_KCVC) + (size_t)(b * 2 + g) * NCP * 64; const bf16* VCt = (const bf16*)(p.ws + WS_KCVC) + (size_t)(4 + b * 2 + g) * NCP * 64;
    const float* GATES = (const float*)(p.ws + WS_GATES);
    { unsigned z = 0u; asm volatile("" : "+v"(z)); *(u32x4*)(RANK + tid * 32) = (u32x4){z, z, z, z}; *(u32x4*)(RANK + tid * 32 + 16) = (u32x4){z, z, z, z}; }
    int row = 32 * w + c, ql = row >> 2, hl = row & 3;
    DCtx X; X.c = c; X.h = h; X.pos = t0 + ql; X.pos_lo = t0 + 8 * w; X.pos_hi = X.pos_lo + 7; X.head = 4 * g + hl; X.hl = hl; X.biasL = (lds_cfp)biasLg;
    bf16x8 qf[4];
#pragma unroll
    for (int k = 0; k < 4; ++k) qf[k] = *(const bf16x8*)(Qg + (size_t)(ql * 8 + hl) * 64 + 16 * k + 8 * h);
    const float* gt = GATES + (tbase + X.pos) * 24 + X.head * 3;
#define LANE_REDERIVE() do { tid = opq_tid(); lane = tid & 63; c = lane & 31; h = lane >> 5; row = 32 * w + c; ql = row >> 2; hl = row & 3; \
        X.c = c; X.h = h; X.pos = t0 + ql; X.head = 4 * g + hl; X.hl = hl; gt = GATES + (tbase + X.pos) * 24 + X.head * 3; } while (0)
    unsigned char* STG = ring + AL_Q;
#define ST_SETUP const int tid_s = opq_tid(); const int st_row = tid_s >> 3, st_ch = tid_s & 7, st_d = (tid_s >> 2) & 63; \
    const int st_koff = st_row * 128 + ((st_ch ^ ((st_row ^ (st_row >> 3)) & 7)) << 4), st_voff = 8192 + (tid_s >> 8) * 4096 + st_d * 64 + (((tid_s & 3) ^ ((st_d >> 2) & 3)) << 4); \
    const int st_ksrc_row = st_row * 64 + st_ch * 8, st_ksrc_frag = (((st_row >> 4) * 2 + (st_ch >> 2)) * 16 + (st_row & 15)) * 32 + (st_ch & 3) * 8, st_vsrc = tid_s * 8;
    u32x4 st_k0, st_v0, st_k1, st_v1;
#define ST_ISSUE(S, Kp, Vp, stp, needv, frag) do { st_k##S = *(const u32x4*)((Kp) + (size_t)(stp) * 4096 + ((frag) ? st_ksrc_frag : st_ksrc_row)); if (needv) st_v##S = *(const u32x4*)((Vp) + (size_t)(stp) * 4096 + st_vsrc); } while (0)
#define ST_COMMIT(S, needv) do { *(u32x4*)(STG + (S) * 16384 + st_koff) = st_k##S; if (needv) *(u32x4*)(STG + (S) * 16384 + st_voff) = st_v##S; } while (0)
#define SEQ_RUN(n_, ISSUE, COMP, NEEDV) do { \
        ISSUE(0, 0); if ((n_) > 1) ISSUE(1, 1); ST_COMMIT(0, NEEDV(0)); if ((n_) > 2) ISSUE(0, 2); __syncthreads(); \
        for (int j = 0; j < (n_); j += 2) { \
            COMP(j, (lds_cbp)STG); \
            if (j + 1 < (n_)) { ST_COMMIT(1, NEEDV(j + 1)); if (j + 3 < (n_)) ISSUE(1, j + 3); } \
            __syncthreads(); \
            if (j + 1 < (n_)) { COMP(j + 1, (lds_cbp)(STG + 16384)); \
                if (j + 2 < (n_)) { ST_COMMIT(0, NEEDV(j + 2)); if (j + 4 < (n_)) ISSUE(0, j + 4); } \
                __syncthreads(); } } } while (0)
    SW_BEGIN(1);
    const int NTc = (4 * cur + 3 + 31) >> 5, nc = (NTc + 1) >> 1;
    f32x16 Ob[2];
    float lsum = 0.f, carry = 0.f, dummy = 0.f, rlc = 0.f;
    {
        ST_SETUP
        const int n = 2 * nc;
#define A_NEEDV(j_) ((j_) >= nc)
#define A_ISSUE(S, j_) ST_ISSUE(S, KC, VCt, ((j_) % nc), A_NEEDV(j_), false)
#define A_COMP(j_, sb_) do { if ((j_) < nc) { stage_compute<0, 0>(sb_, (j_), qf, X, Ob, lsum, 0.f, carry, nullptr); \
                if ((j_) == nc - 1) { lsum = sum_halves(lsum); rlc = lsum > 0.f ? 1.f / lsum : 0.f; } } \
            else stage_compute<0, 3>(sb_, (j_) - nc, qf, X, Ob, dummy, rlc, carry, OACC + (size_t)(8 * w + (c >> 2)) * IMP_LD); } while (0)
#pragma unroll
        for (int i = 0; i < 16; ++i) { Ob[0][i] = 0.f; Ob[1][i] = 0.f; }
        SEQ_RUN(n, A_ISSUE, A_COMP, A_NEEDV);
        if (h == 0) RS[c] = gt[0] * rlc;
        LDS_FENCE();
#pragma unroll
        for (int i = 0; i < 16; ++i) { const int r = crow(i, h); const float a = RS[r];
#pragma unroll
            for (int d0 = 0; d0 < 2; ++d0) PARK[r * 64 + 32 * d0 + c] = (bf16)f2bf(Ob[d0][i] * a); }
#undef A_NEEDV
#undef A_ISSUE
#undef A_COMP
    }
    LDS_FENCE();
    SW_END(1);
    SW_BEGIN(2);
    if (cur >= 16) {
#if PROBE_ATT == 3
        for (int rep = 0; rep < 2; ++rep)
#endif
        for (int qi = 0; qi < 8; ++qi) {
            unsigned key[4];
#pragma unroll
            for (int j = 0; j < 4; ++j) { const int s = lane + 64 * j; const float v = OACC[(size_t)(8 * w + qi) * IMP_LD + s];
                key[j] = (s >= 1 && s <= cur - 2) ? ((__float_as_uint(v) & 0xFFFFFE00u) | 0x100u | (unsigned)(255 - s)) : 0u; }
            for (int r = 0; r < 13; ++r) {
                const unsigned m = wave_max_u32(max(max(key[0], key[1]), max(key[2], key[3])));
                if (m == 0u) break;
                if (lane == 0) RANK[(255u - (m & 0xFFu)) * 64 + 8 * w + qi] = (unsigned char)(r + 1);
#pragma unroll
                for (int j = 0; j < 4; ++j) key[j] = key[j] == m ? 0u : key[j];
            }
        }
    }
    LDS_FENCE();
    SW_END(2);
    SW_BEGIN(3);
    if (cur >= 16) {
#pragma unroll
        for (int k = 0; k < 4; ++k) { const int ci = tid + 512 * k, ql_ = ci >> 5, rem = ci & 31;
            const u32x4 qv = *(const u32x4*)(Qg + (size_t)(ql_ * 8 + (rem >> 3)) * 64 + (rem & 7) * 8);
            *(u32x2*)((unsigned char*)Qs + (size_t)ci * 8) = pack8_fp8(bflo(qv.x), bfhi(qv.x), bflo(qv.y), bfhi(qv.y), bflo(qv.z), bfhi(qv.z), bflo(qv.w), bfhi(qv.w)); }
        __syncthreads();
        const int lane_g = opq_tid() & 63, kr = lane_g & 15, qr = lane_g >> 4, qi = kr >> 2, hh = kr & 3, lim = cur - 2;
        typedef long lx2 __attribute__((ext_vector_type(2)));
        const unsigned char* V8 = (const unsigned char*)kvb(6) + (kr * 4 + qr) * 16; const unsigned char* K8 = V8 + 1048576;
        const unsigned char* Qs8 = (const unsigned char*)Qs;
        lds_cfp biasL = X.biasL;
        u32x4 kA[4], vA[4], kB[4], vB[4], kC[4], vC[4];
#define MFMA8(a, b, c) __builtin_amdgcn_mfma_f32_16x16x32_fp8_fp8((a), (b), (c), 0, 0, 0)
#define GA_NEXT(s_) do { while ((s_) <= lim && __ballot(RANK[(s_) * 64 + lane_g] != 0) == 0ull) (s_) += 8; (s_) = __builtin_amdgcn_readfirstlane((s_)); } while (0)
#define GA_LOAD(kf, s_) do { _Pragma("unroll") for (int a_ = 0; a_ < 4; ++a_) kf[a_] = *(const u32x4*)(K8 + (size_t)(s_) * 4096 + a_ * 1024); } while (0)
#define GA_LOADV(vf, s_) do { _Pragma("unroll") for (int a_ = 0; a_ < 4; ++a_) vf[a_] = *(const u32x4*)(V8 + (size_t)(s_) * 4096 + a_ * 1024); } while (0)
#define GA_PROC(kf, vf, s_) do { unsigned long long m = __ballot(RANK[(s_) * 64 + lane_g] != 0); \
            const bool near = ((s_) == lim); \
            while (m) { int q0 = __builtin_ctzll(m); m &= m - 1; int nv = 1, q1 = q0, q2 = q0, q3 = q0; \
                if (m) { q1 = __builtin_ctzll(m); m &= m - 1; nv = 2; if (m) { q2 = __builtin_ctzll(m); m &= m - 1; nv = 3; if (m) { q3 = __builtin_ctzll(m); m &= m - 1; nv = 4; } } } \
                const int myq = qi == 0 ? q0 : qi == 1 ? q1 : qi == 2 ? q2 : q3; \
                const unsigned char* qp = Qs8 + (size_t)(myq * 4 + hh) * 64 + 8 * qr; const long qb0 = *(const long*)qp, qb1 = *(const long*)(qp + 32); \
                f32x4 St[4]; _Pragma("unroll") for (int kg = 0; kg < 4; ++kg) { const lx2 kk_ = __builtin_bit_cast(lx2, kf[kg]); St[kg] = (f32x4){0.f, 0.f, 0.f, 0.f}; St[kg] = MFMA8(kk_.x, qb0, St[kg]); St[kg] = MFMA8(kk_.y, qb1, St[kg]); } \
                const int qpos = t0 + myq; float mx = -3.0e38f; \
                if (near) { _Pragma("unroll") for (int kg = 0; kg < 4; ++kg) _Pragma("unroll") for (int e = 0; e < 4; ++e) { const int dist = qpos - ((s_) * 64 + 16 * kg + 4 * qr + e); St[kg][e] += biasL[(min(max(dist, 0), 128) + 1) * 4 + hh]; } } \
                _Pragma("unroll") for (int kg = 0; kg < 4; ++kg) mx = fmaxf(mx, fmaxf(fmaxf(St[kg][0], St[kg][1]), fmaxf(St[kg][2], St[kg][3]))); \
                mx = max_rows(mx);        \
                float lg = 0.f; \
                _Pragma("unroll") for (int kg = 0; kg < 4; ++kg) _Pragma("unroll") for (int e = 0; e < 4; ++e) { const float x = __builtin_amdgcn_exp2f(St[kg][e] - mx); St[kg][e] = x; lg += x; } \
                const long pb0 = __builtin_bit_cast(long, pack8_fp8(St[0][0], St[0][1], St[0][2], St[0][3], St[1][0], St[1][1], St[1][2], St[1][3])); \
                const long pb1 = __builtin_bit_cast(long, pack8_fp8(St[2][0], St[2][1], St[2][2], St[2][3], St[3][0], St[3][1], St[3][2], St[3][3])); \
                lg = sum_rows(lg); \
                unsigned char* sp = CUS + (size_t)(myq * 13 + RANK[(s_) * 64 + myq] - 1) * SLOT_B; const bool st_ok = qi < nv && !noacc; \
                _Pragma("unroll") for (int dg = 0; dg < 4; ++dg) { const lx2 vv_ = __builtin_bit_cast(lx2, vf[dg]); f32x4 OT = (f32x4){0.f, 0.f, 0.f, 0.f}; OT = MFMA8(vv_.x, pb0, OT); OT = MFMA8(vv_.y, pb1, OT); \
                    if (st_ok) *(u32x2*)(sp + hh * 128 + (16 * dg + 4 * qr) * 2) = (u32x2){cvtpk(OT[0], OT[1]), cvtpk(OT[2], OT[3])}; } \
                if (st_ok && qr == 0) { *(float*)(sp + 512 + hh * 4) = lg * __builtin_amdgcn_exp2f(mx); *(float*)(sp + 528 + hh * 4) = mx; } } } while (0)
#if PROBE_ATT == 4
        for (int rep = 0; rep < 2; ++rep) { const bool noacc = (rep == 0);
#else
        { const bool noacc = false;
#endif
        int sa = (w == 0) ? 8 : w; GA_NEXT(sa);
        int sb_ = sa + 8; GA_NEXT(sb_);
        int sc_ = sb_ + 8; GA_NEXT(sc_);
        if (sa <= lim) { GA_LOAD(kA, sa); GA_LOADV(vA, sa); }
        if (sb_ <= lim) { GA_LOAD(kB, sb_); GA_LOADV(vB, sb_); }
        if (sc_ <= lim) { GA_LOAD(kC, sc_); GA_LOADV(vC, sc_); }
        while (sa <= lim) {
            GA_PROC(kA, vA, sa);
            sa = sc_ + 8; GA_NEXT(sa);
            if (sa <= lim) { GA_LOAD(kA, sa); GA_LOADV(vA, sa); }
            if (sb_ > lim) break;
            GA_PROC(kB, vB, sb_);
            sb_ = sa + 8; GA_NEXT(sb_);
            if (sb_ <= lim) { GA_LOAD(kB, sb_); GA_LOADV(vB, sb_); }
            if (sc_ > lim) break;
            GA_PROC(kC, vC, sc_);
            sc_ = sb_ + 8; GA_NEXT(sc_);
            if (sc_ <= lim) { GA_LOAD(kC, sc_); GA_LOADV(vC, sc_); }
        }
        }
#undef GA_NEXT
#undef MFMA8
#undef GA_LOAD
#undef GA_LOADV
#undef GA_PROC
        asm volatile("s_waitcnt vmcnt(0) lgkmcnt(0)" ::: "memory");
        __syncthreads();
        SW_END(3);
        SW_BEGIN(4);
        {
            const __amdgpu_buffer_rsrc_t rs_ = __builtin_amdgcn_make_buffer_rsrc((void*)CUS, 0, CU_SCR_B, 0x00020000);
#pragma unroll 4
            for (int qi2 = 0; qi2 < 8; ++qi2) {
                const int qoff = ((8 * w + qi2) * 13) * SLOT_B;
                u32x2 pv[13]; unsigned lv[13], mo[13];
#pragma unroll
                for (int r = 0; r < 13; ++r) { pv[r] = __builtin_bit_cast(u32x2, __builtin_amdgcn_raw_buffer_load_b64(rs_, qoff + r * SLOT_B + lane * 8, 0, 16));
                    lv[r] = __builtin_amdgcn_raw_buffer_load_b32(rs_, qoff + r * SLOT_B + 512 + (lane & 3) * 4, 0, 16);
                    mo[r] = __builtin_amdgcn_raw_buffer_load_b32(rs_, qoff + r * SLOT_B + 528 + (lane >> 4) * 4, 0, 16); }
                float a0 = 0.f, a1 = 0.f, a2 = 0.f, a3 = 0.f, ll = 0.f;
#pragma unroll
                for (int r = 0; r < 13; ++r) { const float so = __builtin_amdgcn_exp2f(__builtin_bit_cast(float, mo[r]));
                    a0 += bflo(pv[r].x) * so; a1 += bfhi(pv[r].x) * so; a2 += bflo(pv[r].y) * so; a3 += bfhi(pv[r].y) * so; ll += __builtin_bit_cast(float, lv[r]); }
                float* ap = ACC + (size_t)(qi2 * 4 + (lane >> 4)) * OACC_LD + 4 * (lane & 15);
                ap[0] = a0; ap[1] = a1; ap[2] = a2; ap[3] = a3;
                if (lane < 4) LACC[32 * w + qi2 * 4 + lane] = ll;
            }
        }
    } else {
        for (int i = lane; i < 32 * OACC_LD; i += 64) ACC[i] = 0.f;
        if (lane < 32) LACC[32 * w + lane] = 0.f;
    }
    LDS_FENCE();
    SW_END(4);
    SW_BEGIN(5);
    LANE_REDERIVE();
#pragma unroll
    for (int k = 0; k < 4; ++k) qf[k] = *(const bf16x8*)(Qg + (size_t)(ql * 8 + hl) * 64 + 16 * k + 8 * h);
    {
        ST_SETUP
        const int ns = cur <= 15 ? cur + 1 : 3, w0 = max(0, t0 - 511) >> 6, nw = cur - w0 + 1, n = ns + nw;
        const bf16* KSd = kvb(2); const bf16* VSd = kvb(3); const bf16* KWd = kvb(4); const bf16* VWd = kvb(5);
#define SEQB_SRC(j_, Kp_, Vp_, st_) do { if ((j_) < ns) { Kp_ = KSd; Vp_ = VSd; st_ = cur <= 15 ? (j_) : ((j_) == 0 ? 0 : cur - 2 + (j_)); } \
            else { Kp_ = KWd; Vp_ = VWd; st_ = w0 + (j_) - ns; } } while (0)
#define FOLD(slot_, aexpr_, first_) do { if (h == 0) RS[(slot_) * 32 + c] = (aexpr_); LDS_FENCE(); \
            _Pragma("unroll") for (int i = 0; i < 16; ++i) { const int r = crow(i, h); const float a = RS[(slot_) * 32 + r]; \
                _Pragma("unroll") for (int d0 = 0; d0 < 2; ++d0) { float* ap = ACC + r * OACC_LD + 32 * d0 + c; if (first_) *ap = a * (Ob[d0][i] + *ap) + bf2f(PARK[r * 64 + 32 * d0 + c]); else *ap += a * Ob[d0][i]; } } \
            _Pragma("unroll") for (int i = 0; i < 16; ++i) { Ob[0][i] = 0.f; Ob[1][i] = 0.f; } lsum = 0.f; } while (0)
#pragma unroll
        for (int i = 0; i < 16; ++i) { Ob[0][i] = 0.f; Ob[1][i] = 0.f; }
        lsum = 0.f;
#define B_NEEDV(j_) true
#define B_ISSUE(S, j_) do { const bf16* Kp; const bf16* Vp; int stp; SEQB_SRC((j_), Kp, Vp, stp); ST_ISSUE(S, Kp, Vp, stp, true, (j_) < ns); } while (0)
#define B_COMP(j_, sb_) do { int st_j; { const bf16* k_; const bf16* v_; SEQB_SRC((j_), k_, v_, st_j); (void)k_; (void)v_; } \
            if ((j_) < ns) { stage_compute<2, 1>(sb_, st_j, qf, X, Ob, lsum, 0.f, carry, nullptr); \
                if ((j_) == ns - 1) { lsum = sum_halves(lsum); const float ls = lsum + LACC[32 * w + c]; FOLD(0, gt[1] * (ls > 0.f ? 1.f / ls : 0.f), true); } } \
            else { stage_compute<1, 1>(sb_, st_j, qf, X, Ob, lsum, 0.f, carry, nullptr); \
                if ((j_) == n - 1) { lsum = sum_halves(lsum); FOLD(2, gt[2] * (lsum > 0.f ? 1.f / lsum : 0.f), false); } } } while (0)
        SEQ_RUN(n, B_ISSUE, B_COMP, B_NEEDV);
#undef B_ISSUE
#undef B_COMP
#undef B_NEEDV
#undef SEQB_SRC
#undef FOLD
    }
#undef ST_ISSUE
#undef ST_COMMIT
#undef SEQ_RUN
    SW_END(5);
    SW_BEGIN(6);
    LDS_FENCE();
    {
        const int r = lane >> 1, hf = lane & 1; const float* src = ACC + r * OACC_LD + 32 * hf;
        float v[32]; float ss = 0.f;
#pragma unroll
        for (int k = 0; k < 32; ++k) { v[k] = src[k]; ss += v[k] * v[k]; }
        ss = add_xor1(ss);
        const float rstd = rsqrtf(ss * (1.f / 64.f) + EPS);
        const int rq = (32 * w + r) >> 2, rh = (32 * w + r) & 3; const int col = (4 * g + rh) * 64 + 32 * hf;
        const float* onw = p.in[15] + col; bf16* dst = (bf16*)(p.ws + WS_MIX) + (tbase + t0 + rq) * DM + col;
#pragma unroll
        for (int k = 0; k < 4; ++k) { const f32x4 w0 = *(const f32x4*)(onw + 8 * k), w1 = *(const f32x4*)(onw + 8 * k + 4);
            *(u32x4*)(dst + 8 * k) = (u32x4){cvtpk(v[8 * k] * rstd * w0.x, v[8 * k + 1] * rstd * w0.y), cvtpk(v[8 * k + 2] * rstd * w0.z, v[8 * k + 3] * rstd * w0.w),
                                            cvtpk(v[8 * k + 4] * rstd * w1.x, v[8 * k + 5] * rstd * w1.y), cvtpk(v[8 * k + 6] * rstd * w1.z, v[8 * k + 7] * rstd * w1.w)}; }
    }
    SW_END(6);
    __syncthreads();
}
__device__ __forceinline__ void ph_attn(const P& p, unsigned char* ring, float* biasL) {
    const int bx = blockIdx.x, vcu = (bx & 7) * 32 + (bx >> 3), bg = vcu >> 6, si = vcu & 63;
    build_bias_table(p, biasL, bg & 1);
    unsigned long long sw_acc = 0;
    for (int ui = 0; ui < 4; ++ui) {
        const int cur = ui == 0 ? si : ui == 1 ? 127 - si : ui == 2 ? 128 + si : 255 - si;
        attn_unit(p, bg >> 1, bg & 1, cur, ring, biasL, sw_acc);
    }
    if (SW_REGION != 0 && si == 24 && bg == 1) {
        const unsigned long long t0 = __builtin_amdgcn_s_memrealtime();
        while (__builtin_amdgcn_s_memrealtime() - t0 < 4ull * sw_acc) __builtin_amdgcn_s_sleep(8);
    }
}

template <int NR>
__device__ __forceinline__ void ph_route(const P& p, int row_lo, int tid, int* lsh  ) {
    const float* LG = (const float*)(p.ws + WS_LOGITS); unsigned* cnt = (unsigned*)(p.ws + WS_CTL) + CW_CNT;
    int* LISTS = (int*)(p.ws + WS_LISTS); float* ROWW = (float*)(p.ws + WS_ROWW);
    const float* bg = p.in[20]; const float* be = p.in[22];
    if (tid < 64) lsh[tid] = 0;
    __syncthreads();
    int ex0 = 0, ex1 = 0, r0 = 0, r1 = 0; float w0 = 0.f, w1 = 0.f; const int t = row_lo + tid;
    if (tid < NR) {
        const float* l = LG + (size_t)t * 128;
        float gl[8]; float gm = -3.0e38f; int gi = 0;
        { const f32x4 a = *(const f32x4*)l, b2 = *(const f32x4*)(l + 4); gl[0] = a.x; gl[1] = a.y; gl[2] = a.z; gl[3] = a.w; gl[4] = b2.x; gl[5] = b2.y; gl[6] = b2.z; gl[7] = b2.w; }
#pragma unroll
        for (int i = 0; i < 8; ++i) { gl[i] += bg[i]; if (gl[i] > gm) { gm = gl[i]; gi = i; } }
        float gs = 0.f;
#pragma unroll
        for (int i = 0; i < 8; ++i) gs += __expf(gl[i] - gm);
        const float gp = 1.f / gs;
        float el[8]; float m0 = -3.0e38f, m1 = -3.0e38f; int i0 = 0, i1 = 0;
        { const f32x4 a = *(const f32x4*)(l + 8 + gi * 8), b2 = *(const f32x4*)(l + 12 + gi * 8); el[0] = a.x; el[1] = a.y; el[2] = a.z; el[3] = a.w; el[4] = b2.x; el[5] = b2.y; el[6] = b2.z; el[7] = b2.w; }
#pragma unroll
        for (int i = 0; i < 8; ++i) { el[i] += be[gi * 8 + i];
            if (el[i] > m0) { m1 = m0; i1 = i0; m0 = el[i]; i0 = i; } else if (el[i] > m1) { m1 = el[i]; i1 = i; } }
        const float e1 = __expf(m1 - m0); w0 = gp / (1.f + e1); w1 = gp * e1 / (1.f + e1);
        ex0 = gi * 8 + i0; ex1 = gi * 8 + i1;
        r0 = atomicAdd(&lsh[ex0], 1); r1 = atomicAdd(&lsh[ex1], 1);
    }
    __syncthreads();
    if (tid < 64) { const int c = lsh[tid]; lsh[128 + tid] = c ? (int)atomicAdd(&cnt[tid * 16], (unsigned)c) : 0; }
    __syncthreads();
    if (tid < NR) {
        const int s0 = lsh[128 + ex0] + r0, s1 = lsh[128 + ex1] + r1;
        LISTS[(size_t)ex0 * T + s0] = t; ROWW[(size_t)ex0 * T + s0] = w0;
        LISTS[(size_t)ex1 * T + s1] = t | (int)0x80000000; ROWW[(size_t)ex1 * T + s1] = w1;
    }
}
__device__ __forceinline__ void ph_norm2_router(const P& p, unsigned char* ldsb) {
    const int tid = opq_tid(), lane = tid & 63, wv = tid >> 6, fr = lane & 15, fq = lane >> 4;
    constexpr int WLD = 2064, L_AB = 73 * WLD, L_RT = L_AB + 8192;
    const int row0 = blockIdx.x * 128, b = row0 / SEQ, row = row0 + wv * 16 + fr;
    const bf16* xr = (const bf16*)(p.ws + WS_X1) + (size_t)row * DM + fq * 8;
    const bf16* WR = (const bf16*)(p.ws + WS_WR_T);
#pragma unroll
    for (int k = 0; k < 18; ++k) { const int it = __builtin_amdgcn_readfirstlane(wv) + 8 * k, n = it >> 1, hf = it & 1;
        __builtin_amdgcn_global_load_lds((const unsigned*)(WR + (size_t)n * 1024 + hf * 512 + lane * 8), (PG8_LAS unsigned*)((PG8_LAS unsigned char*)ldsb + (n + (n >= 67 ? 1 : 0)) * WLD + hf * 1024), 16, 0, 0); }
    const float* mod = (const float*)(p.ws + WS_MOD) + b * 6144 + 3072; const float* nw = p.in[18]; const int t8 = tid & 255;
    const f32x4 m_sh = *(const f32x4*)(mod + 4 * t8), m_sc = *(const f32x4*)(mod + 1024 + 4 * t8), m_w = *(const f32x4*)(nw + 4 * t8);
    asm volatile("" ::: "memory");
    u32x4 v[32];
#pragma unroll
    for (int ks = 0; ks < 32; ++ks) v[ks] = *(const u32x4*)(xr + 32 * ks);
    asm volatile("s_waitcnt vmcnt(32)" ::: "memory");
    if (tid < 256) { *(f32x4*)(ldsb + L_AB + 16 * tid) = m_w * (m_sc + 1.f); *(f32x4*)(ldsb + L_AB + 4096 + 16 * tid) = m_sh; }
    asm volatile("s_waitcnt lgkmcnt(0)" ::: "memory"); __builtin_amdgcn_s_barrier(); asm volatile("" ::: "memory");
    float ss = 0.f;
#pragma unroll
    for (int ks = 0; ks < 32; ++ks) { const u32x4 a = v[ks];
        ss += bflo(a.x) * bflo(a.x) + bfhi(a.x) * bfhi(a.x) + bflo(a.y) * bflo(a.y) + bfhi(a.y) * bfhi(a.y) + bflo(a.z) * bflo(a.z) + bfhi(a.z) * bfhi(a.z) + bflo(a.w) * bflo(a.w) + bfhi(a.w) * bfhi(a.w); }
    const float rstd = rsqrtf(sum_rows(ss) * (1.f / DM) + EPS);
#pragma unroll
    for (int ks = 0; ks < 32; ++ks) asm volatile("" : "+v"(v[ks]));
    f32x4 acc[5];
#pragma unroll
    for (int j = 0; j < 5; ++j) acc[j] = (f32x4){0.f, 0.f, 0.f, 0.f};
    bf16* xo = (bf16*)(p.ws + WS_XN) + (size_t)row * DM + fq * 8;
    const unsigned char* wl = ldsb + fr * WLD + fq * 16; const unsigned char* ab = ldsb + L_AB + fq * 32;
#pragma unroll
    for (int ks = 0; ks < 32; ++ks) {
        const f32x4 a0 = *(const f32x4*)(ab + ks * 128), a1 = *(const f32x4*)(ab + ks * 128 + 16), b0 = *(const f32x4*)(ab + 4096 + ks * 128), b1 = *(const f32x4*)(ab + 4096 + ks * 128 + 16);
        const u32x4 a = v[ks];
        const f32x4 h0 = (f32x4){bflo(a.x), bfhi(a.x), bflo(a.y), bfhi(a.y)} * rstd * a0 + b0, h1 = (f32x4){bflo(a.z), bfhi(a.z), bflo(a.w), bfhi(a.w)} * rstd * a1 + b1;
        const u32x4 hv = (u32x4){pk2(h0.x, h0.y), pk2(h0.z, h0.w), pk2(h1.x, h1.y), pk2(h1.z, h1.w)};
        *(u32x4*)(xo + 32 * ks) = hv;
        const bf16x8 af = __builtin_bit_cast(bf16x8, hv);
#pragma unroll
        for (int j = 0; j < 5; ++j) { u32x4 w = (j < 4 || fr < 8) ? *(const u32x4*)(wl + (j * 16 + ((j == 4 && fr >= 3) ? 1 : 0)) * WLD + ks * 64) : (u32x4){0u, 0u, 0u, 0u};
            acc[j] = __builtin_amdgcn_mfma_f32_16x16x32_bf16(__builtin_bit_cast(bf16x8, w), af, acc[j], 0, 0, 0); }
        asm volatile("" ::: "memory");
    }
    float* LG = (float*)(p.ws + WS_LOGITS) + (size_t)row * 128 + 4 * fq;
#pragma unroll
    for (int j = 0; j < 4; ++j) *(f32x4*)(LG + 16 * j) = acc[j];
    if (fq < 2) *(f32x4*)(LG + 64) = acc[4];
    asm volatile("s_waitcnt vmcnt(0)" ::: "memory");
    __syncthreads();
    ph_route<128>(p, row0, tid, (int*)(ldsb + L_RT));
}
__device__ __forceinline__ void build_tile_base(const P& p, int* tb) {
    const unsigned* cnt = (const unsigned*)(p.ws + WS_CTL) + CW_CNT;
    if (threadIdx.x == 0) { int s = 0; for (int i = 0; i < 64; ++i) { tb[i] = s; s += ((int)cnt[i * 16] + 255) >> 8; } tb[64] = s; }
    __syncthreads();
}
__device__ __forceinline__ void ph_combine(const P& p, int gw, int ngw) {
    const int lane = opq_tid() & 63;
    const bf16* X1 = (const bf16*)(p.ws + WS_X1); const bf16* Y0 = (const bf16*)(p.ws + WS_XN); const bf16* Y1 = (const bf16*)(p.ws + WS_Y1);
    constexpr int RU = 4;
    for (int row0 = gw; row0 < T; row0 += RU * ngw) {
        u32x4 x0[RU], x1[RU], a0[RU], a1[RU], b0[RU], b1[RU];
        const float* g2 = (const float*)(p.ws + WS_MOD) + (row0 / SEQ) * 6144 + 5120 + lane * 16;
        const f32x4 g0 = *(const f32x4*)g2, g1 = *(const f32x4*)(g2 + 4), g2v = *(const f32x4*)(g2 + 8), g3 = *(const f32x4*)(g2 + 12);
#pragma unroll
        for (int u = 0; u < RU; ++u) { const size_t off = (size_t)(row0 + u * ngw) * DM + lane * 16;
            x0[u] = *(const u32x4*)(X1 + off); x1[u] = *(const u32x4*)(X1 + off + 8); a0[u] = *(const u32x4*)(Y0 + off); a1[u] = *(const u32x4*)(Y0 + off + 8); b0[u] = *(const u32x4*)(Y1 + off); b1[u] = *(const u32x4*)(Y1 + off + 8); }
#pragma unroll
        for (int u = 0; u < RU; ++u) { float* o = p.out + (size_t)(row0 + u * ngw) * DM + lane * 16;
#define CMB(xv, av, bv, gv) (f32x4){bflo(xv.x) + gv[0] * (bflo(av.x) + bflo(bv.x)), bfhi(xv.x) + gv[1] * (bfhi(av.x) + bfhi(bv.x)), bflo(xv.y) + gv[2] * (bflo(av.y) + bflo(bv.y)), bfhi(xv.y) + gv[3] * (bfhi(av.y) + bfhi(bv.y))}
#define CMB2(xv, av, bv, gv) (f32x4){bflo(xv.z) + gv[0] * (bflo(av.z) + bflo(bv.z)), bfhi(xv.z) + gv[1] * (bfhi(av.z) + bfhi(bv.z)), bflo(xv.w) + gv[2] * (bflo(av.w) + bflo(bv.w)), bfhi(xv.w) + gv[3] * (bfhi(av.w) + bfhi(bv.w))}
            *(f32x4*)o = CMB(x0[u], a0[u], b0[u], g0); *(f32x4*)(o + 4) = CMB2(x0[u], a0[u], b0[u], g1);
            *(f32x4*)(o + 8) = CMB(x1[u], a1[u], b1[u], g2v); *(f32x4*)(o + 12) = CMB2(x1[u], a1[u], b1[u], g3); }
#undef CMB
#undef CMB2
    }
}
#define LAS __attribute__((address_space(3)))
#define XB_TMO      128
#define XB_XCNT(j)  (256  + 64 * (j))
#define XB_XSUB(j)  (1280 + 64 * (j))
#define XB_XGEN(j)  (2304 + 64 * (j))
#define XB_TOP      3328
#define XB_TOPGEN   3392
#define XCD_BAR_WORDS 3456
#define XB_SPIN_CAP (1u << 18)
constexpr int CW_BAR = 4096;
__device__ __forceinline__ unsigned xb_ld(unsigned* p)              { return __hip_atomic_load(p, __ATOMIC_RELAXED, __HIP_MEMORY_SCOPE_AGENT); }
__device__ __forceinline__ unsigned xb_add(unsigned* p, unsigned v) { return __hip_atomic_fetch_add(p, v, __ATOMIC_RELAXED, __HIP_MEMORY_SCOPE_AGENT); }
__device__ __forceinline__ unsigned xb_xcc_id() { return (unsigned)__builtin_amdgcn_s_getreg((3 << 11) | 20) & 0xFu; }
#define XB_SPIN(cond, bar) do { unsigned _sp = 0; while (cond) { __builtin_amdgcn_s_sleep(1); \
    if ((++_sp & 255u) == 0u) { if (xb_ld(&(bar)[XB_TMO])) break; if (_sp > XB_SPIN_CAP) { atomicAdd(&(bar)[XB_TMO], 1u); break; } } } } while (0)
struct XcdBarrier { unsigned* bar; unsigned x; volatile LAS unsigned* st; };
__device__ __forceinline__ XcdBarrier xcd_barrier_post(unsigned* bar, volatile LAS unsigned* st) {
    XcdBarrier b; b.bar = bar; b.x = xb_xcc_id(); b.st = st;
    if (threadIdx.x == 0) (void)xb_add(&bar[XB_XCNT(b.x)], 1u);
    return b;
}
__device__ __forceinline__ void xcd_barrier_complete(unsigned* bar, unsigned x, unsigned& nloc, unsigned& nx) {
    const unsigned G = gridDim.x * gridDim.y * gridDim.z;
    unsigned sum, cnt, mine, sp = 0u;
    for (;;) {
        sum = 0u; cnt = 0u; mine = 0u;
#pragma unroll
        for (unsigned j = 0; j < 16; ++j) { const unsigned c = xb_ld(&bar[XB_XCNT(j)]); sum += c; cnt += (c > 0u) ? 1u : 0u; mine = (j == x) ? c : mine; }
        if (sum == G) break;
        __builtin_amdgcn_s_sleep(1);
        if ((++sp & 255u) == 0u) { if (xb_ld(&bar[XB_TMO])) break; if (sp > XB_SPIN_CAP) { atomicAdd(&bar[XB_TMO], 1u); break; } }
    }
    nloc = mine > 0u ? mine : 1u; nx = cnt > 0u ? cnt : 1u;
}
__device__ __forceinline__ void xcd_barrier(const XcdBarrier& b) {
    asm volatile("s_waitcnt vmcnt(0)" ::: "memory");
    __syncthreads();
    if (threadIdx.x == 0) {
        unsigned* bar = b.bar;
        __builtin_amdgcn_s_waitcnt(0);
        unsigned nloc = b.st[0], nx = b.st[1];
        if (nloc == 0u) { xcd_barrier_complete(bar, b.x, nloc, nx); b.st[0] = nloc; b.st[1] = nx; }
        const unsigned old = xb_add(&bar[XB_XSUB(b.x)], 1u);
        const unsigned gen = old / nloc;
        if (old + 1u == (gen + 1u) * nloc) {
            __builtin_amdgcn_fence(__ATOMIC_RELEASE, "agent");
            asm volatile("s_waitcnt vmcnt(0)" ::: "memory");
            const unsigned og = xb_add(&bar[XB_TOP], 1u);
            const unsigned tg = og / nx;
            if (og + 1u == (tg + 1u) * nx) xb_add(&bar[XB_TOPGEN], 1u);
            else XB_SPIN(xb_ld(&bar[XB_TOPGEN]) == tg, bar);
            __builtin_amdgcn_fence(__ATOMIC_ACQUIRE, "agent");
            xb_add(&bar[XB_XGEN(b.x)], 1u);
            asm volatile("s_waitcnt vmcnt(0)" ::: "memory");
        } else {
            XB_SPIN(xb_ld(&bar[XB_XGEN(b.x)]) == gen, bar);
            __builtin_amdgcn_fence(__ATOMIC_ACQUIRE, "agent");
            asm volatile("s_waitcnt vmcnt(0)" ::: "memory");
        }
    }
    __syncthreads();
}

constexpr int NT = 512;
constexpr int LDS_SCR = 0, LDS_SHB = 131072, LDS_MISC = 139200, LDS_BYTES = 163840;
__global__ void __launch_bounds__(NT) mega(P p) {
    extern __shared__ __attribute__((aligned(16))) unsigned char ldsb[];
    float* lds = (float*)ldsb;
    const int ngw = gridDim.x * (NT / 64);
#define TIDV opq_tid()
#define GW (blockIdx.x * (NT / 64) + (TIDV >> 6))
#define SCR (lds + (TIDV >> 6) * (8448 / 4))
    float* shb = lds + LDS_SHB / 4;
    volatile LAS unsigned* misc = (volatile LAS unsigned*)((LAS unsigned char*)ldsb + LDS_MISC);
    if (threadIdx.x < 16) misc[threadIdx.x] = 0u;
    __syncthreads();
    XcdBarrier bar = xcd_barrier_post((unsigned*)(p.ws + WS_CTL) + CW_BAR, misc);
#define GB() xcd_barrier(bar)
    PG8_LAS unsigned char* ring = (PG8_LAS unsigned char*)ldsb;
    const int G = gridDim.x, cb = blockIdx.x;
    const unsigned* cnt = (const unsigned*)(p.ws + WS_CTL) + CW_CNT;
#define PHASE_0 { if (cb < 192) ph_mod(p, blockIdx.x, 192, shb); else { ph_posb(p, cb - 192, shb); ph_wprep_a(p, GW - 192 * (NT / 64), ngw - 192 * (NT / 64), SCR); } }
#define PHASE_1 { ph_rownorm<false>(p, GW, ngw, p.in[0], 0); }
#define PHASE_2 { pg8::StaticOrder S; S.init(p.ws + WS_XN, p.ws + WS_WIN_T, DM, DM, T, NINP, G, cb); pg8::EpiRaw E{(bf16*)(p.ws + WS_R1), NINP}; \
      pg8::gemm_phase<pg8::EpiRaw, pg8::StaticOrder, false>(ring, DM, DM, S, E); }
#define PHASE_3 { ph_post(p, ldsb); }
#define PHASE_4 { if (cb < 32) { pg8::CmpOrder S{(const char*)(p.ws + WS_KV), (const char*)(p.ws + WS_CW1_T), cb}; pg8::EpiCmp E{(bf16*)(p.ws + WS_HID), (const float*)(p.ws + WS_POSB)}; \
      pg8::gemm_phase<pg8::EpiCmp, pg8::CmpOrder, false>(ring, 2048, 1024, S, E); \
      asm volatile("s_waitcnt vmcnt(0)" ::: "memory"); __syncthreads(); ph_cmp_fin2(p, cb); } \
    else ph_wprep_moe(p, GW - 32 * (NT / 64), ngw - 32 * (NT / 64), SCR); }
#define PHASE_6 { ph_attn(p, ldsb, shb); }
#define PHASE_7 { pg8::StaticOrder S; S.init(p.ws + WS_MIX, p.ws + WS_WOUT_T, DM, DM, T, DM, G, cb); pg8::EpiOutRes E{p.in[0], (bf16*)(p.ws + WS_X1), (const float*)(p.ws + WS_MOD)}; \
      pg8::gemm_phase<pg8::EpiOutRes, pg8::StaticOrder, false>(ring, DM, DM, S, E); }
#define PHASE_8 { ph_norm2_router(p, ldsb); }
#define PHASE_9 { pg8::StaticOrder S; S.init(p.ws + WS_XN, p.ws + WS_WR_T, DM, DM, T, 256, G, cb); pg8::EpiRouter E{(float*)(p.ws + WS_LOGITS)}; \
      pg8::gemm_phase<pg8::EpiRouter, pg8::StaticOrder, false>(ring, DM, DM, S, E); \
      { pg8::Unit u_; if (S.next(0, u_)) { asm volatile("s_waitcnt vmcnt(0)" ::: "memory"); __syncthreads(); ph_route<256>(p, u_.pm * 256, TIDV, (int*)shb); } } }
#define PHASE_11 { build_tile_base(p, (int*)shb); pg8::MoeOrder1 S{(const char*)(p.ws + WS_XN), (const char*)(p.ws + WS_W13_T), (const int*)(p.ws + WS_LISTS), cnt, (const int*)shb, G, cb}; pg8::EpiMoe1 E{(bf16*)(p.ws + WS_H)}; \
      pg8::gemm_phase<pg8::EpiMoe1, pg8::MoeOrder1, true>(ring, DM, DM, S, E); }
#define PHASE_12 { pg8::MoeOrder2 S{(const char*)(p.ws + WS_H), (const char*)(p.ws + WS_W2_T), (const int*)(p.ws + WS_LISTS), cnt, (const int*)shb, G, cb}; pg8::EpiMoe2 E{(bf16*)(p.ws + WS_XN), (bf16*)(p.ws + WS_Y1), (const float*)(p.ws + WS_MOD)}; \
      pg8::gemm_phase<pg8::EpiMoe2, pg8::MoeOrder2, false>(ring, 512, 512, S, E); }
#define PHASE_13 { ph_combine(p, GW, ngw); }
#ifndef PROBE_DUP
#define PROBE_DUP -1
#endif
#define RUN(k) { PHASE_##k GB(); if (PROBE_DUP == k) { PHASE_##k GB(); } }
    RUN(0) RUN(1) RUN(2) RUN(3) RUN(4) RUN(6) RUN(7) RUN(8)
    RUN(11)
    RUN(12)
    PHASE_13
}

extern "C" void kernel_launch(void* const* d_in, const int* in_sizes, int n_in, void* d_out, int out_size, void* d_ws, size_t ws_size, hipStream_t stream) {
    static int ready = 0;
    if (ready == 0) {
        if (n_in != 26 || ws_size < WS_END) { fprintf(stderr, "kernel_launch: bad args n_in=%d ws=%zu\n", n_in, ws_size); ready = -1; return; }
        if (hipFuncSetAttribute((const void*)mega, hipFuncAttributeMaxDynamicSharedMemorySize, LDS_BYTES) != hipSuccess) { fprintf(stderr, "kernel_launch: hipFuncSetAttribute failed\n"); ready = -1; return; }
        ready = 1;
    }
    if (ready < 0) return;
    P p{};
    for (int i = 0; i < 26; ++i) p.in[i] = (const float*)d_in[i];
    p.out = (float*)d_out; p.ws = (unsigned char*)d_ws;
    (void)hipMemsetAsync((char*)d_ws + WS_CTL, 0, 1 * MiB + 65536 + 2048, stream);
    hipLaunchKernelGGL(mega, dim3(256), dim3(NT), LDS_BYTES, stream, p);
}
```

```cpp
#include <hip/hip_runtime.h>
#include <stdint.h>
#include <stdio.h>

#ifndef PROBE_ATT
#define PROBE_ATT 0
#endif
#ifndef SW_REGION
#define SW_REGION 0
#endif
#define SW_BEGIN(r) do { if (SW_REGION == (r)) sw_t0 = __builtin_amdgcn_s_memrealtime(); } while (0)
#define SW_END(r) do { if (SW_REGION == (r)) { asm volatile("s_waitcnt vmcnt(0) lgkmcnt(0)" ::: "memory"); sw_acc += __builtin_amdgcn_s_memrealtime() - sw_t0; } } while (0)
#ifndef NAIVE_GEMM
#define NAIVE_GEMM 0
#endif

typedef unsigned short bf16;
typedef short bf16x8 __attribute__((ext_vector_type(8)));
typedef float f32x4 __attribute__((ext_vector_type(4)));
typedef unsigned u32x4 __attribute__((ext_vector_type(4)));
typedef unsigned u32x2 __attribute__((ext_vector_type(2)));

constexpr int BATCH = 2, SEQ = 16384, DM = 1024, T = BATCH * SEQ;
constexpr int NIN = 2840, NINP = 3072;
constexpr int NC = 1023, NCP = 1024, NS = 256;
constexpr int NEXP = 64;
constexpr float EPS = 1e-6f;

constexpr size_t MiB = 1u << 20;
constexpr size_t WS_CTL = 0;
constexpr size_t WS_MOD = 1 * MiB;
constexpr size_t WS_POSB = 1 * MiB + 65536;
constexpr size_t WS_WIN_T = 2 * MiB;
constexpr size_t WS_WOUT_T = 8 * MiB;
constexpr size_t WS_CW1_T = 10 * MiB;
constexpr size_t WS_WR_T = 12 * MiB;
constexpr size_t WS_CW2_T = 12 * MiB + 524288;
constexpr size_t WS_HID = 13 * MiB;
constexpr size_t WS_KCVC = 21 * MiB;
constexpr size_t WS_GATES = 22 * MiB;
constexpr size_t WS_LOGITS = 25 * MiB;
constexpr size_t WS_LISTS = 41 * MiB;
constexpr size_t WS_ROWW = 57 * MiB;
constexpr size_t WS_XN = 73 * MiB;
constexpr size_t WS_R1 = 137 * MiB;
constexpr size_t WS_W13_T = WS_R1;
constexpr size_t WS_W2_T = WS_R1 + 128 * MiB;
constexpr size_t WS_Q = 329 * MiB;
constexpr size_t WS_KV = 361 * MiB;
constexpr size_t WS_H = 329 * MiB;
constexpr size_t WS_MIX = 418 * MiB;
constexpr size_t WS_Y1 = 425 * MiB;
constexpr size_t WS_X1 = 489 * MiB;
constexpr size_t WS_END = 553 * MiB;

constexpr int CW_CNT = 0;

struct P {
    const float* in[26];
    float* out;
    unsigned char* ws;
};

__device__ __forceinline__ unsigned f2bf(float f) { unsigned u = __builtin_bit_cast(unsigned, f); return (u + 0x7fffu + ((u >> 16) & 1u)) >> 16; }
__device__ __forceinline__ unsigned pk2(float lo, float hi) { return f2bf(lo) | (f2bf(hi) << 16); }
__device__ __forceinline__ float bf2f(unsigned short h) { return __builtin_bit_cast(float, (unsigned)h << 16); }
__device__ __forceinline__ float bflo(unsigned u) { return __builtin_bit_cast(float, u << 16); }
__device__ __forceinline__ float bfhi(unsigned u) { return __builtin_bit_cast(float, u & 0xffff0000u); }
#define DPPF(x, ctrl) __builtin_bit_cast(float, __builtin_amdgcn_update_dpp(0, __builtin_bit_cast(int, (x)), (ctrl), 0xF, 0xF, false))
__device__ __forceinline__ float add_xor1(float x) { return x + DPPF(x, 0xB1); }
__device__ __forceinline__ float add_xor2(float x) { return x + DPPF(x, 0x4E); }
__device__ __forceinline__ void swap32(float& a, float& b) { asm volatile("s_nop 1\n\tv_permlane32_swap_b32 %0, %1" : "+v"(a), "+v"(b)); }
__device__ __forceinline__ void swap16(float& a, float& b) { asm volatile("s_nop 1\n\tv_permlane16_swap_b32 %0, %1" : "+v"(a), "+v"(b)); }
__device__ __forceinline__ float sum_halves(float x) { float a = x, b = x; swap32(a, b); return a + b; }
__device__ __forceinline__ float other_half(float x, int h) { float a = x, b = x; swap32(a, b); return h ? a : b; }
__device__ __forceinline__ float sum_rows(float x) { float a = x, b = x; swap16(a, b); return sum_halves(a + b); }
__device__ __forceinline__ float max_rows(float x) { float a = x, b = x; swap16(a, b); x = fmaxf(a, b); a = x; b = x; swap32(a, b); return fmaxf(a, b); }
__device__ __forceinline__ float wave_sum(float v) {
    v = add_xor1(v); v = add_xor2(v); v += DPPF(v, 0x141); v += DPPF(v, 0x140);
    return sum_rows(v);
}
__device__ __forceinline__ float silu_f(float v) { return v * __builtin_amdgcn_rcpf(1.f + __expf(-v)); }
#define LDS_FENCE() asm volatile("s_waitcnt lgkmcnt(0)" ::: "memory")
__device__ __forceinline__ int opq_tid() { int t = threadIdx.x; asm volatile("" : "+v"(t)); return t; }

template <class AR, class BR, class EPI>
__device__ __forceinline__ void wave_gemm_64x64(AR arow, BR brow, int K, EPI epi) {
    const int lane = threadIdx.x & 63, fr = lane & 15, fq = lane >> 4;
#if !NAIVE_GEMM
    const bf16* ap[4]; const bf16* bp[4];
#pragma unroll
    for (int i = 0; i < 4; ++i) { ap[i] = arow(16 * i + fr) + fq * 8; bp[i] = brow(16 * i + fr) + fq * 8; }
    f32x4 acc[4][4];
#pragma unroll
    for (int i = 0; i < 4; ++i)
#pragma unroll
        for (int j = 0; j < 4; ++j) acc[i][j] = (f32x4){0.f, 0.f, 0.f, 0.f};
#pragma unroll 1
    for (int k = 0; k < K; k += 64) {
        bf16x8 a[4][2], b[4][2];
#pragma unroll
        for (int i = 0; i < 4; ++i) {
            a[i][0] = *(const bf16x8*)(ap[i] + k); a[i][1] = *(const bf16x8*)(ap[i] + k + 32);
            b[i][0] = *(const bf16x8*)(bp[i] + k); b[i][1] = *(const bf16x8*)(bp[i] + k + 32);
        }
#pragma unroll
        for (int kk = 0; kk < 2; ++kk)
#pragma unroll
            for (int i = 0; i < 4; ++i)
#pragma unroll
                for (int j = 0; j < 4; ++j) acc[i][j] = __builtin_amdgcn_mfma_f32_16x16x32_bf16(b[j][kk], a[i][kk], acc[i][j], 0, 0, 0);
    }
#pragma unroll
    for (int i = 0; i < 4; ++i)
#pragma unroll
        for (int j = 0; j < 4; ++j) { epi(16 * i + fr, 16 * j + 4 * fq, acc[i][j]); asm volatile("" ::: "memory"); }
#else
    for (int i = 0; i < 4; ++i) {
        const bf16* ar = arow(16 * i + fr);
        for (int j = 0; j < 4; ++j) {
            f32x4 acc = (f32x4){0.f, 0.f, 0.f, 0.f};
#pragma unroll
            for (int r = 0; r < 4; ++r) {
                const bf16* br = brow(16 * j + 4 * fq + r);
                float s = 0.f;
                for (int k = 0; k < K; k += 8) {
                    u32x4 av = *(const u32x4*)(ar + k), bv = *(const u32x4*)(br + k);
#pragma unroll
                    for (int q = 0; q < 4; ++q) { s += bflo(av[q]) * bflo(bv[q]); s += bfhi(av[q]) * bfhi(bv[q]); }
                }
                acc[r] = s;
            }
            epi(16 * i + fr, 16 * j + 4 * fq, acc);
        }
    }
#endif
}

__device__ __forceinline__ void transpose_item(const float* W, int K, int N, bf16* WT, int rmul, int radd, float* scr, int item, int lane) {
    const int nblk = (N + 31) / 32, kb = item / nblk, nb = item % nblk, k0 = 64 * kb, n0 = 32 * nb;
    {
        const int n4 = (lane & 7) * 4; f32x4 v[8];
#pragma unroll
        for (int i = 0; i < 8; ++i) { const int kk = 8 * i + (lane >> 3); v[i] = (n0 + n4 < N) ? __builtin_nontemporal_load((const f32x4*)(W + (size_t)(k0 + kk) * N + n0 + n4)) : (f32x4){0.f, 0.f, 0.f, 0.f}; }
#pragma unroll
        for (int i = 0; i < 8; ++i) { const int kk = 8 * i + (lane >> 3); float* d = scr + kk * 33 + n4; d[0] = v[i].x; d[1] = v[i].y; d[2] = v[i].z; d[3] = v[i].w; }
    }
    LDS_FENCE();
    const int c = lane & 7;
#pragma unroll
    for (int j = 0; j < 4; ++j) { const int n = (lane >> 3) + 8 * j; const float* s = scr + (8 * c) * 33 + n;
        u32x4 o; o.x = pk2(s[0 * 33], s[1 * 33]); o.y = pk2(s[2 * 33], s[3 * 33]); o.z = pk2(s[4 * 33], s[5 * 33]); o.w = pk2(s[6 * 33], s[7 * 33]);
        if (n0 + n < N) __builtin_nontemporal_store(o, (u32x4*)(WT + (size_t)(radd + rmul * (n0 + n)) * K + k0 + 8 * c)); }
    LDS_FENCE();
}

namespace pg8 {
#define PG8_LAS __attribute__((address_space(3)))
constexpr int BM = 256, BK = 64, HALF = 128, HTB = HALF * BK * 2, STAGE_BYTES = 8 * HTB, NXCD = 8, WGM = 4;
__host__ __device__ __forceinline__ int lds_byte(int r, int c) { const int st = (r >> 4) * 2 + (c >> 5), rr = r & 15, cc = c & 31, ob = rr * 64 + cc * 2; return st * 1024 + (ob ^ (((ob >> 9) & 1) << 5)); }
__host__ __device__ __forceinline__ void stage_rc(int b, int& R, int& C) { const int st = b / 1024, sb = b % 1024, swz = sb ^ (((sb >> 9) & 1) << 5); R = (st >> 1) * 16 + swz / 64; C = (st & 1) * 32 + (swz % 64) / 2; }
__host__ __device__ __forceinline__ int perm32(int rho) { const int n = rho >> 4, i = rho & 15; return 8 * (i >> 2) + 4 * n + (i & 3); }

struct Unit { const char* A; const char* B; const int* list; int r0, nrows; int pm, pn, aux; };

struct StaticOrder {
    const char* A; const char* B; int lda, K; int nM, nN, nwg, G, c;
    __device__ __forceinline__ void init(const void* A_, const void* B_, int lda_, int K_, int M, int N, int G_, int c_) { A = (const char*)A_; B = (const char*)B_; lda = lda_; K = K_; nM = M / BM; nN = N / BM; nwg = nM * nN; G = G_; c = c_; }
    __device__ __forceinline__ bool next(int i, Unit& u) const {
        const long L = (long)i * G + c; if (L >= nwg) return false;
        int wgid = (int)L; { const int q = nwg / NXCD, r = nwg % NXCD, xcd = wgid % NXCD, off = wgid / NXCD; wgid = (xcd < r ? xcd * (q + 1) : r * (q + 1) + (xcd - r) * q) + off; }
        const int nig = WGM * nN, gid = wgid / nig, fm = gid * WGM, gsz = (nM - fm) < WGM ? (nM - fm) : WGM;
        u.pm = fm + ((wgid % nig) % gsz); u.pn = (wgid % nig) / gsz;
        u.A = A + (size_t)u.pm * BM * lda * 2; u.B = B + (size_t)u.pn * BM * K * 2; u.list = nullptr; u.r0 = 0; u.nrows = BM; u.aux = i; return true;
    }
};

__device__ __forceinline__ unsigned cvt_pk_bf16(float lo, float hi) { unsigned r; asm volatile("v_cvt_pk_bf16_f32 %0, %1, %2" : "=v"(r) : "v"(lo), "v"(hi)); return r; }

template <class Epi, class Sched, bool GATHER, bool ALIGN_EPI = true>
__device__ __forceinline__ void gemm_phase(PG8_LAS unsigned char* lds, const int K, const int lda, const Sched& S, const Epi& E) {
    const int tid = opq_tid(), wid = __builtin_amdgcn_readfirstlane(tid >> 6), lane = tid & 63, wr = wid >> 2, wc = wid & 3, fr = lane & 15, fq = lane >> 4;
    const int nt = K / BK;
    int RA[2], CA[2]; unsigned voffA[2], voffB[2];
#pragma unroll
    for (int i = 0; i < 2; ++i) { int R, C; stage_rc(tid * 16 + i * 8192, R, C); const int Rb = Epi::PERM ? ((R & ~31) + perm32(R & 31)) : R;
        RA[i] = R; CA[i] = C; voffA[i] = (unsigned)(R * lda + C) * 2u; voffB[i] = (unsigned)(Rb * K + C) * 2u; }
    const size_t kstep = (size_t)(BK * 2);
    const size_t hstepA = (size_t)HALF * lda * 2, hstepB = (size_t)HALF * K * 2;
    const unsigned ldsw = (unsigned)wid * 1024u;
    const int aoff = lds_byte(wr * 64 + fr, fq * 8), boff = lds_byte(wc * 32 + fr, fq * 8);
    unsigned offC[2][2], offN[2][2];
#define PG8_SA(b, h) (((b) * 2 + (h)) * HTB)
#define PG8_SB(b, h) ((4 + (b) * 2 + (h)) * HTB)
#define PG8_GL(ptr, bufoff, i_) __builtin_amdgcn_global_load_lds((const unsigned*)(ptr), (PG8_LAS unsigned*)(lds + (bufoff) + ldsw + (i_) * 8192), 16, 0, 0)
#define PG8_STAGE_B(bufoff, gbase) do { _Pragma("unroll") for (int _i = 0; _i < 2; ++_i) PG8_GL((const char*)(gbase) + voffB[_i], bufoff, _i); } while (0)
#define PG8_STAGE_A(bufoff, h, kb, NX) do { const char* _b = (NX) ? nA : cA; _Pragma("unroll") for (int _i = 0; _i < 2; ++_i) { \
        if constexpr (GATHER) { if (NX) PG8_GL(_b + (kb) + offN[h][_i], bufoff, _i); else PG8_GL(_b + (kb) + offC[h][_i], bufoff, _i); } \
        else PG8_GL(_b + (kb) + (h) * hstepA + voffA[_i], bufoff, _i); } } while (0)
#define PG8_LDA(dst, b, h) do { _Pragma("unroll") for (int m = 0; m < 4; ++m) _Pragma("unroll") for (int k = 0; k < 2; ++k) dst[m][k] = *(const PG8_LAS bf16x8*)(lds + PG8_SA(b, h) + aoff + m * 2048 + k * 1024); } while (0)
#define PG8_LDB(dst, b, h) do { _Pragma("unroll") for (int n = 0; n < 2; ++n) _Pragma("unroll") for (int k = 0; k < 2; ++k) dst[n][k] = *(const PG8_LAS bf16x8*)(lds + PG8_SB(b, h) + boff + n * 2048 + k * 1024); } while (0)
#define PG8_MMA(ai, bj, At, Bt) do { __builtin_amdgcn_s_setprio(1); _Pragma("unroll") for (int m = 0; m < 4; ++m) _Pragma("unroll") for (int n = 0; n < 2; ++n) _Pragma("unroll") for (int k = 0; k < 2; ++k) \
        acc[ai][bj][m][n] = __builtin_amdgcn_mfma_f32_16x16x32_bf16(Bt[n][k], At[m][k], acc[ai][bj][m][n], 0, 0, 0); __builtin_amdgcn_s_setprio(0); } while (0)
#define PG8_WAIT_V(n) asm volatile("s_waitcnt vmcnt(" #n ")" ::: "memory")
#define PG8_WAIT_L(n) asm volatile("s_waitcnt lgkmcnt(" #n ")" ::: "memory")
#define PG8_BAR __builtin_amdgcn_s_barrier()
#define PG8_SCHED __builtin_amdgcn_sched_barrier(0)
#define PG8_GOFF(dst, u) do { if constexpr (GATHER) { _Pragma("unroll") for (int _h = 0; _h < 2; ++_h) _Pragma("unroll") for (int _i = 0; _i < 2; ++_i) { \
        int _r = (u).r0 + _h * HALF + RA[_i]; _r = _r < (u).nrows ? _r : (u).nrows - 1; dst[_h][_i] = (unsigned)(((u).list[_r] & 0x7fffffff) * lda + CA[_i]) * 2u; } } } while (0)
    Unit cur, nxt; int ui = 0;
    if (!S.next(0, cur)) return;
    f32x4 acc[2][2][4][2];
#pragma unroll
    for (int a = 0; a < 2; ++a)
#pragma unroll
        for (int b = 0; b < 2; ++b)
#pragma unroll
            for (int m = 0; m < 4; ++m)
#pragma unroll
                for (int n = 0; n < 2; ++n) acc[a][b][m][n] = (f32x4){0.f, 0.f, 0.f, 0.f};
    bf16x8 At[4][2], B0[2][2], B1[2][2];
    const char* cA = cur.A; const char* cB = cur.B; const char* nA = cA; const char* nB = cB;
    PG8_GOFF(offC, cur); PG8_GOFF(offN, cur);
    PG8_STAGE_B(PG8_SB(0, 0), cB); PG8_STAGE_B(PG8_SB(0, 1), cB + hstepB); PG8_STAGE_A(PG8_SA(0, 0), 0, 0, false); PG8_STAGE_A(PG8_SA(0, 1), 1, 0, false);
    if (wr == 1) PG8_BAR;
    PG8_WAIT_V(2); PG8_BAR;
    PG8_STAGE_B(PG8_SB(1, 0), cB + kstep); PG8_STAGE_A(PG8_SA(1, 0), 0, kstep, false); PG8_STAGE_B(PG8_SB(1, 1), cB + hstepB + kstep);
    PG8_WAIT_V(6); PG8_BAR;
    for (;;) {
        const bool has_next = S.next(ui + 1, nxt);
        nA = has_next ? nxt.A : cA; nB = has_next ? nxt.B : cB;
        if (has_next) PG8_GOFF(offN, nxt); else { if constexpr (GATHER) { _Pragma("unroll") for (int _h = 0; _h < 2; ++_h) _Pragma("unroll") for (int _i = 0; _i < 2; ++_i) offN[_h][_i] = offC[_h][_i]; } }
        for (int t = 0; t < nt; t += 2) {
            const bool last = (t == nt - 2);
            const size_t k1 = (size_t)(t + 1) * kstep;
            const size_t k2 = last ? 0 : (size_t)(t + 2) * kstep, k3 = k2 + kstep;
            const char* b2 = last ? nB : cB + (size_t)(t + 2) * kstep; const char* b3 = b2 + kstep;
            PG8_LDB(B0, 0, 0); PG8_LDB(B1, 0, 1); PG8_SCHED; PG8_LDA(At, 0, 0); PG8_STAGE_A(PG8_SA(1, 1), 1, k1, false);
            PG8_WAIT_V(8); PG8_WAIT_L(0); PG8_BAR; PG8_MMA(0, 0, At, B0); PG8_MMA(0, 1, At, B1); PG8_BAR; PG8_SCHED;
            PG8_LDA(At, 0, 1); PG8_STAGE_B(PG8_SB(0, 0), b2); PG8_STAGE_B(PG8_SB(0, 1), b2 + hstepB); PG8_STAGE_A(PG8_SA(0, 0), 0, k2, last);
            PG8_WAIT_V(8); PG8_WAIT_L(0); PG8_BAR; PG8_MMA(1, 0, At, B0); PG8_MMA(1, 1, At, B1); PG8_BAR; PG8_SCHED;
            PG8_LDB(B0, 1, 0); PG8_LDB(B1, 1, 1); PG8_SCHED; PG8_LDA(At, 1, 0); PG8_STAGE_A(PG8_SA(0, 1), 1, k2, last);
            PG8_WAIT_V(8); PG8_WAIT_L(0); PG8_BAR; PG8_MMA(0, 0, At, B0); PG8_MMA(0, 1, At, B1); PG8_BAR; PG8_SCHED;
            PG8_LDA(At, 1, 1); PG8_STAGE_B(PG8_SB(1, 0), b3); PG8_STAGE_B(PG8_SB(1, 1), b3 + hstepB); PG8_STAGE_A(PG8_SA(1, 0), 0, k3, last);
            PG8_WAIT_V(8); PG8_WAIT_L(0); PG8_BAR; PG8_MMA(1, 0, At, B0); PG8_MMA(1, 1, At, B1); PG8_BAR; PG8_SCHED;
        }
        if constexpr (ALIGN_EPI) { if (wr == 0) PG8_BAR; }
        E(acc, cur, wr, wc, fr, fq);
        if (!has_next) break;
#pragma unroll
        for (int a = 0; a < 2; ++a)
#pragma unroll
            for (int b = 0; b < 2; ++b)
#pragma unroll
                for (int m = 0; m < 4; ++m)
#pragma unroll
                    for (int n = 0; n < 2; ++n) acc[a][b][m][n] = (f32x4){0.f, 0.f, 0.f, 0.f};
        cur = nxt; cA = nA; cB = nB; ++ui;
        if constexpr (GATHER) { _Pragma("unroll") for (int _h = 0; _h < 2; ++_h) _Pragma("unroll") for (int _i = 0; _i < 2; ++_i) offC[_h][_i] = offN[_h][_i]; }
        if constexpr (ALIGN_EPI) { if (wr == 1) PG8_BAR; }
    }
    PG8_WAIT_V(0);
    if constexpr (!ALIGN_EPI) { if (wr == 0) PG8_BAR; }
    PG8_BAR;
#undef PG8_SA
#undef PG8_SB
#undef PG8_GL
#undef PG8_STAGE_A
#undef PG8_STAGE_B
#undef PG8_LDA
#undef PG8_LDB
#undef PG8_MMA
#undef PG8_WAIT_V
#undef PG8_WAIT_L
#undef PG8_BAR
#undef PG8_SCHED
#undef PG8_GOFF
}
struct EpiRaw {
    static constexpr bool PERM = true; bf16* O; int ldc;
    __device__ __forceinline__ void operator()(const f32x4 (&acc)[2][2][4][2], const Unit& u, int wr, int wc, int fr, int fq) const {
#pragma unroll
        for (int ai = 0; ai < 2; ++ai)
#pragma unroll
            for (int m = 0; m < 4; ++m) { bf16* rowp = O + (size_t)(u.pm * BM + ai * HALF + wr * 64 + m * 16 + fr) * ldc + u.pn * BM + wc * 32 + 8 * fq;
#pragma unroll
                for (int bj = 0; bj < 2; ++bj) { const f32x4 v0 = acc[ai][bj][m][0], v1 = acc[ai][bj][m][1];
                    u32x4 w; w.x = cvt_pk_bf16(v0[0], v0[1]); w.y = cvt_pk_bf16(v0[2], v0[3]); w.z = cvt_pk_bf16(v1[0], v1[1]); w.w = cvt_pk_bf16(v1[2], v1[3]);
                    if (u.aux >= 5) __builtin_nontemporal_store(w, (u32x4*)(rowp + bj * HALF)); else *(u32x4*)(rowp + bj * HALF) = w; } }
    }
};
struct EpiOutRes {
    static constexpr bool PERM = true; const float* x; bf16* x1; const float* mod;
    __device__ __forceinline__ void operator()(const f32x4 (&acc)[2][2][4][2], const Unit& u, int wr, int wc, int fr, int fq) const {
        const int b = (u.pm * BM) / SEQ; const int col0 = u.pn * BM + wc * 32 + 8 * fq;
        f32x4 g[2][2];
#pragma unroll
        for (int bj = 0; bj < 2; ++bj)
#pragma unroll
            for (int n = 0; n < 2; ++n) g[bj][n] = *(const f32x4*)(mod + b * 6144 + 2048 + col0 + bj * HALF + n * 4);
#pragma unroll
        for (int ai = 0; ai < 2; ++ai) {
            f32x4 xr[4][2][2];
#pragma unroll
            for (int m = 0; m < 4; ++m) { const size_t off = (size_t)(u.pm * BM + ai * HALF + wr * 64 + m * 16 + fr) * DM + col0;
#pragma unroll
                for (int bj = 0; bj < 2; ++bj) { xr[m][bj][0] = *(const f32x4*)(x + off + bj * HALF); xr[m][bj][1] = *(const f32x4*)(x + off + bj * HALF + 4); } }
            asm volatile("" ::: "memory");
#pragma unroll
            for (int m = 0; m < 4; ++m) { const size_t off = (size_t)(u.pm * BM + ai * HALF + wr * 64 + m * 16 + fr) * DM + col0;
#pragma unroll
                for (int bj = 0; bj < 2; ++bj) { const f32x4 v0 = xr[m][bj][0] + g[bj][0] * acc[ai][bj][m][0], v1 = xr[m][bj][1] + g[bj][1] * acc[ai][bj][m][1];
                    *(u32x4*)(x1 + off + bj * HALF) = (u32x4){cvt_pk_bf16(v0[0], v0[1]), cvt_pk_bf16(v0[2], v0[3]), cvt_pk_bf16(v1[0], v1[1]), cvt_pk_bf16(v1[2], v1[3])}; } }
            asm volatile("" ::: "memory"); }
    }
};
struct EpiRouter {
    static constexpr bool PERM = false; float* LG;
    __device__ __forceinline__ void operator()(const f32x4 (&acc)[2][2][4][2], const Unit& u, int wr, int wc, int fr, int fq) const {
#pragma unroll
        for (int ai = 0; ai < 2; ++ai)
#pragma unroll
            for (int m = 0; m < 4; ++m)
#pragma unroll
                for (int n = 0; n < 2; ++n) *(f32x4*)(LG + (size_t)(u.pm * BM + ai * HALF + wr * 64 + m * 16 + fr) * 128 + wc * 32 + n * 16 + 4 * fq) = acc[ai][0][m][n];
    }
};
struct EpiCmp {
    static constexpr bool PERM = true; bf16* HID; const float* posb;
    __device__ __forceinline__ void operator()(const f32x4 (&acc)[2][2][4][2], const Unit& u, int wr, int wc, int fr, int fq) const {
        const int kv = u.pm >= 16 ? 1 : 0; const int col0 = wc * 32 + 8 * fq;
#pragma unroll
        for (int bj = 0; bj < 2; ++bj) { const f32x4 pb0 = *(const f32x4*)(posb + kv * 256 + col0 + bj * HALF), pb1 = *(const f32x4*)(posb + kv * 256 + col0 + bj * HALF + 4);
#pragma unroll
            for (int ai = 0; ai < 2; ++ai)
#pragma unroll
                for (int m = 0; m < 4; ++m) { const f32x4 v0 = acc[ai][bj][m][0] + pb0, v1 = acc[ai][bj][m][1] + pb1;
                    *(u32x4*)(HID + (size_t)(u.pm * BM + ai * HALF + wr * 64 + m * 16 + fr) * 256 + col0 + bj * HALF) =
                        (u32x4){cvt_pk_bf16(silu_f(v0[0]), silu_f(v0[1])), cvt_pk_bf16(silu_f(v0[2]), silu_f(v0[3])), cvt_pk_bf16(silu_f(v1[0]), silu_f(v1[1])), cvt_pk_bf16(silu_f(v1[2]), silu_f(v1[3]))}; } }
    }
};
struct EpiMoe1 {
    static constexpr bool PERM = true; bf16* H;
    __device__ __forceinline__ void operator()(const f32x4 (&acc)[2][2][4][2], const Unit& u, int wr, int wc, int fr, int fq) const {
#pragma unroll
        for (int ai = 0; ai < 2; ++ai)
#pragma unroll
            for (int m = 0; m < 4; ++m) { bf16* rowp = H + (size_t)(u.aux + ai * HALF + wr * 64 + m * 16 + fr) * 512 + ((u.pn * BM + wc * 32 + 8 * fq) >> 1);
#pragma unroll
                for (int bj = 0; bj < 2; ++bj) { const f32x4 v0 = acc[ai][bj][m][0], v1 = acc[ai][bj][m][1];
                    u32x2 w; w.x = cvt_pk_bf16(silu_f(v0[0]) * v0[1], silu_f(v0[2]) * v0[3]); w.y = cvt_pk_bf16(silu_f(v1[0]) * v1[1], silu_f(v1[2]) * v1[3]);
                    *(u32x2*)(rowp + bj * (HALF / 2)) = w; } }
    }
};
struct EpiMoe2 {
    static constexpr bool PERM = true; bf16* Y0; bf16* Y1; const float* mod;
    __device__ __forceinline__ void operator()(const f32x4 (&acc)[2][2][4][2], const Unit& u, int wr, int wc, int fr, int fq) const {
        const int col0 = u.pn * BM + wc * 32 + 8 * fq; const float* roww = (const float*)((const char*)u.list + (WS_ROWW - WS_LISTS));
        int tok[2][4]; float wgt[2][4];
#pragma unroll
        for (int ai = 0; ai < 2; ++ai)
#pragma unroll
            for (int m = 0; m < 4; ++m) { const int r = u.r0 + ai * HALF + wr * 64 + m * 16 + fr; const bool ok = r < u.nrows; tok[ai][m] = ok ? u.list[r] : -1; wgt[ai][m] = ok ? roww[r] : 0.f; }
#pragma unroll
        for (int ai = 0; ai < 2; ++ai)
#pragma unroll
            for (int m = 0; m < 4; ++m) { if (tok[ai][m] != -1) { const int tk = tok[ai][m] & 0x7fffffff; bf16* o = (tok[ai][m] < 0 ? Y1 : Y0) + (size_t)tk * DM + col0; const float w = wgt[ai][m];
#pragma unroll
                    for (int bj = 0; bj < 2; ++bj) { const f32x4 v0 = acc[ai][bj][m][0] * w, v1 = acc[ai][bj][m][1] * w;
                        *(u32x4*)(o + bj * HALF) = (u32x4){cvt_pk_bf16(v0[0], v0[1]), cvt_pk_bf16(v0[2], v0[3]), cvt_pk_bf16(v1[0], v1[1]), cvt_pk_bf16(v1[2], v1[3])}; } } }
    }
};
__device__ __forceinline__ int xcd_remap(int L, int total) { const int q = total / NXCD, r = total % NXCD, xcd = L % NXCD, off = L / NXCD; return (xcd < r ? xcd * (q + 1) : r * (q + 1) + (xcd - r) * q) + off; }
__device__ __forceinline__ int find_list(const int* tb, int R, int lo, int hi) { while (hi - lo > 1) { const int mid = (lo + hi) >> 1; if (tb[mid] <= R) lo = mid; else hi = mid; } return lo; }
struct CmpOrder {
    const char* A; const char* B; int c;
    __device__ __forceinline__ bool next(int i, Unit& u) const { if (i > 0 || c >= 32) return false; u.pm = c; u.pn = 0; u.A = A + (size_t)c * BM * 1024 * 2; u.B = B + (size_t)(c >= 16 ? 1 : 0) * 256 * 2048 * 2; u.list = nullptr; u.r0 = 0; u.nrows = BM; u.aux = 0; return true; }
};
struct MoeOrder1 {
    const char* XNb; const char* W13; const int* LISTS; const unsigned* cnt; const int* tb; int G, c;
    __device__ __forceinline__ bool next(int i, Unit& u) const {
        const int total = tb[64] * 4; const long L0 = (long)i * G + c; if (L0 >= total) return false;
        const int L = xcd_remap((int)L0, total); const int R = L >> 2, pn = L & 3, idx = find_list(tb, R, 0, 64), e = idx;
        u.pm = R; u.pn = pn; u.A = XNb; u.B = W13 + ((size_t)e * 1024 + pn * BM) * 1024 * 2; u.list = LISTS + (size_t)idx * T; u.r0 = (R - tb[idx]) * BM; u.nrows = (int)cnt[idx * 16]; u.aux = R * BM; return true;
    }
};
struct MoeOrder2 {
    const char* Hb; const char* W2T; const int* LISTS; const unsigned* cnt; const int* tb; int G, c;
    __device__ __forceinline__ bool next(int i, Unit& u) const {
        const int total = tb[64] * 4; const long L0 = (long)i * G + c; if (L0 >= total) return false;
        const int L = xcd_remap((int)L0, total); const int R = L >> 2, pn = L & 3, idx = find_list(tb, R, 0, 64), e = idx;
        u.pm = R; u.pn = pn; u.A = Hb + (size_t)R * BM * 512 * 2; u.B = W2T + ((size_t)e * 1024 + pn * BM) * 512 * 2; u.list = LISTS + (size_t)idx * T; u.r0 = (R - tb[idx]) * BM; u.nrows = (int)cnt[idx * 16]; u.aux = 0; return true;
    }
};
}


__device__ __forceinline__ void ph_mod(const P& p, int blk, int nblk, float* shb) {
    const float* c = p.in[1]; const float* w_ada = p.in[2]; const float* b_ada = p.in[3];
    float* mod = (float*)(p.ws + WS_MOD);
    const int tid = opq_tid(), wave = tid >> 6, lane = tid & 63, nw = blockDim.x >> 6;
    for (int task = blk; task < 192; task += nblk) {
        const int cg = task % 96, kh = task / 96, col = cg * 64 + lane;
        float a0 = 0.f, a1 = 0.f;
        constexpr int kper = 64; const int kb = kh * 512 + wave * kper;
#pragma unroll
        for (int hb = 0; hb < 2; ++hb) { float wv[32];
#pragma unroll
            for (int k = 0; k < 32; ++k) wv[k] = __builtin_nontemporal_load(w_ada + (size_t)(kb + 32 * hb + k) * 6144 + col);
#pragma unroll
            for (int k = 0; k < 32; ++k) { a0 += silu_f(c[kb + 32 * hb + k]) * wv[k]; a1 += silu_f(c[1024 + kb + 32 * hb + k]) * wv[k]; } }
        shb[(wave * 2 + 0) * 64 + lane] = a0; shb[(wave * 2 + 1) * 64 + lane] = a1;
        __syncthreads();
        if (wave < 2) { float s = 0.f; for (int w = 0; w < nw; ++w) s += shb[(w * 2 + wave) * 64 + lane]; atomicAdd(&mod[wave * 6144 + col], s + (kh == 0 ? b_ada[col] : 0.f)); }
        __syncthreads();
    }
}
__device__ __forceinline__ void ph_posb(const P& p, int task, float* shb) {
    const int tid = opq_tid(), wave = tid >> 6, lane = tid & 63;
    float* posb = (float*)(p.ws + WS_POSB);
    const int kv = task >> 5, cg = (task >> 3) & 3, kc = task & 7, col = cg * 64 + lane;
    const float* pos = kv == 0 ? p.in[8] : p.in[9]; const float* w1 = kv == 0 ? p.in[10] : p.in[12];
    float a = 0.f; const int kb = kc * 256 + wave * 32;
#pragma unroll 8
    for (int k = kb; k < kb + 32; ++k) a += pos[k] * w1[(size_t)k * 256 + col];
    shb[wave * 64 + lane] = a;
    __syncthreads();
    if (wave == 0) { float s2 = 0.f; for (int w = 0; w < 8; ++w) s2 += shb[w * 64 + lane]; atomicAdd(&posb[kv * 256 + col], s2); }
    __syncthreads();
}

__device__ __forceinline__ void ph_wprep_a(const P& p, int gw, int ngw, float* scr) {
    const int lane = opq_tid() & 63;
    bf16* WIN_T = (bf16*)(p.ws + WS_WIN_T); bf16* WOUT_T = (bf16*)(p.ws + WS_WOUT_T); bf16* CW1_T = (bf16*)(p.ws + WS_CW1_T); bf16* WR_T = (bf16*)(p.ws + WS_WR_T);
    constexpr int I_IN = (1024 / 64) * 89, I_OUT = 16 * 32, I_C = (2048 / 64) * 8;
    for (int it = gw; it < I_IN + I_OUT + 2 * I_C; it += ngw) {
        int r = it;
        if (r < I_IN) { transpose_item(p.in[5], 1024, NIN, WIN_T, 1, 0, scr, r, lane); continue; } r -= I_IN;
        if (r < I_OUT) { transpose_item(p.in[16], 1024, 1024, WOUT_T, 1, 0, scr, r, lane); continue; } r -= I_OUT;
        if (r < I_C) { transpose_item(p.in[10], 2048, 256, CW1_T, 1, 0, scr, r, lane); continue; } r -= I_C;
        transpose_item(p.in[12], 2048, 256, CW1_T + 256 * 2048, 1, 0, scr, r, lane);
    }
    for (int i = gw * 64 + lane; i < 232 * 1024 / 8; i += ngw * 64) *(u32x4*)(WIN_T + (size_t)2840 * 1024 + (size_t)i * 8) = (u32x4){0u, 0u, 0u, 0u};
    for (int i = gw * 64 + lane; i < 184 * 1024 / 8; i += ngw * 64) *(u32x4*)(WR_T + (size_t)72 * 1024 + (size_t)i * 8) = (u32x4){0u, 0u, 0u, 0u};
    for (int it = gw; it < 48; it += ngw) { if (it < 16) transpose_item(p.in[19], 1024, 8, WR_T, 1, 0, scr, it, lane); else transpose_item(p.in[21], 1024, 64, WR_T, 1, 8, scr, it - 16, lane); }
    { bf16* CW2T = (bf16*)(p.ws + WS_CW2_T);
      for (int i = gw * 64 + lane; i < 2 * 64 * 256; i += ngw * 64) { const int kv = i >> 14, d = (i >> 8) & 63, j = i & 255; const float* w2_ = kv == 0 ? p.in[11] : p.in[13]; CW2T[i] = (bf16)f2bf(w2_[j * 64 + d]); } }
}
__device__ __forceinline__ void ph_wprep_moe(const P& p, int gw, int ngw, float* scr) {
    const int lane = opq_tid() & 63;
    bf16* W13 = (bf16*)(p.ws + WS_W13_T); bf16* W2T = (bf16*)(p.ws + WS_W2_T);
    constexpr int I_13 = (1024 / 64) * (512 / 32), I_2 = (512 / 64) * (1024 / 32);
    for (int it = gw; it < NEXP * (2 * I_13 + I_2); it += ngw) {
        const int e = it / (2 * I_13 + I_2); int r = it % (2 * I_13 + I_2);
        if (r < I_13) { transpose_item(p.in[23] + (size_t)e * 1024 * 512, 1024, 512, W13 + (size_t)e * 1024 * 1024, 2, 0, scr, r, lane); continue; } r -= I_13;
        if (r < I_13) { transpose_item(p.in[24] + (size_t)e * 1024 * 512, 1024, 512, W13 + (size_t)e * 1024 * 1024, 2, 1, scr, r, lane); continue; } r -= I_13;
        transpose_item(p.in[25] + (size_t)e * 512 * 1024, 512, 1024, W2T + (size_t)e * 1024 * 512, 1, 0, scr, r, lane);
    }
}

template <bool SRC_BF16>
__device__ __forceinline__ void ph_rownorm(const P& p, int gw, int ngw, const void* src_, int which) {
    const int lane = opq_tid() & 63;
    const float* nw = which == 0 ? p.in[4] : p.in[18];
    const float* mod = (const float*)(p.ws + WS_MOD);
    bf16* XN = (bf16*)(p.ws + WS_XN);
    for (int b = 0; b < BATCH; ++b) {
        const float* sh = mod + b * 6144 + (which == 0 ? 0 : 3072); const float* sc = sh + 1024;
        f32x4 A[4], Bv[4];
#pragma unroll
        for (int j = 0; j < 4; ++j) { const int co = SRC_BF16 ? 16 * lane + 4 * j : 4 * lane + 256 * j; A[j] = *(const f32x4*)(nw + co) * (*(const f32x4*)(sc + co) + 1.f); Bv[j] = *(const f32x4*)(sh + co); }
        constexpr int RU = 4;
        for (int r0 = gw; r0 < SEQ; r0 += RU * ngw) {
            f32x4 v[RU][4];
#pragma unroll
            for (int u = 0; u < RU; ++u) { const int row = b * SEQ + r0 + u * ngw;
                if (SRC_BF16) { const bf16* xr = (const bf16*)src_ + (size_t)row * DM + 16 * lane; const u32x4 a = *(const u32x4*)xr, b2 = *(const u32x4*)(xr + 8);
                    v[u][0] = (f32x4){bflo(a.x), bfhi(a.x), bflo(a.y), bfhi(a.y)}; v[u][1] = (f32x4){bflo(a.z), bfhi(a.z), bflo(a.w), bfhi(a.w)};
                    v[u][2] = (f32x4){bflo(b2.x), bfhi(b2.x), bflo(b2.y), bfhi(b2.y)}; v[u][3] = (f32x4){bflo(b2.z), bfhi(b2.z), bflo(b2.w), bfhi(b2.w)}; }
                else { const f32x4* xr = (const f32x4*)((const float*)src_ + (size_t)row * DM) + lane;
#pragma unroll
                    for (int j = 0; j < 4; ++j) v[u][j] = __builtin_nontemporal_load(xr + 64 * j); } }
#pragma unroll
            for (int u = 0; u < RU; ++u) {
                const int row = b * SEQ + r0 + u * ngw; float ss = 0.f;
#pragma unroll
                for (int j = 0; j < 4; ++j) ss += v[u][j].x * v[u][j].x + v[u][j].y * v[u][j].y + v[u][j].z * v[u][j].z + v[u][j].w * v[u][j].w;
                const float rstd = rsqrtf(wave_sum(ss) * (1.f / DM) + EPS);
                f32x4 h[4];
#pragma unroll
                for (int j = 0; j < 4; ++j) h[j] = v[u][j] * rstd * A[j] + Bv[j];
                if (SRC_BF16) { bf16* o = XN + (size_t)row * DM + 16 * lane;
                    *(u32x4*)o = (u32x4){pk2(h[0].x, h[0].y), pk2(h[0].z, h[0].w), pk2(h[1].x, h[1].y), pk2(h[1].z, h[1].w)}; *(u32x4*)(o + 8) = (u32x4){pk2(h[2].x, h[2].y), pk2(h[2].z, h[2].w), pk2(h[3].x, h[3].y), pk2(h[3].z, h[3].w)}; }
                else { unsigned long long* o8 = (unsigned long long*)(XN + (size_t)row * DM) + lane;
#pragma unroll
                    for (int j = 0; j < 4; ++j) o8[64 * j] = (unsigned long long)pk2(h[j].x, h[j].y) | ((unsigned long long)pk2(h[j].z, h[j].w) << 32); }
            }
        }
    }
}

__device__ __forceinline__ unsigned pack4_fp8(float a0, float a1, float a2, float a3) {
    int w = __builtin_amdgcn_cvt_pk_fp8_f32(a0, a1, __builtin_bit_cast(int, a0), false); w = __builtin_amdgcn_cvt_pk_fp8_f32(a2, a3, w, true); return (unsigned)w;
}
__device__ __forceinline__ float max3f(float a, float b, float c) { return __builtin_fmaxf(__builtin_fmaxf(a, b), c); }
__device__ __forceinline__ u32x2 pack8_fp8(float a0, float a1, float a2, float a3, float a4, float a5, float a6, float a7) {
    return (u32x2){pack4_fp8(a0, a1, a2, a3), pack4_fp8(a4, a5, a6, a7)};
}
constexpr float QSCALE = 0.125f * 1.4426950408889634f;
__device__ __forceinline__ int vt32_slot(int kk) { const int s = kk >> 4, rem = kk & 15, h = (rem >> 2) & 1, j = ((rem >> 3) << 2) | (rem & 3); return 16 * s + 8 * h + j; }
__device__ __forceinline__ int vt16_slot(int kk) { const int ks = kk >> 5, rem = kk & 31, hi = rem >> 4, r2 = rem & 15, qr = r2 >> 2, j = (r2 & 3) + 4 * hi; return 32 * ks + 8 * qr + j; }
__device__ __forceinline__ void unpack16(const u32x4 a, const u32x4 b, float (&v)[16]) {
    v[0] = bflo(a.x); v[1] = bfhi(a.x); v[2] = bflo(a.y); v[3] = bfhi(a.y); v[4] = bflo(a.z); v[5] = bfhi(a.z); v[6] = bflo(a.w); v[7] = bfhi(a.w);
    v[8] = bflo(b.x); v[9] = bfhi(b.x); v[10] = bflo(b.y); v[11] = bfhi(b.y); v[12] = bflo(b.z); v[13] = bfhi(b.z); v[14] = bflo(b.w); v[15] = bfhi(b.w);
}
__device__ __forceinline__ void ph_post(const P& p, unsigned char* ldsb) {
    const int tid = opq_tid(), l4 = tid & 3;
    const bf16* RAW = (const bf16*)(p.ws + WS_R1);
    bf16* Q = (bf16*)(p.ws + WS_Q); bf16* KV = (bf16*)(p.ws + WS_KV); float* GATES = (float*)(p.ws + WS_GATES); bf16* MIX = (bf16*)(p.ws + WS_MIX);
    const float* conv_w = p.in[14]; const float* onw = p.in[15];
    bf16* TL = (bf16*)ldsb;
    constexpr int TLD = 34;
    float wvr[16], cwr[3][16], onr[16];
    { const int grpA = (tid >> 2) & 15; const float* wvp = grpA < 8 ? p.in[6] : (p.in[7] + (grpA < 14 ? 64 : 128)); const int ch0c = ((tid >> 2) & 7) * 64 + l4 * 16;
#pragma unroll
      for (int e = 0; e < 16; ++e) { wvr[e] = wvp[l4 * 16 + e]; onr[e] = onw[512 + ch0c + e];
#pragma unroll
          for (int d = 0; d < 3; ++d) cwr[d][e] = conv_w[d * 512 + ch0c + e]; } }
    for (int tile = blockIdx.x; tile < T / 32; tile += gridDim.x) {
        const int tk0 = tile * 32, b = tk0 / SEQ, s0 = tk0 % SEQ;
        u32x4 la[4][2];
#pragma unroll
        for (int it = 0; it < 4; ++it) { const int unit = (tid >> 2) + 128 * it, tok = unit >> 4, grp = unit & 15; const int i = grp < 8 ? -1 : (grp < 10 ? 0 : grp < 12 ? 1 : grp < 14 ? 2 : 4), g = grp & 1;
            const int col = grp < 8 ? grp * 64 : 512 + i * 128 + g * 64; const bf16* src = RAW + (size_t)(tk0 + tok) * NINP + col + l4 * 16; la[it][0] = *(const u32x4*)src; la[it][1] = *(const u32x4*)(src + 8); }
        asm volatile("" ::: "memory");
#pragma unroll
        for (int it = 0; it < 4; ++it) {
            const int unit = (tid >> 2) + 128 * it, tok = unit >> 4, grp = unit & 15;
            const int i = grp < 8 ? -1 : (grp < 10 ? 0 : grp < 12 ? 1 : grp < 14 ? 2 : 4), g = grp & 1;
            const int col = grp < 8 ? grp * 64 : 512 + i * 128 + g * 64;
            float v[16]; unpack16(la[it][0], la[it][1], v);
            float ss = 0.f;
#pragma unroll
            for (int e = 0; e < 16; ++e) ss += v[e] * v[e];
            ss = add_xor2(add_xor1(ss));
            const bool normed = grp < 8 || grp >= 12;
            const float rs = normed ? rsqrtf(ss * (1.f / 64.f) + EPS) * (grp < 8 ? QSCALE : 1.f) : 1.f;
            if (normed) {
#pragma unroll
                for (int e = 0; e < 16; ++e) v[e] = v[e] * rs * wvr[e];
            }
            bf16* dst = grp < 8 ? Q + ((size_t)(tk0 + tok) * 8 + grp) * 64 + l4 * 16 : KV + ((((size_t)i * 2 + b) * 2 + g) * SEQ + s0 + tok) * 64 + l4 * 16;
            bf16* dst2 = dst + 8;
            if (i == 2) {
                const int sq = s0 + tok, kk = sq & 63; bf16* bb = KV + (((size_t)2 * 2 + b) * 2 + g) * SEQ * 64 + (size_t)(sq >> 6) * 4096 + (((kk >> 4) * 2 + (l4 >> 1)) * 16 + (kk & 15)) * 32;
                dst = bb + ((l4 & 1) * 2) * 8; dst2 = dst + 8; }
            *(u32x4*)dst = (u32x4){pk2(v[0], v[1]), pk2(v[2], v[3]), pk2(v[4], v[5]), pk2(v[6], v[7])};
            *(u32x4*)dst2 = (u32x4){pk2(v[8], v[9]), pk2(v[10], v[11]), pk2(v[12], v[13]), pk2(v[14], v[15])};
            if (i == 2) {
                const int sq = s0 + tok, kk = sq & 63;
                unsigned char* k8 = (unsigned char*)(KV + (((size_t)6 * 2 + b) * 2 + g) * SEQ * 64) + 1048576 + (size_t)(sq >> 6) * 4096 + (((kk >> 4) * 16 + (kk & 15)) * 4 + (l4 & 1) * 2) * 16 + (l4 >> 1) * 8;
                *(u32x2*)k8 = pack8_fp8(v[0], v[1], v[2], v[3], v[4], v[5], v[6], v[7]); *(u32x2*)(k8 + 16) = pack8_fp8(v[8], v[9], v[10], v[11], v[12], v[13], v[14], v[15]); }
        }
        {
            const int tl = tid >> 7, tok = (tid >> 2) & 31, i = tl < 2 ? 3 : 5, g = tl & 1;
            const bf16* src = RAW + (size_t)(tk0 + tok) * NINP + 512 + i * 128 + g * 64 + l4 * 16;
            const u32x4 a = *(const u32x4*)src, c2 = *(const u32x4*)(src + 8);
            unsigned short e16[16];
            e16[0] = a.x & 0xffff; e16[1] = a.x >> 16; e16[2] = a.y & 0xffff; e16[3] = a.y >> 16; e16[4] = a.z & 0xffff; e16[5] = a.z >> 16; e16[6] = a.w & 0xffff; e16[7] = a.w >> 16;
            e16[8] = c2.x & 0xffff; e16[9] = c2.x >> 16; e16[10] = c2.y & 0xffff; e16[11] = c2.y >> 16; e16[12] = c2.z & 0xffff; e16[13] = c2.z >> 16; e16[14] = c2.w & 0xffff; e16[15] = c2.w >> 16;
            const int sl32 = vt32_slot(tok), sl16 = vt16_slot(tok) & 31;
#pragma unroll
            for (int e = 0; e < 16; ++e) { TL[(tl * 64 + l4 * 16 + e) * TLD + sl32] = e16[e]; if (tl < 2) TL[((4 + tl) * 64 + l4 * 16 + e) * TLD + sl16] = e16[e]; }
        }
        __syncthreads();
#pragma unroll
        for (int k = 0; k < 3; ++k) {
            const int ch = tid + 512 * k, tl = ch >> 8, d = (ch >> 2) & 63, part = ch & 3;
            const bf16* sp = TL + (tl * 64 + d) * TLD + part * 8;
            const u32x4 o = (u32x4){*(const unsigned*)(sp), *(const unsigned*)(sp + 2), *(const unsigned*)(sp + 4), *(const unsigned*)(sp + 6)};
            bf16* dst;
            if (tl < 4) { const int i = tl < 2 ? 3 : 5, g = tl & 1; dst = KV + (((size_t)i * 2 + b) * 2 + g) * SEQ * 64 + (size_t)(s0 >> 5) * 2048 + d * 32 + part * 8; }
            else { const int g = tl & 1;
                unsigned char* v8 = (unsigned char*)(KV + (((size_t)6 * 2 + b) * 2 + g) * SEQ * 64) + (size_t)(s0 >> 6) * 4096 + ((((d >> 2) & 3) * 16 + 4 * (d >> 4) + (d & 3)) * 4 + part) * 16 + ((s0 >> 5) & 1) * 8;
                *(u32x2*)v8 = pack8_fp8(0.25f * bflo(o.x), 0.25f * bfhi(o.x), 0.25f * bflo(o.y), 0.25f * bfhi(o.y), 0.25f * bflo(o.z), 0.25f * bfhi(o.z), 0.25f * bflo(o.w), 0.25f * bfhi(o.w)); continue; }
            *(u32x4*)dst = o;
        }
        for (int k = tid; k < 32 * 24; k += 512) { const int tok = k / 24, jj = k % 24; GATES[(size_t)(tk0 + tok) * 24 + jj] = __builtin_amdgcn_rcpf(1.f + __expf(-bf2f(RAW[(size_t)(tk0 + tok) * NINP + 1280 + jj]))); }
#pragma unroll
        for (int it = 0; it < 2; ++it) {
            const int unit = (tid >> 2) + 128 * it, tok = unit >> 3, grp = unit & 7, ch0 = grp * 64 + l4 * 16;
            float acc[16];
#pragma unroll
            for (int e = 0; e < 16; ++e) acc[e] = 0.f;
#pragma unroll
            for (int d = 0; d < 3; ++d) {
                if (s0 + tok - 2 + d >= 0) {
                    const bf16* rr = RAW + (size_t)(tk0 + tok - 2 + d) * NINP;
                    float cg[16], uu[16]; unpack16(*(const u32x4*)(rr + 1816 + ch0), *(const u32x4*)(rr + 1816 + ch0 + 8), cg); unpack16(*(const u32x4*)(rr + 2328 + ch0), *(const u32x4*)(rr + 2328 + ch0 + 8), uu);
#pragma unroll
                    for (int e = 0; e < 16; ++e) acc[e] += cwr[d][e] * cg[e] * uu[e];
                }
            }
            const bf16* r0 = RAW + (size_t)(tk0 + tok) * NINP + 1304 + ch0;
            float bg[16]; unpack16(*(const u32x4*)r0, *(const u32x4*)(r0 + 8), bg);
            float ss = 0.f;
#pragma unroll
            for (int e = 0; e < 16; ++e) { acc[e] *= bg[e]; ss += acc[e] * acc[e]; }
            ss = add_xor2(add_xor1(ss));
            const float rs = rsqrtf(ss * (1.f / 64.f) + EPS);
#pragma unroll
            for (int e = 0; e < 16; ++e) acc[e] = acc[e] * rs * onr[e];
            bf16* dst = MIX + (size_t)(tk0 + tok) * DM + 512 + ch0;
            *(u32x4*)dst = (u32x4){pk2(acc[0], acc[1]), pk2(acc[2], acc[3]), pk2(acc[4], acc[5]), pk2(acc[6], acc[7])};
            *(u32x4*)(dst + 8) = (u32x4){pk2(acc[8], acc[9]), pk2(acc[10], acc[11]), pk2(acc[12], acc[13]), pk2(acc[14], acc[15])};
        }
        __syncthreads();
    }
}

__device__ __forceinline__ void ph_cmp_fin2(const P& p, int pm) {
    const int tid = opq_tid(), lane = tid & 63, wv = tid >> 6, fr = lane & 15, fq = lane >> 4;
    if (wv >= 4) return;
    const int kv = pm >= 16 ? 1 : 0;
    const bf16* A = (const bf16*)(p.ws + WS_HID) + (size_t)(pm * 256 + 64 * wv + fr) * 256 + fq * 8;
    const bf16* B = (const bf16*)(p.ws + WS_CW2_T) + (size_t)(kv * 64 + fr) * 256 + fq * 8;
    bf16* KCVC = (bf16*)(p.ws + WS_KCVC);
    f32x4 acc[4][4];
#pragma unroll
    for (int i = 0; i < 4; ++i)
#pragma unroll
        for (int j = 0; j < 4; ++j) acc[i][j] = (f32x4){0.f, 0.f, 0.f, 0.f};
#pragma unroll 2
    for (int ks = 0; ks < 8; ++ks) {
        bf16x8 a[4], b[4];
#pragma unroll
        for (int i = 0; i < 4; ++i) { a[i] = *(const bf16x8*)(A + (size_t)(16 * i) * 256 + 32 * ks); b[i] = *(const bf16x8*)(B + (size_t)(16 * i) * 256 + 32 * ks); }
#pragma unroll
        for (int i = 0; i < 4; ++i)
#pragma unroll
            for (int j = 0; j < 4; ++j) acc[i][j] = __builtin_amdgcn_mfma_f32_16x16x32_bf16(b[j], a[i], acc[i][j], 0, 0, 0);
    }
#pragma unroll
    for (int i = 0; i < 4; ++i) {
        const int r = pm * 256 + 64 * wv + 16 * i + fr, n = r & 1023; const bool valid = n < NC;
        float ss = 0.f;
#pragma unroll
        for (int j = 0; j < 4; ++j) ss += acc[i][j].x * acc[i][j].x + acc[i][j].y * acc[i][j].y + acc[i][j].z * acc[i][j].z + acc[i][j].w * acc[i][j].w;
        ss = sum_rows(ss);
        const float rs = kv == 0 ? rsqrtf(ss * (1.f / 64.f) + EPS) : 1.f;
#pragma unroll
        for (int j = 0; j < 4; ++j) { const int col = 16 * j + 4 * fq; f32x4 v = acc[i][j] * rs;
            if (kv == 0) v = v * *(const f32x4*)(p.in[7] + col);
            if (!valid) v = (f32x4){0.f, 0.f, 0.f, 0.f};
            if (kv == 0) *(u32x2*)(KCVC + (size_t)r * 64 + col) = (u32x2){pk2(v.x, v.y), pk2(v.z, v.w)};
            else { bf16* vb = KCVC + (size_t)(r - n) * 64 + (size_t)(n >> 5) * 2048 + vt32_slot(n & 31);
                vb[(col + 0) * 32] = (bf16)f2bf(v.x); vb[(col + 1) * 32] = (bf16)f2bf(v.y); vb[(col + 2) * 32] = (bf16)f2bf(v.z); vb[(col + 3) * 32] = (bf16)f2bf(v.w); } }
    }
}

typedef float f32x16 __attribute__((ext_vector_type(16)));
typedef float f32x2_t __attribute__((ext_vector_type(2))); typedef __bf16 bf16x2_t __attribute__((ext_vector_type(2)));
#define MFMA32(a, b, c) __builtin_amdgcn_mfma_f32_32x32x16_bf16((a), (b), (c), 0, 0, 0)
#define MFMA16(a, b, c) __builtin_amdgcn_mfma_f32_16x16x32_bf16((a), (b), (c), 0, 0, 0)
__device__ __forceinline__ unsigned cvtpk(float lo, float hi) { f32x2_t v = {lo, hi}; bf16x2_t b = __builtin_convertvector(v, bf16x2_t); return __builtin_bit_cast(unsigned, b); }
__device__ __forceinline__ int crow(int i, int h) { return (i & 3) + 8 * (i >> 2) + 4 * h; }
#define PACK8(x, s) __builtin_bit_cast(bf16x8, (u32x4){cvtpk(x[8 * (s)], x[8 * (s) + 1]), cvtpk(x[8 * (s) + 2], x[8 * (s) + 3]), cvtpk(x[8 * (s) + 4], x[8 * (s) + 5]), cvtpk(x[8 * (s) + 6], x[8 * (s) + 7])})
constexpr int AL_Q = 0, AL_ACC = 32768, AL_LACC = 99328, AL_ROWS = 100352, AL_RANK = 104448, AL_PARK01 = 120832, AL_PARK27 = 139264;
constexpr int SLOT_B = 288, CU_SCR_B = 458752;
constexpr int IMP_LD = 260, OACC_LD = 65;
typedef __attribute__((address_space(3))) const float* lds_cfp;

constexpr int BN_LO = 70, BN_N = 269;
__device__ __forceinline__ void build_bias_table(const P& p, float* biasL, int g) {
    float* biasN = biasL + 130 * 4;
    for (int i = threadIdx.x; i < (130 + BN_N) * 4; i += blockDim.x) {
        const bool n = i >= 130 * 4; const int k = (n ? i - 130 * 4 : i) >> 2, hl = i & 3, d = n ? k - BN_LO : k - 1; int bk;
        if (d < 16) bk = max(d, 0); else { bk = 16 + (int)(logf((float)d / 16.f) / logf(8.f) * 16.f); bk = min(bk, 31); }
        if (d >= 128) bk = 31;
        biasL[i] = d < 0 ? -1.0e30f : (p.in[17][bk * 8 + 4 * g + hl] - p.in[17][31 * 8 + 4 * g + hl]) * 1.4426950408889634f;
    }
    __syncthreads();
}
template <int KIND, int NM> __device__ __forceinline__ float apply_p(f32x16& S, int key0, int h, int pos, int hl, lds_cfp biasL) {
    float sum = 0.f;
    if (NM == 0) {
#pragma unroll
        for (int i = 0; i < 16; ++i) { S[i] = __builtin_amdgcn_exp2f(S[i]); sum += S[i]; }
    } else if (NM == 2) {
        const int B1 = pos - key0 - 4 * h;
#pragma unroll
        for (int i = 0; i < 16; ++i) { const int d = B1 - ((i & 3) + 8 * (i >> 2)); const float v = __builtin_amdgcn_exp2f(S[i]); S[i] = d < 512 ? v : 0.f; sum += S[i]; }
    } else if (KIND == 0) {
        const int B1 = pos - 16 * (key0 + 4 * h) - 30;
#pragma unroll
        for (int i = 0; i < 16; ++i) { const int bi = min(max(B1 - 16 * ((i & 3) + 8 * (i >> 2)), 0), 129);
            S[i] = __builtin_amdgcn_exp2f(S[i] + biasL[bi * 4 + hl]); sum += S[i]; }
    } else {
        lds_cfp tb = biasL + 130 * 4 + (pos - key0 - 4 * h + BN_LO - 27) * 4 + hl;
#pragma unroll
        for (int i = 0; i < 16; ++i) { S[i] = __builtin_amdgcn_exp2f(S[i] + tb[(27 - ((i & 3) + 8 * (i >> 2))) * 4]); sum += S[i]; }
    }
    return sum;
}
struct DCtx { int c, h, pos, pos_lo, pos_hi, head, hl; lds_cfp biasL; };
typedef __attribute__((address_space(3))) const unsigned char* lds_cbp;
template <int KIND, int MODE>
__device__ __forceinline__ void stage_compute(lds_cbp sb, int step, const bf16x8 (&qf)[4], const DCtx& X, f32x16 (&O)[2], float& lsum, float rl, float& carry, float* imp_row) {
#pragma unroll
    for (int t2 = 0; t2 < 2; ++t2) {
        const int kt = 2 * step + t2;
        bool skip; if (KIND == 0) skip = 16 * (32 * kt) + 31 > X.pos_hi; else if (KIND == 1) skip = (32 * kt > X.pos_hi) || (32 * kt + 31 < X.pos_lo - 511); else skip = 32 * kt > X.pos_hi;
        if (skip) continue;
        const int row = 32 * t2 + X.c, sw = (row ^ (row >> 3)) & 7;
        f32x16 S;
#pragma unroll
        for (int i_ = 0; i_ < 16; ++i_) S[i_] = 0.f;
        bf16x8 kf[4];
#pragma unroll
        for (int k_ = 0; k_ < 4; ++k_) kf[k_] = *(const __attribute__((address_space(3))) bf16x8*)(sb + row * 128 + (((2 * k_ + X.h) ^ sw) << 4));
        __builtin_amdgcn_s_setprio(1);
#pragma unroll
        for (int k_ = 0; k_ < 4; ++k_) S = MFMA32(kf[k_], qf[k_], S);
        __builtin_amdgcn_s_setprio(0);
        int nm;
        if (KIND == 0) nm = (X.pos_lo - 16 * (32 * kt + 31) - 31 >= 128) ? 0 : 1;
        else if (KIND == 1) nm = (32 * kt < X.pos_hi - 511) ? 2 : ((32 * kt + 31 <= X.pos_lo - 128) ? 0 : 1);
        else nm = (32 * kt + 31 <= X.pos_lo - 128) ? 0 : 1;
        nm = __builtin_amdgcn_readfirstlane(nm);
        if (nm == 0) lsum += apply_p<KIND, 0>(S, 32 * kt, X.h, X.pos, X.hl, X.biasL);
        else if (KIND == 1 && nm == 2) lsum += apply_p<KIND, 2>(S, 32 * kt, X.h, X.pos, X.hl, X.biasL);
        else lsum += apply_p<KIND, 1>(S, 32 * kt, X.h, X.pos, X.hl, X.biasL);
        if (MODE & 1) { const bf16x8 pa0 = PACK8(S, 0), pa1 = PACK8(S, 1);
#pragma unroll
            for (int d0 = 0; d0 < 2; ++d0) { const int d = 32 * d0 + X.c, sv = (d >> 2) & 3; lds_cbp vb = sb + 8192 + t2 * 4096 + d * 64;
                const bf16x8 v0 = *(const __attribute__((address_space(3))) bf16x8*)(vb + ((X.h ^ sv) << 4)), v1 = *(const __attribute__((address_space(3))) bf16x8*)(vb + (((2 + X.h) ^ sv) << 4));
                __builtin_amdgcn_s_setprio(1); O[d0] = MFMA32(pa0, v0, O[d0]); O[d0] = MFMA32(pa1, v1, O[d0]); __builtin_amdgcn_s_setprio(0); } }
        if (MODE & 2) { float G[4], E[4], Eo[4];
#pragma unroll
            for (int m = 0; m < 4; ++m) { G[m] = (S[4 * m] + S[4 * m + 1] + S[4 * m + 2] + S[4 * m + 3]) * rl; E[m] = S[4 * m + 3] * rl;
                G[m] = add_xor2(add_xor1(G[m])); E[m] = add_xor2(add_xor1(E[m])); Eo[m] = other_half(E[m], X.h); }
            if (X.h == 1) {
#pragma unroll
                for (int m = 0; m < 4; ++m) G[m] += Eo[m];
            } else { G[0] += carry; G[1] += Eo[0]; G[2] += Eo[1]; G[3] += Eo[2]; carry = Eo[3]; }
            if ((X.c & 3) == 0) {
#pragma unroll
                for (int m = 0; m < 4; ++m) imp_row[kt * 8 + 2 * m + X.h] = G[m];
            } }
    }
}
__device__ __forceinline__ unsigned wave_max_u32(unsigned v) {
    v = max(v, (unsigned)__builtin_amdgcn_update_dpp(0, (int)v, 0xB1, 0xF, 0xF, false));
    v = max(v, (unsigned)__builtin_amdgcn_update_dpp(0, (int)v, 0x4E, 0xF, 0xF, false));
    v = max(v, (unsigned)__builtin_amdgcn_update_dpp(0, (int)v, 0x141, 0xF, 0xF, false));
    v = max(v, (unsigned)__builtin_amdgcn_update_dpp(0, (int)v, 0x140, 0xF, 0xF, false));
    const unsigned s0 = __builtin_amdgcn_readlane(v, 0), s1 = __builtin_amdgcn_readlane(v, 16), s2 = __builtin_amdgcn_readlane(v, 32), s3 = __builtin_amdgcn_readlane(v, 48);
    return max(max(s0, s1), max(s2, s3));
}
struct GaCtx { const unsigned char* Qs8; unsigned char* CUS; const unsigned char* RANK; lds_cfp biasL; int qr, hh, t0; long ones; };
template <int NG>
__device__ __forceinline__ void ga_groups(const u32x4 (&kf)[4], const u32x4 (&vf)[4], const int (&myq)[NG], const bool (&ok)[NG], const int s, const bool near, const GaCtx& C) {
    typedef long lx2 __attribute__((ext_vector_type(2)));
    long qb0[NG], qb1[NG]; int rk[NG];
#pragma unroll
    for (int g = 0; g < NG; ++g) { const unsigned char* qp = C.Qs8 + (size_t)(myq[g] * 4 + C.hh) * 64 + 8 * C.qr; qb0[g] = *(const long*)qp; qb1[g] = *(const long*)(qp + 32); rk[g] = C.RANK[s * 64 + myq[g]]; }
    f32x4 St[NG][4];
#pragma unroll
    for (int kg = 0; kg < 4; ++kg) { const lx2 kk_ = __builtin_bit_cast(lx2, kf[kg]);
#pragma unroll
        for (int g = 0; g < NG; ++g) { St[g][kg] = (f32x4){0.f, 0.f, 0.f, 0.f}; St[g][kg] = __builtin_amdgcn_mfma_f32_16x16x32_fp8_fp8(kk_.x, qb0[g], St[g][kg], 0, 0, 0); }
#pragma unroll
        for (int g = 0; g < NG; ++g) St[g][kg] = __builtin_amdgcn_mfma_f32_16x16x32_fp8_fp8(kk_.y, qb1[g], St[g][kg], 0, 0, 0); }
    if (near) {
#pragma unroll
        for (int g = 0; g < NG; ++g) { const int qpos = C.t0 + myq[g];
#pragma unroll
            for (int kg = 0; kg < 4; ++kg)
#pragma unroll
                for (int e = 0; e < 4; ++e) { const int dist = qpos - (s * 64 + 16 * kg + 4 * C.qr + e); St[g][kg][e] += C.biasL[(min(max(dist, 0), 128) + 1) * 4 + C.hh]; } } }
    float mx[NG], lg[NG]; long pb0[NG], pb1[NG];
#pragma unroll
    for (int g = 0; g < NG; ++g) { const f32x4 (&T)[4] = St[g];
        const float t0 = max3f(T[0][0], T[0][1], T[0][2]), t1 = max3f(T[0][3], T[1][0], T[1][1]), t2 = max3f(T[1][2], T[1][3], T[2][0]), t3 = max3f(T[2][1], T[2][2], T[2][3]), t4 = max3f(T[3][0], T[3][1], T[3][2]);
        mx[g] = __builtin_ceilf(max_rows(fmaxf(max3f(max3f(t0, t1, t2), t3, t4), T[3][3]))); }
#pragma unroll
    for (int g = 0; g < NG; ++g) {
#pragma unroll
        for (int kg = 0; kg < 4; ++kg)
#pragma unroll
            for (int e = 0; e < 4; ++e) St[g][kg][e] = __builtin_amdgcn_exp2f(St[g][kg][e]);
        { typedef short v2s_ __attribute__((ext_vector_type(2))); const float scl_ = __builtin_amdgcn_exp2f(mx[g]);
          unsigned w_[4];
#pragma unroll
          for (int kg = 0; kg < 4; ++kg) { v2s_ t_ = {0, 0}; t_ = __builtin_amdgcn_cvt_scalef32_pk_fp8_f32(t_, St[g][kg][0], St[g][kg][1], scl_, false); t_ = __builtin_amdgcn_cvt_scalef32_pk_fp8_f32(t_, St[g][kg][2], St[g][kg][3], scl_, true); w_[kg] = __builtin_bit_cast(unsigned, t_); }
          pb0[g] = __builtin_bit_cast(long, (u32x2){w_[0], w_[1]}); pb1[g] = __builtin_bit_cast(long, (u32x2){w_[2], w_[3]}); }
        f32x4 OL = (f32x4){0.f, 0.f, 0.f, 0.f}; OL = __builtin_amdgcn_mfma_f32_16x16x32_fp8_fp8(C.ones, pb0[g], OL, 0, 0, 0); OL = __builtin_amdgcn_mfma_f32_16x16x32_fp8_fp8(C.ones, pb1[g], OL, 0, 0, 0);
        lg[g] = OL[0]; }
    unsigned char* sp[NG];
#pragma unroll
    for (int g = 0; g < NG; ++g) sp[g] = C.CUS + (size_t)(myq[g] * 13 + rk[g] - 1) * SLOT_B;
    unsigned ow[NG][4];
#pragma unroll
    for (int dg = 0; dg < 4; ++dg) { const lx2 vv_ = __builtin_bit_cast(lx2, vf[dg]);
#pragma unroll
        for (int g = 0; g < NG; ++g) { f32x4 OT = (f32x4){0.f, 0.f, 0.f, 0.f}; OT = __builtin_amdgcn_mfma_f32_16x16x32_fp8_fp8(vv_.x, pb0[g], OT, 0, 0, 0); OT = __builtin_amdgcn_mfma_f32_16x16x32_fp8_fp8(vv_.y, pb1[g], OT, 0, 0, 0);
            ow[g][dg] = pack4_fp8(OT[0], OT[1], OT[2], OT[3]); } }
#pragma unroll
    for (int g = 0; g < NG; ++g) if (ok[g]) *(u32x4*)(sp[g] + C.hh * 64 + C.qr * 16) = (u32x4){ow[g][0], ow[g][1], ow[g][2], ow[g][3]};
#pragma unroll
    for (int g = 0; g < NG; ++g) if (ok[g] && C.qr == 0) { *(float*)(sp[g] + 256 + C.hh * 4) = lg[g] * __builtin_amdgcn_exp2f(mx[g]); *(float*)(sp[g] + 272 + C.hh * 4) = mx[g]; }
}
template <int NJ>
__device__ __forceinline__ void topk_rows(const float* OACC, unsigned char* RANK, int w, int cur, int lane) {
    const int rw = lane >> 4, l16 = lane & 15;
#pragma unroll 1
    for (int half = 0; half < 2; ++half) {
        const int qi = 4 * half + rw;
        unsigned nk[NJ];
#pragma unroll
        for (int j = 0; j < NJ; ++j) { const int s = l16 + 16 * j; const float v = OACC[(size_t)(8 * w + qi) * IMP_LD + s];
            nk[j] = (s >= 1 && s <= cur - 2) ? ~((__float_as_uint(v) & 0xFFFFFE00u) | 0x100u | (unsigned)(255 - s)) : 0xFFFFFFFFu; }
        unsigned c1 = 1u;
#pragma unroll 1
        for (int r = 0; r < 13; ++r) {
            unsigned d = nk[0] - c1;
#pragma unroll
            for (int j = 1; j < NJ; ++j) d = min(d, nk[j] - c1);
            d = min(d, (unsigned)__builtin_amdgcn_update_dpp(0, (int)d, 0xB1, 0xF, 0xF, false));
            d = min(d, (unsigned)__builtin_amdgcn_update_dpp(0, (int)d, 0x4E, 0xF, 0xF, false));
            d = min(d, (unsigned)__builtin_amdgcn_update_dpp(0, (int)d, 0x141, 0xF, 0xF, false));
            d = min(d, (unsigned)__builtin_amdgcn_update_dpp(0, (int)d, 0x140, 0xF, 0xF, false));
            const unsigned nm = d + c1, m = ~nm;
            if (l16 == 0 && m != 0u) RANK[(255u - (m & 0xFFu)) * 64 + 8 * w + qi] = (unsigned char)(r + 1);
            c1 = nm + 1u;
        }
    }
}
__device__ __forceinline__ void attn_unit(const P& p, const int b, const int g, const int cur, unsigned char* ring, const float* biasLg, unsigned long long& sw_acc) {
    unsigned long long sw_t0 = 0;
    int tid = opq_tid(), lane = tid & 63, c = lane & 31, h = lane >> 5; const int w = __builtin_amdgcn_readfirstlane(tid >> 6);
    const int t0 = cur * 64; const size_t tbase = (size_t)b * SEQ;
    bf16* Qs = (bf16*)(ring + AL_Q); float* OACC = (float*)(ring + AL_ACC); float* ACC = OACC + w * (32 * OACC_LD);
    float* LACC = (float*)(ring + AL_LACC);
    float* RS = (float*)(ring + AL_ROWS) + w * 128; unsigned char* RANK = ring + AL_RANK;
    bf16* PARK = (bf16*)(ring + (w < 2 ? AL_PARK01 + w * 4096 : AL_PARK27 + (w - 2) * 4096));
    unsigned char* CUS = p.ws + WS_LOGITS + (size_t)blockIdx.x * CU_SCR_B;
    const bf16* Qg = (const bf16*)(p.ws + WS_Q) + ((tbase + t0) * 8 + 4 * g) * 64;
    const bf16* KVall = (const bf16*)(p.ws + WS_KV);
    auto kvb = [&](int i) { return KVall + (((size_t)i * 2 + b) * 2 + g) * SEQ * 64; };
    const bf16* KC = (const bf16*)(p.ws + WS_KCVC) + (size_t)(b * 2 + g) * NCP * 64; const bf16* VCt = (const bf16*)(p.ws + WS_KCVC) + (size_t)(4 + b * 2 + g) * NCP * 64;
    const float* GATES = (const float*)(p.ws + WS_GATES);
    { unsigned z = 0u; asm volatile("" : "+v"(z)); *(u32x4*)(RANK + tid * 32) = (u32x4){z, z, z, z}; *(u32x4*)(RANK + tid * 32 + 16) = (u32x4){z, z, z, z}; }
    int row = 32 * w + c, ql = row >> 2, hl = row & 3;
    DCtx X; X.c = c; X.h = h; X.pos = t0 + ql; X.pos_lo = t0 + 8 * w; X.pos_hi = X.pos_lo + 7; X.head = 4 * g + hl; X.hl = hl; X.biasL = (lds_cfp)biasLg;
    bf16x8 qf[4];
#pragma unroll
    for (int k = 0; k < 4; ++k) qf[k] = *(const bf16x8*)(Qg + (size_t)(ql * 8 + hl) * 64 + 16 * k + 8 * h);
    const float* gt = GATES + (tbase + X.pos) * 24 + X.head * 3;
#define LANE_REDERIVE() do { tid = opq_tid(); lane = tid & 63; c = lane & 31; h = lane >> 5; row = 32 * w + c; ql = row >> 2; hl = row & 3; \
        X.c = c; X.h = h; X.pos = t0 + ql; X.head = 4 * g + hl; X.hl = hl; gt = GATES + (tbase + X.pos) * 24 + X.head * 3; } while (0)
    unsigned char* STG = ring + AL_Q;
#define ST_SETUP const int tid_s = opq_tid(); const int st_row = tid_s >> 3, st_ch = tid_s & 7, st_d = (tid_s >> 2) & 63; \
    const int st_koff = st_row * 128 + ((st_ch ^ ((st_row ^ (st_row >> 3)) & 7)) << 4), st_voff = 8192 + (tid_s >> 8) * 4096 + st_d * 64 + (((tid_s & 3) ^ ((st_d >> 2) & 3)) << 4); \
    const int st_ksrc_row = st_row * 64 + st_ch * 8, st_ksrc_frag = (((st_row >> 4) * 2 + (st_ch >> 2)) * 16 + (st_row & 15)) * 32 + (st_ch & 3) * 8, st_vsrc = tid_s * 8;
    u32x4 st_k0, st_v0, st_k1, st_v1;
#define ST_ISSUE(S, Kp, Vp, stp, needv, frag) do { st_k##S = *(const u32x4*)((Kp) + (size_t)(stp) * 4096 + ((frag) ? st_ksrc_frag : st_ksrc_row)); if (needv) st_v##S = *(const u32x4*)((Vp) + (size_t)(stp) * 4096 + st_vsrc); } while (0)
#define ST_COMMIT(S, needv) do { *(u32x4*)(STG + (S) * 16384 + st_koff) = st_k##S; if (needv) *(u32x4*)(STG + (S) * 16384 + st_voff) = st_v##S; } while (0)
#define SEQ_RUN(n_, ISSUE, COMP, NEEDV) do { \
        ISSUE(0, 0); if ((n_) > 1) ISSUE(1, 1); ST_COMMIT(0, NEEDV(0)); if ((n_) > 2) ISSUE(0, 2); __syncthreads(); \
        for (int j = 0; j < (n_); j += 2) { \
            COMP(j, (lds_cbp)STG); \
            if (j + 1 < (n_)) { ST_COMMIT(1, NEEDV(j + 1)); if (j + 3 < (n_)) ISSUE(1, j + 3); } \
            __syncthreads(); \
            if (j + 1 < (n_)) { COMP(j + 1, (lds_cbp)(STG + 16384)); \
                if (j + 2 < (n_)) { ST_COMMIT(0, NEEDV(j + 2)); if (j + 4 < (n_)) ISSUE(0, j + 4); } \
                __syncthreads(); } } } while (0)
    SW_BEGIN(1);
    const int NTc = (4 * cur + 3 + 31) >> 5, nc = (NTc + 1) >> 1;
    f32x16 Ob[2];
    float lsum = 0.f, carry = 0.f, dummy = 0.f, rlc = 0.f;
    {
        ST_SETUP
        const int n = 2 * nc;
#define A_NEEDV(j_) ((j_) >= nc)
#define A_ISSUE(S, j_) ST_ISSUE(S, KC, VCt, ((j_) % nc), A_NEEDV(j_), false)
#define A_COMP(j_, sb_) do { if ((j_) < nc) { stage_compute<0, 0>(sb_, (j_), qf, X, Ob, lsum, 0.f, carry, nullptr); \
                if ((j_) == nc - 1) { lsum = sum_halves(lsum); rlc = lsum > 0.f ? 1.f / lsum : 0.f; } } \
            else stage_compute<0, 3>(sb_, (j_) - nc, qf, X, Ob, dummy, rlc, carry, OACC + (size_t)(8 * w + (c >> 2)) * IMP_LD); } while (0)
#pragma unroll
        for (int i = 0; i < 16; ++i) { Ob[0][i] = 0.f; Ob[1][i] = 0.f; }
        SEQ_RUN(n, A_ISSUE, A_COMP, A_NEEDV);
        if (h == 0) RS[c] = gt[0] * rlc;
        LDS_FENCE();
#pragma unroll
        for (int i = 0; i < 16; ++i) { const int r = crow(i, h); const float a = RS[r];
#pragma unroll
            for (int d0 = 0; d0 < 2; ++d0) PARK[r * 64 + 32 * d0 + c] = (bf16)f2bf(Ob[d0][i] * a); }
#undef A_NEEDV
#undef A_ISSUE
#undef A_COMP
    }
    LDS_FENCE();
    SW_END(1);
    SW_BEGIN(2);
    if (cur >= 16) {
#if PROBE_ATT == 3
        for (int rep = 0; rep < 2; ++rep)
#endif
        { const int nj = ((cur - 2) >> 4) + 1;
          if (nj <= 4) topk_rows<4>(OACC, RANK, w, cur, lane); else if (nj <= 8) topk_rows<8>(OACC, RANK, w, cur, lane); else if (nj <= 12) topk_rows<12>(OACC, RANK, w, cur, lane); else topk_rows<16>(OACC, RANK, w, cur, lane); }
    }
    LDS_FENCE();
    SW_END(2);
    SW_BEGIN(3);
    if (cur >= 16) {
#pragma unroll
        for (int k = 0; k < 4; ++k) { const int ci = tid + 512 * k, ql_ = ci >> 5, rem = ci & 31;
            const u32x4 qv = *(const u32x4*)(Qg + (size_t)(ql_ * 8 + (rem >> 3)) * 64 + (rem & 7) * 8);
            *(u32x2*)((unsigned char*)Qs + (size_t)ci * 8) = pack8_fp8(bflo(qv.x), bfhi(qv.x), bflo(qv.y), bfhi(qv.y), bflo(qv.z), bfhi(qv.z), bflo(qv.w), bfhi(qv.w)); }
        __attribute__((address_space(3))) int* gctr = (__attribute__((address_space(3))) int*)((__attribute__((address_space(3))) unsigned char*)ring + 139200 + 32);
        if (tid == 0) *gctr = 1;
        __syncthreads();
        const int lane_g = opq_tid() & 63, kr = lane_g & 15, qr = lane_g >> 4, qi = kr >> 2, hh = kr & 3, lim = cur - 2;
        typedef long lx2 __attribute__((ext_vector_type(2)));
        const unsigned char* V8 = (const unsigned char*)kvb(6) + (kr * 4 + qr) * 16; const unsigned char* K8 = V8 + 1048576;
        const unsigned char* Qs8 = (const unsigned char*)Qs;
        const GaCtx gctx{(const unsigned char*)Qs, CUS, RANK, X.biasL, qr, hh, t0, kr == 0 ? 0x3838383838383838L : 0L};
        u32x4 kA[4], vA[4], kB[4], vB[4], kC[4], vC[4];
#define MFMA8(a, b, c) __builtin_amdgcn_mfma_f32_16x16x32_fp8_fp8((a), (b), (c), 0, 0, 0)
#define GA_NEXT(s_) do { for (;;) { int g_ = 0; if (lane_g == 0) g_ = __hip_atomic_fetch_add(gctr, 1, __ATOMIC_RELAXED, __HIP_MEMORY_SCOPE_WORKGROUP); (s_) = __builtin_amdgcn_readfirstlane(g_); \
            if ((s_) > lim || __ballot(RANK[(s_) * 64 + lane_g] != 0) != 0ull) break; } } while (0)
#define GA_LOAD(kf, s_) do { _Pragma("unroll") for (int a_ = 0; a_ < 4; ++a_) kf[a_] = *(const u32x4*)(K8 + (size_t)(s_) * 4096 + a_ * 1024); } while (0)
#define GA_LOADV(vf, s_) do { _Pragma("unroll") for (int a_ = 0; a_ < 4; ++a_) vf[a_] = *(const u32x4*)(V8 + (size_t)(s_) * 4096 + a_ * 1024); } while (0)
#define GA_X4(q0_, q1_, q2_, q3_, n_) int q0_ = __builtin_ctzll(m); m &= m - 1; int n_ = 1, q1_ = q0_, q2_ = q0_, q3_ = q0_; \
            if (m) { q1_ = __builtin_ctzll(m); m &= m - 1; n_ = 2; if (m) { q2_ = __builtin_ctzll(m); m &= m - 1; n_ = 3; if (m) { q3_ = __builtin_ctzll(m); m &= m - 1; n_ = 4; } } }
#define GA_PROC(kf, vf, s_) do { unsigned long long m = __ballot(RANK[(s_) * 64 + lane_g] != 0); const bool near = ((s_) == lim); \
            while (m) { GA_X4(a0, a1, a2, a3, na) \
                if (m) { GA_X4(b0, b1, b2, b3, nb) const int mq[2] = {qi == 0 ? a0 : qi == 1 ? a1 : qi == 2 ? a2 : a3, qi == 0 ? b0 : qi == 1 ? b1 : qi == 2 ? b2 : b3}; const bool okk[2] = {qi < na, qi < nb}; \
                    ga_groups<2>(kf, vf, mq, okk, (s_), near, gctx); } \
                else { const int mq[1] = {qi == 0 ? a0 : qi == 1 ? a1 : qi == 2 ? a2 : a3}; const bool okk[1] = {qi < na}; ga_groups<1>(kf, vf, mq, okk, (s_), near, gctx); } } } while (0)
#if PROBE_ATT == 4
        for (int rep = 0; rep < 2; ++rep) { const bool noacc = (rep == 0);
#else
        { const bool noacc = false;
#endif
#define GA_TOUCH(kf, vf) asm volatile("" :: "v"(kf[0]), "v"(kf[1]), "v"(kf[2]), "v"(kf[3]), "v"(vf[0]), "v"(vf[1]), "v"(vf[2]), "v"(vf[3]))
        int sa, sb_, sc_; GA_NEXT(sa); GA_NEXT(sb_); GA_NEXT(sc_);
        if (sa <= lim) { GA_LOAD(kA, sa); GA_LOADV(vA, sa); }
        if (sb_ <= lim) { GA_LOAD(kB, sb_); GA_LOADV(vB, sb_); }
        while (sa <= lim) {
            GA_TOUCH(kA, vA); if (sc_ <= lim) { GA_LOAD(kC, sc_); GA_LOADV(vC, sc_); }
            GA_PROC(kA, vA, sa); GA_NEXT(sa);
            if (sb_ > lim) break;
            GA_TOUCH(kB, vB); if (sa <= lim) { GA_LOAD(kA, sa); GA_LOADV(vA, sa); }
            GA_PROC(kB, vB, sb_); GA_NEXT(sb_);
            if (sc_ > lim) break;
            GA_TOUCH(kC, vC); if (sb_ <= lim) { GA_LOAD(kB, sb_); GA_LOADV(vB, sb_); }
            GA_PROC(kC, vC, sc_); GA_NEXT(sc_);
        }
        }
#undef GA_TOUCH
#undef GA_NEXT
#undef MFMA8
#undef GA_LOAD
#undef GA_LOADV
#undef GA_PROC
        asm volatile("s_waitcnt vmcnt(0) lgkmcnt(0)" ::: "memory");
        __syncthreads();
        SW_END(3);
        SW_BEGIN(4);
        {
            const __amdgpu_buffer_rsrc_t rs_ = __builtin_amdgcn_make_buffer_rsrc((void*)CUS, 0, CU_SCR_B, 0x00020000);
            const int rl_ = lane < 52 ? lane >> 2 : 12, hl_ = lane & 3;
            unsigned pv[8][13], lq[8], mq[8];
#pragma unroll
            for (int qi2 = 0; qi2 < 8; ++qi2) { const int qoff = ((8 * w + qi2) * 13) * SLOT_B;
                lq[qi2] = __builtin_amdgcn_raw_buffer_load_b32(rs_, qoff + rl_ * SLOT_B + 256 + hl_ * 4, 0, 0); mq[qi2] = __builtin_amdgcn_raw_buffer_load_b32(rs_, qoff + rl_ * SLOT_B + 272 + hl_ * 4, 0, 0);
#pragma unroll
                for (int r = 0; r < 13; ++r) pv[qi2][r] = __builtin_amdgcn_raw_buffer_load_b32(rs_, qoff + r * SLOT_B + lane * 4, 0, 0); }
#pragma unroll
            for (int qi2 = 0; qi2 < 8; ++qi2) {
                const float sc_ = __builtin_amdgcn_exp2f(__builtin_bit_cast(float, mq[qi2]) + 2.f);
                float lt = lane < 52 ? __builtin_bit_cast(float, lq[qi2]) : 0.f;
                lt += __builtin_bit_cast(float, __builtin_amdgcn_update_dpp(0, __builtin_bit_cast(int, lt), 0x114, 0xF, 0xF, true));
                lt += __builtin_bit_cast(float, __builtin_amdgcn_update_dpp(0, __builtin_bit_cast(int, lt), 0x118, 0xF, 0xF, true));
                lt = sum_rows(lt);
                f32x2_t a01 = {0.f, 0.f}, a23 = {0.f, 0.f};
#pragma unroll
                for (int r = 0; r < 13; ++r) { const float so = __builtin_bit_cast(float, __builtin_amdgcn_ds_bpermute(4 * (4 * r + (lane >> 4)), __builtin_bit_cast(int, sc_)));
                    const f32x2_t so2 = {so, so}; a01 += __builtin_amdgcn_cvt_pk_f32_fp8((int)pv[qi2][r], false) * so2; a23 += __builtin_amdgcn_cvt_pk_f32_fp8((int)pv[qi2][r], true) * so2; }
                float* ap = ACC + (size_t)(qi2 * 4 + (lane >> 4)) * OACC_LD + 4 * (lane & 15);
                ap[0] = a01.x; ap[1] = a01.y; ap[2] = a23.x; ap[3] = a23.y;
                if (lane >= 12 && lane < 16) LACC[32 * w + qi2 * 4 + lane - 12] = lt;
            }
        }
    } else {
        for (int i = lane; i < 32 * OACC_LD; i += 64) ACC[i] = 0.f;
        if (lane < 32) LACC[32 * w + lane] = 0.f;
    }
    LDS_FENCE();
    SW_END(4);
    SW_BEGIN(5);
    LANE_REDERIVE();
#pragma unroll
    for (int k = 0; k < 4; ++k) qf[k] = *(const bf16x8*)(Qg + (size_t)(ql * 8 + hl) * 64 + 16 * k + 8 * h);
    {
        ST_SETUP
        const int ns = cur <= 15 ? cur + 1 : 3, w0 = max(0, t0 - 511) >> 6, nw = cur - w0 + 1, n = ns + nw;
        const bf16* KSd = kvb(2); const bf16* VSd = kvb(3); const bf16* KWd = kvb(4); const bf16* VWd = kvb(5);
#define SEQB_SRC(j_, Kp_, Vp_, st_) do { if ((j_) < ns) { Kp_ = KSd; Vp_ = VSd; st_ = cur <= 15 ? (j_) : ((j_) == 0 ? 0 : cur - 2 + (j_)); } \
            else { Kp_ = KWd; Vp_ = VWd; st_ = w0 + (j_) - ns; } } while (0)
#define FOLD(slot_, aexpr_, first_) do { if (h == 0) RS[(slot_) * 32 + c] = (aexpr_); LDS_FENCE(); \
            _Pragma("unroll") for (int i = 0; i < 16; ++i) { const int r = crow(i, h); const float a = RS[(slot_) * 32 + r]; \
                _Pragma("unroll") for (int d0 = 0; d0 < 2; ++d0) { float* ap = ACC + r * OACC_LD + 32 * d0 + c; if (first_) *ap = a * (Ob[d0][i] + *ap) + bf2f(PARK[r * 64 + 32 * d0 + c]); else *ap += a * Ob[d0][i]; } } \
            _Pragma("unroll") for (int i = 0; i < 16; ++i) { Ob[0][i] = 0.f; Ob[1][i] = 0.f; } lsum = 0.f; } while (0)
#pragma unroll
        for (int i = 0; i < 16; ++i) { Ob[0][i] = 0.f; Ob[1][i] = 0.f; }
        lsum = 0.f;
#define B_NEEDV(j_) true
#define B_ISSUE(S, j_) do { const bf16* Kp; const bf16* Vp; int stp; SEQB_SRC((j_), Kp, Vp, stp); ST_ISSUE(S, Kp, Vp, stp, true, (j_) < ns); } while (0)
#define B_COMP(j_, sb_) do { int st_j; { const bf16* k_; const bf16* v_; SEQB_SRC((j_), k_, v_, st_j); (void)k_; (void)v_; } \
            if ((j_) < ns) { stage_compute<2, 1>(sb_, st_j, qf, X, Ob, lsum, 0.f, carry, nullptr); \
                if ((j_) == ns - 1) { lsum = sum_halves(lsum); const float ls = lsum + LACC[32 * w + c]; FOLD(0, gt[1] * (ls > 0.f ? 1.f / ls : 0.f), true); } } \
            else { stage_compute<1, 1>(sb_, st_j, qf, X, Ob, lsum, 0.f, carry, nullptr); \
                if ((j_) == n - 1) { lsum = sum_halves(lsum); FOLD(2, gt[2] * (lsum > 0.f ? 1.f / lsum : 0.f), false); } } } while (0)
        SEQ_RUN(n, B_ISSUE, B_COMP, B_NEEDV);
#undef B_ISSUE
#undef B_COMP
#undef B_NEEDV
#undef SEQB_SRC
#undef FOLD
    }
#undef ST_ISSUE
#undef ST_COMMIT
#undef SEQ_RUN
    SW_END(5);
    SW_BEGIN(6);
    LDS_FENCE();
    {
        const int r = lane >> 1, hf = lane & 1; const float* src = ACC + r * OACC_LD + 32 * hf;
        float v[32]; float ss = 0.f;
#pragma unroll
        for (int k = 0; k < 32; ++k) { v[k] = src[k]; ss += v[k] * v[k]; }
        ss = add_xor1(ss);
        const float rstd = rsqrtf(ss * (1.f / 64.f) + EPS);
        const int rq = (32 * w + r) >> 2, rh = (32 * w + r) & 3; const int col = (4 * g + rh) * 64 + 32 * hf;
        const float* onw = p.in[15] + col; bf16* dst = (bf16*)(p.ws + WS_MIX) + (tbase + t0 + rq) * DM + col;
#pragma unroll
        for (int k = 0; k < 4; ++k) { const f32x4 w0 = *(const f32x4*)(onw + 8 * k), w1 = *(const f32x4*)(onw + 8 * k + 4);
            *(u32x4*)(dst + 8 * k) = (u32x4){cvtpk(v[8 * k] * rstd * w0.x, v[8 * k + 1] * rstd * w0.y), cvtpk(v[8 * k + 2] * rstd * w0.z, v[8 * k + 3] * rstd * w0.w),
                                            cvtpk(v[8 * k + 4] * rstd * w1.x, v[8 * k + 5] * rstd * w1.y), cvtpk(v[8 * k + 6] * rstd * w1.z, v[8 * k + 7] * rstd * w1.w)}; }
    }
    SW_END(6);
    __syncthreads();
}
__device__ __forceinline__ void ph_attn(const P& p, unsigned char* ring, float* biasL) {
    const int bx = blockIdx.x, vcu = (bx & 7) * 32 + (bx >> 3), bg = vcu >> 6, si = vcu & 63;
    build_bias_table(p, biasL, bg & 1);
    unsigned long long sw_acc = 0;
    for (int ui = 0; ui < 3; ++ui) {
        const int cur = ui == 0 ? 255 - si : ui == 1 ? 128 + si : 127 - si;
        attn_unit(p, bg >> 1, bg & 1, cur, ring, biasL, sw_acc);
    }
    {
        unsigned* qctr = (unsigned*)(p.ws + WS_CTL) + 2048 + 16 * bg;
        volatile __attribute__((address_space(3))) unsigned* qslot = (volatile __attribute__((address_space(3))) unsigned*)((__attribute__((address_space(3))) unsigned char*)ring + 139200 + 40);
        for (;;) {
            if (threadIdx.x == 0) *qslot = __hip_atomic_fetch_add(qctr, 1u, __ATOMIC_RELAXED, __HIP_MEMORY_SCOPE_AGENT);
            __syncthreads();
            const unsigned k = *qslot;
            __syncthreads();
            if (k >= 64u) break;
            attn_unit(p, bg >> 1, bg & 1, 63 - (int)k, ring, biasL, sw_acc);
        }
    }
    if (SW_REGION != 0 && si == 24 && bg == 1) {
        const unsigned long long t0 = __builtin_amdgcn_s_memrealtime();
        while (__builtin_amdgcn_s_memrealtime() - t0 < 4ull * sw_acc) __builtin_amdgcn_s_sleep(8);
    }
}

template <int NR>
__device__ __forceinline__ void ph_route(const P& p, int row_lo, int tid, int* lsh  , const float* LGb  , int ldl) {
    unsigned* cnt = (unsigned*)(p.ws + WS_CTL) + CW_CNT;
    int* LISTS = (int*)(p.ws + WS_LISTS); float* ROWW = (float*)(p.ws + WS_ROWW);
    const float* bg = p.in[20]; const float* be = p.in[22];
    if (tid < 64) lsh[tid] = 0;
    __syncthreads();
    int ex0 = 0, ex1 = 0, r0 = 0, r1 = 0; float w0 = 0.f, w1 = 0.f; const int t = row_lo + tid;
    if (tid < NR) {
        const float* l = LGb + (size_t)tid * ldl;
        float gl[8]; float gm = -3.0e38f; int gi = 0;
#pragma unroll
        for (int i = 0; i < 8; ++i) gl[i] = l[i];
#pragma unroll
        for (int i = 0; i < 8; ++i) { gl[i] += bg[i]; if (gl[i] > gm) { gm = gl[i]; gi = i; } }
        float gs = 0.f;
#pragma unroll
        for (int i = 0; i < 8; ++i) gs += __expf(gl[i] - gm);
        const float gp = 1.f / gs;
        float el[8]; float m0 = -3.0e38f, m1 = -3.0e38f; int i0 = 0, i1 = 0;
#pragma unroll
        for (int i = 0; i < 8; ++i) el[i] = l[8 + gi * 8 + i];
#pragma unroll
        for (int i = 0; i < 8; ++i) { el[i] += be[gi * 8 + i];
            if (el[i] > m0) { m1 = m0; i1 = i0; m0 = el[i]; i0 = i; } else if (el[i] > m1) { m1 = el[i]; i1 = i; } }
        const float e1 = __expf(m1 - m0); w0 = gp / (1.f + e1); w1 = gp * e1 / (1.f + e1);
        ex0 = gi * 8 + i0; ex1 = gi * 8 + i1;
        r0 = atomicAdd(&lsh[ex0], 1); r1 = atomicAdd(&lsh[ex1], 1);
    }
    __syncthreads();
    if (tid < 64) { const int c = lsh[tid]; lsh[128 + tid] = c ? (int)atomicAdd(&cnt[tid * 16], (unsigned)c) : 0; }
    __syncthreads();
    if (tid < NR) {
        const int s0 = lsh[128 + ex0] + r0, s1 = lsh[128 + ex1] + r1;
        LISTS[(size_t)ex0 * T + s0] = t; ROWW[(size_t)ex0 * T + s0] = w0;
        LISTS[(size_t)ex1 * T + s1] = t | (int)0x80000000; ROWW[(size_t)ex1 * T + s1] = w1;
    }
}
__device__ __forceinline__ void ph_norm2_router(const P& p, unsigned char* ldsb) {
    const int tid = opq_tid(), lane = tid & 63, wv = tid >> 6, fr = lane & 15, fq = lane >> 4;
    constexpr int WLD = 2064, L_AB = 73 * WLD, L_RT = L_AB + 8192;
    const int row0 = blockIdx.x * 128, b = row0 / SEQ, row = row0 + wv * 16 + fr;
    const bf16* xr = (const bf16*)(p.ws + WS_X1) + (size_t)row * DM + fq * 8;
    const bf16* WR = (const bf16*)(p.ws + WS_WR_T);
#pragma unroll
    for (int k = 0; k < 18; ++k) { const int it = __builtin_amdgcn_readfirstlane(wv) + 8 * k, n = it >> 1, hf = it & 1;
        __builtin_amdgcn_global_load_lds((const unsigned*)(WR + (size_t)n * 1024 + hf * 512 + lane * 8), (PG8_LAS unsigned*)((PG8_LAS unsigned char*)ldsb + (n + (n >= 67 ? 1 : 0)) * WLD + hf * 1024), 16, 0, 0); }
    const float* mod = (const float*)(p.ws + WS_MOD) + b * 6144 + 3072; const float* nw = p.in[18]; const int t8 = tid & 255;
    const f32x4 m_sh = *(const f32x4*)(mod + 4 * t8), m_sc = *(const f32x4*)(mod + 1024 + 4 * t8), m_w = *(const f32x4*)(nw + 4 * t8);
    asm volatile("" ::: "memory");
    u32x4 v[32];
#pragma unroll
    for (int ks = 0; ks < 32; ++ks) v[ks] = *(const u32x4*)(xr + 32 * ks);
    asm volatile("s_waitcnt vmcnt(32)" ::: "memory");
    if (tid < 256) { *(f32x4*)(ldsb + L_AB + 16 * tid) = m_w * (m_sc + 1.f); *(f32x4*)(ldsb + L_AB + 4096 + 16 * tid) = m_sh; }
    asm volatile("s_waitcnt lgkmcnt(0)" ::: "memory"); __builtin_amdgcn_s_barrier(); asm volatile("" ::: "memory");
    float ss = 0.f;
#pragma unroll
    for (int ks = 0; ks < 32; ++ks) { const u32x4 a = v[ks];
        ss += bflo(a.x) * bflo(a.x) + bfhi(a.x) * bfhi(a.x) + bflo(a.y) * bflo(a.y) + bfhi(a.y) * bfhi(a.y) + bflo(a.z) * bflo(a.z) + bfhi(a.z) * bfhi(a.z) + bflo(a.w) * bflo(a.w) + bfhi(a.w) * bfhi(a.w); }
    const float rstd = rsqrtf(sum_rows(ss) * (1.f / DM) + EPS);
#pragma unroll
    for (int ks = 0; ks < 32; ++ks) asm volatile("" : "+v"(v[ks]));
    f32x4 acc[5];
#pragma unroll
    for (int j = 0; j < 5; ++j) acc[j] = (f32x4){0.f, 0.f, 0.f, 0.f};
    bf16* xo = (bf16*)(p.ws + WS_XN) + (size_t)row * DM + fq * 8;
    const unsigned char* wl = ldsb + fr * WLD + fq * 16; const unsigned char* ab = ldsb + L_AB + fq * 32;
#pragma unroll
    for (int ks = 0; ks < 32; ++ks) {
        const f32x4 a0 = *(const f32x4*)(ab + ks * 128), a1 = *(const f32x4*)(ab + ks * 128 + 16), b0 = *(const f32x4*)(ab + 4096 + ks * 128), b1 = *(const f32x4*)(ab + 4096 + ks * 128 + 16);
        const u32x4 a = v[ks];
        const f32x4 h0 = (f32x4){bflo(a.x), bfhi(a.x), bflo(a.y), bfhi(a.y)} * rstd * a0 + b0, h1 = (f32x4){bflo(a.z), bfhi(a.z), bflo(a.w), bfhi(a.w)} * rstd * a1 + b1;
        const u32x4 hv = (u32x4){pk2(h0.x, h0.y), pk2(h0.z, h0.w), pk2(h1.x, h1.y), pk2(h1.z, h1.w)};
        *(u32x4*)(xo + 32 * ks) = hv;
        const bf16x8 af = __builtin_bit_cast(bf16x8, hv);
#pragma unroll
        for (int j = 0; j < 5; ++j) { u32x4 w = (j < 4 || fr < 8) ? *(const u32x4*)(wl + (j * 16 + ((j == 4 && fr >= 3) ? 1 : 0)) * WLD + ks * 64) : (u32x4){0u, 0u, 0u, 0u};
            acc[j] = __builtin_amdgcn_mfma_f32_16x16x32_bf16(__builtin_bit_cast(bf16x8, w), af, acc[j], 0, 0, 0); }
        asm volatile("" ::: "memory");
    }
    asm volatile("s_waitcnt lgkmcnt(0)" ::: "memory"); __builtin_amdgcn_s_barrier(); asm volatile("" ::: "memory");
    { float* ll = (float*)ldsb + (size_t)(wv * 16 + fr) * 73 + 4 * fq;
#pragma unroll
      for (int j = 0; j < 4; ++j) { ll[16 * j] = acc[j][0]; ll[16 * j + 1] = acc[j][1]; ll[16 * j + 2] = acc[j][2]; ll[16 * j + 3] = acc[j][3]; }
      if (fq < 2) { ll[64] = acc[4][0]; ll[65] = acc[4][1]; ll[66] = acc[4][2]; ll[67] = acc[4][3]; } }
    asm volatile("s_waitcnt lgkmcnt(0)" ::: "memory"); __builtin_amdgcn_s_barrier(); asm volatile("" ::: "memory");
    ph_route<128>(p, row0, tid, (int*)(ldsb + L_RT), (const float*)ldsb, 73);
}
__device__ __forceinline__ void build_tile_base(const P& p, int* tb) {
    const unsigned* cnt = (const unsigned*)(p.ws + WS_CTL) + CW_CNT;
    if (threadIdx.x == 0) { int s = 0; for (int i = 0; i < 64; ++i) { tb[i] = s; s += ((int)cnt[i * 16] + 255) >> 8; } tb[64] = s; }
    __syncthreads();
}
__device__ __forceinline__ void ph_combine(const P& p, int gw, int ngw) {
    const int lane = opq_tid() & 63;
    const bf16* X1 = (const bf16*)(p.ws + WS_X1); const bf16* Y0 = (const bf16*)(p.ws + WS_XN); const bf16* Y1 = (const bf16*)(p.ws + WS_Y1);
    constexpr int RU = 4;
    for (int row0 = gw; row0 < T; row0 += RU * ngw) {
        u32x4 x0[RU], x1[RU], a0[RU], a1[RU], b0[RU], b1[RU];
        const float* g2 = (const float*)(p.ws + WS_MOD) + (row0 / SEQ) * 6144 + 5120 + lane * 16;
        const f32x4 g0 = *(const f32x4*)g2, g1 = *(const f32x4*)(g2 + 4), g2v = *(const f32x4*)(g2 + 8), g3 = *(const f32x4*)(g2 + 12);
#pragma unroll
        for (int u = 0; u < RU; ++u) { const size_t off = (size_t)(row0 + u * ngw) * DM + lane * 16;
            x0[u] = *(const u32x4*)(X1 + off); x1[u] = *(const u32x4*)(X1 + off + 8); a0[u] = *(const u32x4*)(Y0 + off); a1[u] = *(const u32x4*)(Y0 + off + 8); b0[u] = *(const u32x4*)(Y1 + off); b1[u] = *(const u32x4*)(Y1 + off + 8); }
#pragma unroll
        for (int u = 0; u < RU; ++u) { float* o = p.out + (size_t)(row0 + u * ngw) * DM + lane * 16;
#define CMB(xv, av, bv, gv) (f32x4){bflo(xv.x) + gv[0] * (bflo(av.x) + bflo(bv.x)), bfhi(xv.x) + gv[1] * (bfhi(av.x) + bfhi(bv.x)), bflo(xv.y) + gv[2] * (bflo(av.y) + bflo(bv.y)), bfhi(xv.y) + gv[3] * (bfhi(av.y) + bfhi(bv.y))}
#define CMB2(xv, av, bv, gv) (f32x4){bflo(xv.z) + gv[0] * (bflo(av.z) + bflo(bv.z)), bfhi(xv.z) + gv[1] * (bfhi(av.z) + bfhi(bv.z)), bflo(xv.w) + gv[2] * (bflo(av.w) + bflo(bv.w)), bfhi(xv.w) + gv[3] * (bfhi(av.w) + bfhi(bv.w))}
            *(f32x4*)o = CMB(x0[u], a0[u], b0[u], g0); *(f32x4*)(o + 4) = CMB2(x0[u], a0[u], b0[u], g1);
            *(f32x4*)(o + 8) = CMB(x1[u], a1[u], b1[u], g2v); *(f32x4*)(o + 12) = CMB2(x1[u], a1[u], b1[u], g3); }
#undef CMB
#undef CMB2
    }
}
#define LAS __attribute__((address_space(3)))
#define XB_TMO      128
#define XB_XCNT(j)  (256  + 64 * (j))
#define XB_XSUB(j)  (1280 + 64 * (j))
#define XB_XGEN(j)  (2304 + 64 * (j))
#define XB_TOP      3328
#define XB_TOPGEN   3392
#define XCD_BAR_WORDS 3456
#define XB_SPIN_CAP (1u << 18)
constexpr int CW_BAR = 4096;
__device__ __forceinline__ unsigned xb_ld(unsigned* p)              { return __hip_atomic_load(p, __ATOMIC_RELAXED, __HIP_MEMORY_SCOPE_AGENT); }
__device__ __forceinline__ unsigned xb_add(unsigned* p, unsigned v) { return __hip_atomic_fetch_add(p, v, __ATOMIC_RELAXED, __HIP_MEMORY_SCOPE_AGENT); }
__device__ __forceinline__ unsigned xb_xcc_id() { return (unsigned)__builtin_amdgcn_s_getreg((3 << 11) | 20) & 0xFu; }
#define XB_SPIN(cond, bar) do { unsigned _sp = 0; while (cond) { __builtin_amdgcn_s_sleep(1); \
    if ((++_sp & 255u) == 0u) { if (xb_ld(&(bar)[XB_TMO])) break; if (_sp > XB_SPIN_CAP) { atomicAdd(&(bar)[XB_TMO], 1u); break; } } } } while (0)
struct XcdBarrier { unsigned* bar; unsigned x; volatile LAS unsigned* st; };
__device__ __forceinline__ XcdBarrier xcd_barrier_post(unsigned* bar, volatile LAS unsigned* st) {
    XcdBarrier b; b.bar = bar; b.x = xb_xcc_id(); b.st = st;
    if (threadIdx.x == 0) (void)xb_add(&bar[XB_XCNT(b.x)], 1u);
    return b;
}
__device__ __forceinline__ void xcd_barrier_complete(unsigned* bar, unsigned x, unsigned& nloc, unsigned& nx) {
    const unsigned G = gridDim.x * gridDim.y * gridDim.z;
    unsigned sum, cnt, mine, sp = 0u;
    for (;;) {
        sum = 0u; cnt = 0u; mine = 0u;
#pragma unroll
        for (unsigned j = 0; j < 16; ++j) { const unsigned c = xb_ld(&bar[XB_XCNT(j)]); sum += c; cnt += (c > 0u) ? 1u : 0u; mine = (j == x) ? c : mine; }
        if (sum == G) break;
        __builtin_amdgcn_s_sleep(1);
        if ((++sp & 255u) == 0u) { if (xb_ld(&bar[XB_TMO])) break; if (sp > XB_SPIN_CAP) { atomicAdd(&bar[XB_TMO], 1u); break; } }
    }
    nloc = mine > 0u ? mine : 1u; nx = cnt > 0u ? cnt : 1u;
}
__device__ __forceinline__ void xcd_barrier(const XcdBarrier& b) {
    asm volatile("s_waitcnt vmcnt(0)" ::: "memory");
    __syncthreads();
    if (threadIdx.x == 0) {
        unsigned* bar = b.bar;
        __builtin_amdgcn_s_waitcnt(0);
        unsigned nloc = b.st[0], nx = b.st[1];
        if (nloc == 0u) { xcd_barrier_complete(bar, b.x, nloc, nx); b.st[0] = nloc; b.st[1] = nx; }
        const unsigned old = xb_add(&bar[XB_XSUB(b.x)], 1u);
        const unsigned gen = old / nloc;
        if (old + 1u == (gen + 1u) * nloc) {
            __builtin_amdgcn_fence(__ATOMIC_RELEASE, "agent");
            asm volatile("s_waitcnt vmcnt(0)" ::: "memory");
            const unsigned og = xb_add(&bar[XB_TOP], 1u);
            const unsigned tg = og / nx;
            if (og + 1u == (tg + 1u) * nx) xb_add(&bar[XB_TOPGEN], 1u);
            else XB_SPIN(xb_ld(&bar[XB_TOPGEN]) == tg, bar);
            __builtin_amdgcn_fence(__ATOMIC_ACQUIRE, "agent");
            xb_add(&bar[XB_XGEN(b.x)], 1u);
            asm volatile("s_waitcnt vmcnt(0)" ::: "memory");
        } else {
            XB_SPIN(xb_ld(&bar[XB_XGEN(b.x)]) == gen, bar);
            __builtin_amdgcn_fence(__ATOMIC_ACQUIRE, "agent");
            asm volatile("s_waitcnt vmcnt(0)" ::: "memory");
        }
    }
    __syncthreads();
}

constexpr int NT = 512;
constexpr int LDS_SCR = 0, LDS_SHB = 131072, LDS_MISC = 139200, LDS_BYTES = 163840;
__global__ void __launch_bounds__(NT) mega(P p) {
    extern __shared__ __attribute__((aligned(16))) unsigned char ldsb[];
    float* lds = (float*)ldsb;
    const int ngw = gridDim.x * (NT / 64);
#define TIDV opq_tid()
#define GW (blockIdx.x * (NT / 64) + (TIDV >> 6))
#define SCR (lds + (TIDV >> 6) * (8448 / 4))
    float* shb = lds + LDS_SHB / 4;
    volatile LAS unsigned* misc = (volatile LAS unsigned*)((LAS unsigned char*)ldsb + LDS_MISC);
    if (threadIdx.x < 16) misc[threadIdx.x] = 0u;
    __syncthreads();
    XcdBarrier bar = xcd_barrier_post((unsigned*)(p.ws + WS_CTL) + CW_BAR, misc);
#define GB() xcd_barrier(bar)
    PG8_LAS unsigned char* ring = (PG8_LAS unsigned char*)ldsb;
    const int G = gridDim.x, cb = blockIdx.x;
    const unsigned* cnt = (const unsigned*)(p.ws + WS_CTL) + CW_CNT;
#define PHASE_0 { ph_wprep_a(p, GW, ngw, SCR); if (cb < 192) ph_mod(p, blockIdx.x, 192, shb); else ph_posb(p, cb - 192, shb); }
#define PHASE_1 { ph_rownorm<false>(p, GW, ngw, p.in[0], 0); }
#define PHASE_2 { pg8::StaticOrder S; S.init(p.ws + WS_XN, p.ws + WS_WIN_T, DM, DM, T, NINP, G, cb); pg8::EpiRaw E{(bf16*)(p.ws + WS_R1), NINP}; \
      pg8::gemm_phase<pg8::EpiRaw, pg8::StaticOrder, false>(ring, DM, DM, S, E); }
#define PHASE_3 { ph_post(p, ldsb); }
#define PHASE_4 { if (cb < 32) { pg8::CmpOrder S{(const char*)(p.ws + WS_KV), (const char*)(p.ws + WS_CW1_T), cb}; pg8::EpiCmp E{(bf16*)(p.ws + WS_HID), (const float*)(p.ws + WS_POSB)}; \
      pg8::gemm_phase<pg8::EpiCmp, pg8::CmpOrder, false>(ring, 2048, 1024, S, E); \
      asm volatile("s_waitcnt vmcnt(0)" ::: "memory"); __syncthreads(); ph_cmp_fin2(p, cb); \
      asm volatile("s_waitcnt vmcnt(0)" ::: "memory"); __syncthreads(); \
      if (threadIdx.x == 0) { __builtin_amdgcn_fence(__ATOMIC_RELEASE, "agent"); (void)xb_add((unsigned*)(p.ws + WS_CTL) + 2200, 1u); } } \
    else ph_wprep_moe(p, GW - 32 * (NT / 64), ngw - 32 * (NT / 64), SCR); }
#define PHASE_6 { ph_attn(p, ldsb, shb); }
#define PHASE_7 { pg8::StaticOrder S; S.init(p.ws + WS_MIX, p.ws + WS_WOUT_T, DM, DM, T, DM, G, cb); pg8::EpiOutRes E{p.in[0], (bf16*)(p.ws + WS_X1), (const float*)(p.ws + WS_MOD)}; \
      pg8::gemm_phase<pg8::EpiOutRes, pg8::StaticOrder, false>(ring, DM, DM, S, E); }
#define PHASE_8 { ph_norm2_router(p, ldsb); }
#define PHASE_9 { pg8::StaticOrder S; S.init(p.ws + WS_XN, p.ws + WS_WR_T, DM, DM, T, 256, G, cb); pg8::EpiRouter E{(float*)(p.ws + WS_LOGITS)}; \
      pg8::gemm_phase<pg8::EpiRouter, pg8::StaticOrder, false>(ring, DM, DM, S, E); \
      { pg8::Unit u_; if (S.next(0, u_)) { asm volatile("s_waitcnt vmcnt(0)" ::: "memory"); __syncthreads(); ph_route<256>(p, u_.pm * 256, TIDV, (int*)shb); } } }
#define PHASE_11 { build_tile_base(p, (int*)shb); pg8::MoeOrder1 S{(const char*)(p.ws + WS_XN), (const char*)(p.ws + WS_W13_T), (const int*)(p.ws + WS_LISTS), cnt, (const int*)shb, G, cb}; pg8::EpiMoe1 E{(bf16*)(p.ws + WS_H)}; \
      pg8::gemm_phase<pg8::EpiMoe1, pg8::MoeOrder1, true>(ring, DM, DM, S, E); }
#define PHASE_12 { pg8::MoeOrder2 S{(const char*)(p.ws + WS_H), (const char*)(p.ws + WS_W2_T), (const int*)(p.ws + WS_LISTS), cnt, (const int*)shb, G, cb}; pg8::EpiMoe2 E{(bf16*)(p.ws + WS_XN), (bf16*)(p.ws + WS_Y1), (const float*)(p.ws + WS_MOD)}; \
      pg8::gemm_phase<pg8::EpiMoe2, pg8::MoeOrder2, false>(ring, 512, 512, S, E); }
#define PHASE_13 { ph_combine(p, GW, ngw); }
#ifndef PROBE_DUP
#define PROBE_DUP -1
#endif
#define RUN(k) { PHASE_##k GB(); if (PROBE_DUP == k) { PHASE_##k GB(); } }
    RUN(0) RUN(1) RUN(2) RUN(3)
    { PHASE_4 }
    { asm volatile("s_waitcnt vmcnt(0)" ::: "memory"); __syncthreads();
      if (threadIdx.x == 0) { unsigned* cd_ = (unsigned*)(p.ws + WS_CTL) + 2200; unsigned sp_ = 0u;
          while (xb_ld(cd_) < 32u) { __builtin_amdgcn_s_sleep(2); if (++sp_ > XB_SPIN_CAP) break; }
          __builtin_amdgcn_fence(__ATOMIC_ACQUIRE, "agent"); asm volatile("s_waitcnt vmcnt(0)" ::: "memory"); }
      __syncthreads(); }
    RUN(6) RUN(7) RUN(8)
    RUN(11)
    RUN(12)
    PHASE_13
}

extern "C" void kernel_launch(void* const* d_in, const int* in_sizes, int n_in, void* d_out, int out_size, void* d_ws, size_t ws_size, hipStream_t stream) {
    static int ready = 0;
    if (ready == 0) {
        if (n_in != 26 || ws_size < WS_END) { fprintf(stderr, "kernel_launch: bad args n_in=%d ws=%zu\n", n_in, ws_size); ready = -1; return; }
        if (hipFuncSetAttribute((const void*)mega, hipFuncAttributeMaxDynamicSharedMemorySize, LDS_BYTES) != hipSuccess) { fprintf(stderr, "kernel_launch: hipFuncSetAttribute failed\n"); ready = -1; return; }
        ready = 1;
    }
    if (ready < 0) return;
    P p{};
    for (int i = 0; i < 26; ++i) p.in[i] = (const float*)d_in[i];
    p.out = (float*)d_out; p.ws = (unsigned char*)d_ws;
    (void)hipMemsetAsync((char*)d_ws + WS_CTL, 0, 1 * MiB + 65536 + 2048, stream);
    hipLaunchKernelGGL(mega, dim3(256), dim3(NT), LDS_BYTES, stream, p);
}
```
